# Optimizing an MI355X kernel written in HIP

```python
import jax
import jax.numpy as jnp
from jax import lax
import numpy as np

D_MODEL = 1024
BATCH = 4
SEQ = 8192
DEPTH = 2

GRID_W = 64
CTX_LEN = 256
D_MIX = D_MODEL
CONF_W = D_MIX // 4
SCONV_W = D_MIX // 4
LRU_W = D_MIX // 2
MIX_HEAD_DIM = 64
MIX_HEADS = D_MIX // MIX_HEAD_DIM
CONF_K = 31
SCONV_K = 3
LRU_CONV_K = 4
CONF_PAD = ((CONF_K - 1) // 2, (CONF_K - 1) // 2)
SCONV_PAD = ((SCONV_K - 1) // 2, (SCONV_K - 1) // 2)
LRU_PAD = (LRU_CONV_K // 2, LRU_CONV_K - 1 - LRU_CONV_K // 2)
LRU_HEAD_DIM = 64
LRU_HEADS = LRU_W // LRU_HEAD_DIM
LRU_C = 8.0
D_FF = ((8 * D_MODEL // 3 + 127) // 128) * 128
N_EXPERTS = 8
TOP_K = 2
N_DENSE = (DEPTH + 1) // 2
N_MOE = DEPTH // 2
EPS = 1e-6
SPLITS = (CONF_W, 2 * CONF_W, 2 * CONF_W + SCONV_W, 2 * CONF_W + 2 * SCONV_W,
          2 * CONF_W + 3 * SCONV_W, 2 * CONF_W + 3 * SCONV_W + LRU_W)
W_IN_COLS = 2 * CONF_W + 3 * SCONV_W + 2 * LRU_W
C_X_START = SPLITS[4]
C_X_END = SPLITS[5]

kernel_name = 'hybrid_conformer_shortconv_rglru_moe_dit'


def rms_norm(x, g):
    xf = x.astype(jnp.float32)
    y = xf * lax.rsqrt(jnp.mean(xf * xf, axis=-1, keepdims=True) + EPS)
    return (y * g.astype(jnp.float32)).astype(x.dtype)


def layer_norm(x, g, b):
    xf = x.astype(jnp.float32)
    mu = jnp.mean(xf, axis=-1, keepdims=True)
    var = jnp.mean(jnp.square(xf - mu), axis=-1, keepdims=True)
    y = (xf - mu) * lax.rsqrt(var + EPS)
    return (y * g.astype(jnp.float32) + b.astype(jnp.float32)).astype(x.dtype)


def head_rms_norm(y, g):
    bsz, t, _ = y.shape
    yh = y.reshape(bsz, t, MIX_HEADS, MIX_HEAD_DIM).astype(jnp.float32)
    yh = yh * lax.rsqrt(jnp.mean(yh * yh, axis=-1, keepdims=True) + EPS)
    return (yh.reshape(bsz, t, D_MIX) * g.astype(jnp.float32)).astype(y.dtype)


def modulate(x, shift, scale):
    return x * (1.0 + scale) + shift


def dwconv(x, w, pad, b=None):
    y = lax.conv_general_dilated(x, w[:, None, :].astype(x.dtype), window_strides=(1,), padding=[pad],
                                 dimension_numbers=('NWC', 'WIO', 'NWC'), feature_group_count=x.shape[-1])
    return y if b is None else y + b.astype(y.dtype)


def conv_rows(x, w, pad, b=None):
    bsz, t, ch = x.shape
    rows = t // GRID_W
    y = dwconv(x.reshape(bsz * rows, GRID_W, ch), w, pad, b)
    return y.reshape(bsz, t, ch)


def conv_cols(x, w, pad, b=None):
    bsz, t, ch = x.shape
    rows = t // GRID_W
    xc = x.reshape(bsz, rows, GRID_W, ch).transpose(0, 2, 1, 3).reshape(bsz * GRID_W, rows, ch)
    y = dwconv(xc, w, pad, b)
    return y.reshape(bsz, GRID_W, rows, ch).transpose(0, 2, 1, 3).reshape(bsz, t, ch)


def linear_scan(a, b, h0, reverse):
    if reverse:
        b = b.at[:, -1].add(a[:, -1] * h0)
    else:
        b = b.at[:, 0].add(a[:, 0] * h0)

    def combine(e1, e2):
        a1, b1 = e1
        a2, b2 = e2
        return a1 * a2, a2 * b1 + b2

    _, h = lax.associative_scan(combine, (a, b), axis=1, reverse=reverse)
    return h


def rglru_direction(xc, w_a, b_a, w_x, b_x, lam, h0, reverse):
    bsz, t, _ = xc.shape
    xh = xc.reshape(bsz, t, LRU_HEADS, LRU_HEAD_DIM)
    r = jax.nn.sigmoid(jnp.einsum('blhi,hij->blhj', xh, w_a.astype(jnp.float32)).reshape(bsz, t, LRU_W)
                       + b_a.astype(jnp.float32))
    i = jax.nn.sigmoid(jnp.einsum('blhi,hij->blhj', xh, w_x.astype(jnp.float32)).reshape(bsz, t, LRU_W)
                       + b_x.astype(jnp.float32))
    log_a = LRU_C * r * jax.nn.log_sigmoid(lam.astype(jnp.float32))
    a = jnp.exp(log_a)
    mult = jnp.sqrt(jnp.maximum(-jnp.expm1(2.0 * log_a), 0.0))
    return linear_scan(a, mult * (i * xc), h0, reverse)


def rglru_bidir(c_x, p, h0f, h0b):
    xc = dwconv(c_x, p['lru_conv_w'], LRU_PAD, p['lru_conv_b']).astype(jnp.float32)
    hf = rglru_direction(xc, p['lru_wa'][0], p['lru_ba'][0], p['lru_wx'][0], p['lru_bx'][0],
                         p['lru_lam'][0], h0f, False)
    hb = rglru_direction(xc, p['lru_wa'][1], p['lru_ba'][1], p['lru_wx'][1], p['lru_bx'][1],
                         p['lru_lam'][1], h0b, True)
    return hf, hb


def token_mixer(h, p, grid, h0f, h0b):
    proj = h @ p['w_in']
    a_val, a_gate, s_bg, s_cg, s_x, c_x, c_g = jnp.split(proj, list(SPLITS), axis=-1)
    conv_a = conv_rows if grid else dwconv
    conv_b = conv_cols if grid else dwconv
    u = conv_a(a_val * jax.nn.sigmoid(a_gate), p['conf_w'], CONF_PAD, p['conf_b'])
    ya = jax.nn.silu(layer_norm(u, p['conf_ln_g'], p['conf_ln_b']))
    yb = s_bg * conv_b(s_cg * s_x, p['sconv_w'], SCONV_PAD)
    hf, hb = rglru_bidir(c_x, p, h0f, h0b)
    yc = (hf + hb).astype(h.dtype) * jax.nn.gelu(c_g)
    y = head_rms_norm(jnp.concatenate([ya, yb, yc], axis=-1), p['g_mix'])
    return y @ p['w_out'], hf[:, -1], hb[:, 0]


def swiglu(h, w1, w3, w2):
    return (jax.nn.silu(h @ w1) * (h @ w3)) @ w2


def moe_swiglu(h, w_r, b_r, w1, w3, w2):
    logits = (h @ w_r).astype(jnp.float32) + b_r.astype(jnp.float32)
    top_v, top_i = lax.top_k(logits, TOP_K)
    probs = jax.nn.softmax(top_v, axis=-1)
    combine = jnp.einsum('blk,blke->ble', probs, jax.nn.one_hot(top_i, N_EXPERTS, dtype=jnp.float32))
    out = jnp.zeros_like(h)
    for e in range(N_EXPERTS):
        out = out + combine[..., e, None].astype(h.dtype) * swiglu(h, w1[e], w3[e], w2[e])
    return out


def setup_inputs(seed: int = 0) -> dict:
    key = jax.random.key(seed)
    ks = iter(jax.random.split(key, 40))

    def nrm(shape, scale):
        return scale * jax.random.normal(next(ks), shape, jnp.float32)

    def gain(shape):
        return 1.0 + 0.1 * jax.random.normal(next(ks), shape, jnp.float32)

    d = D_MODEL
    x = nrm((BATCH, SEQ, d), 1.0)
    c = nrm((BATCH, d), 1.0)
    ctx = nrm((BATCH, CTX_LEN, d), 1.0)
    c_ctx = nrm((d,), 1.0)
    w_mod = nrm((DEPTH, d, 6 * d), 0.5 * d ** -0.5)
    b_mod = nrm((DEPTH, 6 * d), 0.1)
    g_norm1 = gain((DEPTH, d))
    g_norm2 = gain((DEPTH, d))
    w_in = nrm((DEPTH, d, W_IN_COLS), d ** -0.5)
    conf_w = nrm((DEPTH, CONF_K, CONF_W), CONF_K ** -0.5)
    conf_b = nrm((DEPTH, CONF_W), 0.02)
    conf_ln_g = gain((DEPTH, CONF_W))
    conf_ln_b = nrm((DEPTH, CONF_W), 0.02)
    sconv_w = nrm((DEPTH, SCONV_K, SCONV_W), SCONV_K ** -0.5)
    lru_conv_w = nrm((DEPTH, LRU_CONV_K, LRU_W), LRU_CONV_K ** -0.5)
    lru_conv_b = nrm((DEPTH, LRU_W), 0.02)
    lru_wa = nrm((DEPTH, 2, LRU_HEADS, LRU_HEAD_DIM, LRU_HEAD_DIM), LRU_HEAD_DIM ** -0.5)
    lru_ba = nrm((DEPTH, 2, LRU_W), 0.1)
    lru_wx = nrm((DEPTH, 2, LRU_HEADS, LRU_HEAD_DIM, LRU_HEAD_DIM), LRU_HEAD_DIM ** -0.5)
    lru_bx = nrm((DEPTH, 2, LRU_W), 0.1)
    u = jax.random.uniform(next(ks), (DEPTH, 2, LRU_W), jnp.float32, 0.9, 0.999)
    a_base = u ** (1.0 / LRU_C)
    lru_lam = jnp.log(a_base) - jnp.log1p(-a_base)
    g_mix = gain((DEPTH, D_MIX))
    w_out = nrm((DEPTH, D_MIX, d), D_MIX ** -0.5)
    ffn_w1 = nrm((N_DENSE, d, D_FF), d ** -0.5)
    ffn_w3 = nrm((N_DENSE, d, D_FF), d ** -0.5)
    ffn_w2 = nrm((N_DENSE, D_FF, d), D_FF ** -0.5)
    router_w = nrm((N_MOE, d, N_EXPERTS), d ** -0.5)
    router_b = nrm((N_MOE, N_EXPERTS), 0.01)
    moe_w1 = nrm((N_MOE, N_EXPERTS, d, D_FF), d ** -0.5)
    moe_w3 = nrm((N_MOE, N_EXPERTS, d, D_FF), d ** -0.5)
    moe_w2 = nrm((N_MOE, N_EXPERTS, D_FF, d), D_FF ** -0.5)
    g_final = gain((d,))
    return {'x': x, 'c': c, 'ctx': ctx, 'c_ctx': c_ctx, 'w_mod': w_mod, 'b_mod': b_mod,
            'g_norm1': g_norm1, 'g_norm2': g_norm2, 'w_in': w_in, 'conf_w': conf_w, 'conf_b': conf_b,
            'conf_ln_g': conf_ln_g, 'conf_ln_b': conf_ln_b, 'sconv_w': sconv_w,
            'lru_conv_w': lru_conv_w, 'lru_conv_b': lru_conv_b, 'lru_wa': lru_wa, 'lru_ba': lru_ba,
            'lru_wx': lru_wx, 'lru_bx': lru_bx, 'lru_lam': lru_lam, 'g_mix': g_mix, 'w_out': w_out,
            'ffn_w1': ffn_w1, 'ffn_w3': ffn_w3, 'ffn_w2': ffn_w2, 'router_w': router_w,
            'router_b': router_b, 'moe_w1': moe_w1, 'moe_w3': moe_w3, 'moe_w2': moe_w2,
            'g_final': g_final}


def reference(x, c, ctx, c_ctx, w_mod, b_mod, g_norm1, g_norm2, w_in, conf_w, conf_b, conf_ln_g,
              conf_ln_b, sconv_w, lru_conv_w, lru_conv_b, lru_wa, lru_ba, lru_wx, lru_bx, lru_lam,
              g_mix, w_out, ffn_w1, ffn_w3, ffn_w2, router_w, router_b, moe_w1, moe_w3, moe_w2,
              g_final):
    bsz = x.shape[0]
    zero_state = jnp.zeros((bsz, LRU_W), jnp.float32)
    silu_c = jax.nn.silu(c)
    silu_cc = jax.nn.silu(c_ctx)
    for l in range(DEPTH):
        last = l == DEPTH - 1
        p = {'w_in': w_in[l], 'conf_w': conf_w[l], 'conf_b': conf_b[l], 'conf_ln_g': conf_ln_g[l],
             'conf_ln_b': conf_ln_b[l], 'sconv_w': sconv_w[l], 'lru_conv_w': lru_conv_w[l],
             'lru_conv_b': lru_conv_b[l], 'lru_wa': lru_wa[l], 'lru_ba': lru_ba[l], 'lru_wx': lru_wx[l],
             'lru_bx': lru_bx[l], 'lru_lam': lru_lam[l], 'g_mix': g_mix[l], 'w_out': w_out[l]}

        def channel_mixer(h):
            j = l // 2
            if l % 2 == 0:
                return swiglu(h, ffn_w1[j], ffn_w3[j], ffn_w2[j])
            return moe_swiglu(h, router_w[j], router_b[j], moe_w1[j], moe_w3[j], moe_w2[j])

        mod_x = (silu_c @ w_mod[l] + b_mod[l])[:, None, :]
        sh1, sc1, gt1, sh2, sc2, gt2 = jnp.split(mod_x, 6, axis=-1)
        mod_c = (silu_cc @ w_mod[l] + b_mod[l])[None, None, :]
        csh1, csc1, cgt1, csh2, csc2, cgt2 = jnp.split(mod_c, 6, axis=-1)

        hc = modulate(rms_norm(ctx, g_norm1[l]), csh1, csc1)
        if last:
            hf_c, hb_c = rglru_bidir(hc @ w_in[l][:, C_X_START:C_X_END], p, zero_state, zero_state)
            state_f, state_b = hf_c[:, -1], hb_c[:, 0]
        else:
            out_c, state_f, state_b = token_mixer(hc, p, False, zero_state, zero_state)
            ctx = ctx + cgt1 * out_c
            ctx = ctx + cgt2 * channel_mixer(modulate(rms_norm(ctx, g_norm2[l]), csh2, csc2))

        hx = modulate(rms_norm(x, g_norm1[l]), sh1, sc1)
        out_x, _, _ = token_mixer(hx, p, True, state_f, state_b)
        x = x + gt1 * out_x
        x = x + gt2 * channel_mixer(modulate(rms_norm(x, g_norm2[l]), sh2, sc2))
    return rms_norm(x, g_final)
```

```cpp
#include <hip/hip_runtime.h>
#include <stdint.h>
#include <cstdio>

constexpr int D = 1024, NB = 4, SEQ = 8192, CTXL = 256, GW = 64;
constexpr int ML = NB * SEQ;
constexpr int MC = NB * CTXL;
constexpr int MA = ML + MC;
constexpr int WIN = 2304, DFF = 2816, NE = 8, LRU = 512;
constexpr int CONFK = 31;
constexpr float EPS = 1e-6f;
constexpr int C_AVAL = 0, C_AGATE = 256, C_SBG = 512, C_SCG = 768, C_SX = 1024, C_CX = 1280, C_CG = 1792;
constexpr int PW = 1792, P_GLU = 0, P_V = 256, P_SBG = 512, P_CX = 768, P_CG = 1280;
constexpr int M_SH1 = 0, M_SC1 = 1024, M_GT1 = 2048, M_SH2 = 3072, M_SC2 = 4096, M_GT2 = 5120;

typedef unsigned short bf16_t;
typedef short bf16x8 __attribute__((ext_vector_type(8)));
typedef float f32x4 __attribute__((ext_vector_type(4)));
typedef float f32x2 __attribute__((ext_vector_type(2)));

__device__ __forceinline__ bf16_t f2bf(float f) { unsigned u = __builtin_bit_cast(unsigned, f); return (bf16_t)((u + 0x7fffu + ((u >> 16) & 1u)) >> 16); }
__device__ __forceinline__ float bf2f(bf16_t b) { return __builtin_bit_cast(float, ((unsigned)b) << 16); }
__device__ __forceinline__ float sigmoidf_(float x) { return 1.0f / (1.0f + __expf(-x)); }
__device__ __forceinline__ float siluf_(float x) { return x * sigmoidf_(x); }
__device__ __forceinline__ float gelu_tanh(float x) { const float u = 0.7978845608028654f * (x + 0.044715f * x * x * x); return 0.5f * x * (1.0f + tanhf(u)); }
__device__ __forceinline__ float wave_sum(float v) {
#pragma unroll
    for (int o = 1; o < 64; o <<= 1) v += __shfl_xor(v, o);
    return v;
}

__device__ __forceinline__ int row_modidx(int r) { return r < ML ? r / SEQ : 4; }


#define LAS __attribute__((address_space(3)))
typedef unsigned u32x4 __attribute__((ext_vector_type(4)));
typedef unsigned u32x2 __attribute__((ext_vector_type(2)));
typedef int v4i_t __attribute__((ext_vector_type(4)));
typedef int v8i_t __attribute__((ext_vector_type(8)));
constexpr int NWAVES = 8, NTHREADS = 512;
constexpr int LDS_BYTES = 160 * 1024;

__device__ __forceinline__ unsigned cvt_pk_bf16(float lo, float hi) { unsigned r; asm volatile("v_cvt_pk_bf16_f32 %0, %1, %2" : "=v"(r) : "v"(lo), "v"(hi)); return r; }
__device__ __forceinline__ float fast_silu(float x) { return x * __builtin_amdgcn_rcpf(1.0f + __expf(-x)); }

constexpr float FP8_SW = 64.0f, FP8_SH = 8.0f;
constexpr int MD_SPLIT = 4, MD_NT0 = 6, MD_QMAX = 64;
namespace pg8 {
constexpr int BM = 256, BK = 64, HALF = 128, HTB = HALF * BK * 2, STAGE_BYTES = 8 * HTB, NXCD = 8, WGM = 4;
__device__ __forceinline__ int lds_byte(int r, int c) { const int st = (r >> 4) * 2 + (c >> 5), rr = r & 15, cc = c & 31, ob = rr * 64 + cc * 2; return st * 1024 + (ob ^ (((ob >> 9) & 1) << 5)); }
__device__ __forceinline__ void stage_rc(int b, int& R, int& C) { const int st = b / 1024, sb = b % 1024, swz = sb ^ (((sb >> 9) & 1) << 5); R = (st >> 1) * 16 + swz / 64; C = (st & 1) * 32 + (swz % 64) / 2; }
__device__ __forceinline__ int perm32(int rho) { const int n = rho >> 4, i = rho & 15; return 8 * (i >> 2) + 4 * n + (i & 3); }

constexpr int SC_OFF = -4096;
constexpr int IDX_OFF = -2048;
struct Unit { int pm, pn; const char* a; const char* b; int e, rb, cnt, nt, part, q; };

struct Order {
    int nM, nN, nwg, G, c;
    __device__ __forceinline__ void init(int nM_, int nN_, int G_, int c_) { nM = nM_; nN = nN_; nwg = nM * nN; G = G_; c = c_; }
    __device__ __forceinline__ bool lin(int i, int& pm, int& pn) const { const long L = (long)i * G + c; if (L >= nwg) return false; lin_abs((int)L, pm, pn); return true; }
    __device__ __forceinline__ bool lin_abs(int L, int& pm, int& pn) const {
        int wgid = L; { const int q = nwg / NXCD, r = nwg % NXCD, xcd = wgid % NXCD, off = wgid / NXCD; wgid = (xcd < r ? xcd * (q + 1) : r * (q + 1) + (xcd - r) * q) + off; }
        const int nig = WGM * nN, gid = wgid / nig, fm = gid * WGM, gsz = (nM - fm) < WGM ? (nM - fm) : WGM;
        pm = fm + ((wgid % nig) % gsz); pn = (wgid % nig) / gsz; return true;
    }
};
struct DenseSched {
    static constexpr bool GATHER = false; static constexpr bool VARNT = false;
    Order o; const char* A; const char* Bt; size_t tstep; int pm_off;
    __device__ __forceinline__ void init(const void* A_, const void* Bt_, int M, int N, int KB, int G, int c, int pm_off_ = 0) { o.init(M / BM, N / BM, G, c); A = (const char*)A_; Bt = (const char*)Bt_; tstep = (size_t)BM * KB; pm_off = pm_off_; }
    __device__ __forceinline__ bool next(int i, Unit& u) const { if (!o.lin(i, u.pm, u.pn)) return false; u.pm += pm_off; u.a = A + (size_t)u.pm * tstep; u.b = Bt + (size_t)u.pn * tstep; u.e = 0; u.rb = 0; u.cnt = 0; u.part = 0; return true; }
    __device__ __forceinline__ unsigned arow(const Unit&, int r) const { return (unsigned)r; }
    __device__ __forceinline__ void a_ready(const Unit&) const {}
    __device__ __forceinline__ void done(const Unit&) const {}
};

template <int MODE> struct AccT { typedef f32x4 type; };
template <> struct AccT<2> { typedef v4i_t type; };
template <int MODE, class Epi, class Sched>
__device__ __forceinline__ void gemm_phase(LAS unsigned char* lds, const int KB, const Sched& S, const Epi& E) {
    const int tid = threadIdx.x, wid = __builtin_amdgcn_readfirstlane(tid >> 6), lane = tid & 63, wr = wid >> 2, wc = wid & 3, fr = lane & 15, fq = lane >> 4;
    const int nt = KB / (BK * 2);
    int sR[2], sC[2]; unsigned voffB[2];
#pragma unroll
    for (int i = 0; i < 2; ++i) { stage_rc(tid * 16 + i * 8192, sR[i], sC[i]); const int Rb = Epi::PERM ? ((sR[i] & ~31) + perm32(sR[i] & 31)) : sR[i]; voffB[i] = (unsigned)(Rb * KB) + (unsigned)sC[i] * 2u; }
    const size_t kstep = (size_t)(BK * 2);
    const size_t hstep = (size_t)HALF * KB;
    const unsigned ldsw = (unsigned)wid * 1024u;
    const int aoff = lds_byte(wr * 64 + fr, fq * 8), boff = lds_byte(wc * 32 + fr, fq * 8);
#define PG8_SA(b, h) (((b) * 2 + (h)) * HTB)
#define PG8_SB(b, h) ((4 + (b) * 2 + (h)) * HTB)
#define PG8_STAGE(bufoff, gbase, voff) do { _Pragma("unroll") for (int _i = 0; _i < 2; ++_i) \
        __builtin_amdgcn_global_load_lds((const unsigned*)((const char*)(gbase) + (voff)[_i]), (LAS unsigned*)(lds + (bufoff) + ldsw + _i * 8192), 16, 0, 0); } while (0)
#define PG8_LDA(dst, b, h) do { _Pragma("unroll") for (int m = 0; m < 4; ++m) _Pragma("unroll") for (int k = 0; k < 2; ++k) dst[m][k] = *(const LAS bf16x8*)(lds + PG8_SA(b, h) + aoff + m * 2048 + k * 1024); } while (0)
#define PG8_LDB(dst, b, h) do { _Pragma("unroll") for (int n = 0; n < 2; ++n) _Pragma("unroll") for (int k = 0; k < 2; ++k) dst[n][k] = *(const LAS bf16x8*)(lds + PG8_SB(b, h) + boff + n * 2048 + k * 1024); } while (0)
#define PG8_MMA(ai, bj, At, Bt) do { __builtin_amdgcn_s_setprio(1); _Pragma("unroll") for (int m = 0; m < 4; ++m) _Pragma("unroll") for (int n = 0; n < 2; ++n) { \
        if constexpr (MODE == 1) { const v8i_t b8 = __builtin_shufflevector(__builtin_bit_cast(v4i_t, Bt[n][0]), __builtin_bit_cast(v4i_t, Bt[n][1]), 0, 1, 2, 3, 4, 5, 6, 7), a8 = __builtin_shufflevector(__builtin_bit_cast(v4i_t, At[m][0]), __builtin_bit_cast(v4i_t, At[m][1]), 0, 1, 2, 3, 4, 5, 6, 7); \
            asm volatile("v_mfma_scale_f32_16x16x128_f8f6f4 %0, %1, %2, %0, %3, %3 op_sel_hi:[0,0,0]" : "+v"(acc[ai][bj][m][n]) : "v"(b8), "v"(a8), "v"(fp8_one)); } \
        else if constexpr (MODE == 2) { _Pragma("unroll") for (int k = 0; k < 2; ++k) acc[ai][bj][m][n] = __builtin_amdgcn_mfma_i32_16x16x64_i8(__builtin_bit_cast(v4i_t, Bt[n][k]), __builtin_bit_cast(v4i_t, At[m][k]), acc[ai][bj][m][n], 0, 0, 0); } \
        else { _Pragma("unroll") for (int k = 0; k < 2; ++k) acc[ai][bj][m][n] = __builtin_amdgcn_mfma_f32_16x16x32_bf16(Bt[n][k], At[m][k], acc[ai][bj][m][n], 0, 0, 0); } } \
        __builtin_amdgcn_s_setprio(0); } while (0)
#define PG8_WAIT_V(n) asm volatile("s_waitcnt vmcnt(" #n ")" ::: "memory")
#define PG8_WAIT_L(n) asm volatile("s_waitcnt lgkmcnt(" #n ")" ::: "memory")
#define PG8_BAR __builtin_amdgcn_s_barrier()
#define PG8_SCHED __builtin_amdgcn_sched_barrier(0)
    const int fp8_one = 0x7f7f7f7f;
    Unit cur, nxt; int ui = 0;
    if (!S.next(0, cur)) return;
    typedef typename AccT<MODE>::type acc_t;
    acc_t acc[2][2][4][2];
#pragma unroll
    for (int a = 0; a < 2; ++a)
#pragma unroll
        for (int b = 0; b < 2; ++b)
#pragma unroll
            for (int m = 0; m < 4; ++m)
#pragma unroll
                for (int n = 0; n < 2; ++n) acc[a][b][m][n] = (acc_t){0, 0, 0, 0};
    bf16x8 At[4][2], B0[2][2], B1[2][2];
    unsigned vA0[2], vA1[2], vA0n[2], vA1n[2];
#pragma unroll
    for (int i = 0; i < 2; ++i) {
        vA0[i] = S.arow(cur, sR[i]) * (unsigned)KB + (unsigned)sC[i] * 2u;
        vA1[i] = S.arow(cur, HALF + sR[i]) * (unsigned)KB + (unsigned)sC[i] * 2u;
        vA0n[i] = vA0[i]; vA1n[i] = vA1[i];
    }
    const char* cA = cur.a; const char* cB = cur.b;
    S.a_ready(cur);
    PG8_STAGE(PG8_SB(0, 0), cB, voffB); PG8_STAGE(PG8_SB(0, 1), cB + hstep, voffB); PG8_STAGE(PG8_SA(0, 0), cA, vA0); PG8_STAGE(PG8_SA(0, 1), cA, vA1);
    if (wr == 1) PG8_BAR;
    PG8_WAIT_V(2); PG8_BAR;
    PG8_STAGE(PG8_SB(1, 0), cB + kstep, voffB); PG8_STAGE(PG8_SA(1, 0), cA + kstep, vA0); PG8_STAGE(PG8_SB(1, 1), cB + hstep + kstep, voffB);
    PG8_WAIT_V(6); PG8_BAR;
    for (;;) {
        const bool has_next = S.next(ui + 1, nxt);
        const char* nA = has_next ? nxt.a : cA; const char* nB = has_next ? nxt.b : cB;
        if constexpr (Epi::SCALES) { if (wid < 2) E.dma(cur, lds + SC_OFF + (ui & 1) * 2048, wid, lane); }
        if constexpr (Sched::GATHER) {
            if (has_next && wid == 0) S.idx_dma(nxt, lds + IDX_OFF + ((ui + 1) & 1) * 1024, lane);
        }
        const int nt_u = Sched::VARNT ? cur.nt : nt;
#pragma unroll 1
        for (int t = 0; t < nt_u; t += 2) {
            const bool last = (t == nt_u - 2);
            const char* a1 = cA + (size_t)(t + 1) * kstep;
            const char* a2 = last ? nA : cA + (size_t)(t + 2) * kstep; const char* b2 = last ? nB : cB + (size_t)(t + 2) * kstep;
            const char* a3 = a2 + kstep; const char* b3 = b2 + kstep;
            if constexpr (Sched::GATHER) {
                if (last && has_next) {
                    const LAS int* ix = (const LAS int*)(lds + IDX_OFF + ((ui + 1) & 1) * 1024);
#pragma unroll
                    for (int i = 0; i < 2; ++i) {
                        vA0n[i] = S.arow_lds(nxt, sR[i], ix) * (unsigned)KB + (unsigned)sC[i] * 2u;
                        vA1n[i] = S.arow_lds(nxt, HALF + sR[i], ix) * (unsigned)KB + (unsigned)sC[i] * 2u;
                    }
                }
            }
            unsigned w0[2], w1[2];
#pragma unroll
            for (int i = 0; i < 2; ++i) { w0[i] = (Sched::GATHER && last) ? vA0n[i] : vA0[i]; w1[i] = (Sched::GATHER && last) ? vA1n[i] : vA1[i]; }
            if (last && has_next) S.a_ready(nxt);
            PG8_LDB(B0, 0, 0); PG8_LDB(B1, 0, 1); PG8_SCHED; PG8_LDA(At, 0, 0); PG8_STAGE(PG8_SA(1, 1), a1, vA1);
            PG8_WAIT_V(8); PG8_WAIT_L(0); PG8_BAR; PG8_MMA(0, 0, At, B0); PG8_MMA(0, 1, At, B1); PG8_BAR; PG8_SCHED;
            PG8_LDA(At, 0, 1); PG8_STAGE(PG8_SB(0, 0), b2, voffB); PG8_STAGE(PG8_SB(0, 1), b2 + hstep, voffB); PG8_STAGE(PG8_SA(0, 0), a2, w0);
            PG8_WAIT_V(8); PG8_WAIT_L(0); PG8_BAR; PG8_MMA(1, 0, At, B0); PG8_MMA(1, 1, At, B1); PG8_BAR; PG8_SCHED;
            PG8_LDB(B0, 1, 0); PG8_LDB(B1, 1, 1); PG8_SCHED; PG8_LDA(At, 1, 0); PG8_STAGE(PG8_SA(0, 1), a2, w1);
            PG8_WAIT_V(8); PG8_WAIT_L(0); PG8_BAR; PG8_MMA(0, 0, At, B0); PG8_MMA(0, 1, At, B1); PG8_BAR; PG8_SCHED;
            PG8_LDA(At, 1, 1); PG8_STAGE(PG8_SB(1, 0), b3, voffB); PG8_STAGE(PG8_SB(1, 1), b3 + hstep, voffB); PG8_STAGE(PG8_SA(1, 0), a3, w0);
            PG8_WAIT_V(8); PG8_WAIT_L(0); PG8_BAR; PG8_MMA(1, 0, At, B0); PG8_MMA(1, 1, At, B1); PG8_BAR; PG8_SCHED;
        }
        if constexpr (MODE == 1) asm volatile("s_nop 15\n\ts_nop 15" ::: "memory");
        if (wr == 0) PG8_BAR;
        if constexpr (Epi::SCALES) E(acc, cur, wr, wc, fr, fq, (const LAS float*)(lds + SC_OFF + (ui & 1) * 2048)); else E(acc, cur, wr, wc, fr, fq);
        S.done(cur);
        if (!has_next) break;
#pragma unroll
        for (int a = 0; a < 2; ++a)
#pragma unroll
            for (int b = 0; b < 2; ++b)
#pragma unroll
                for (int m = 0; m < 4; ++m)
#pragma unroll
                    for (int n = 0; n < 2; ++n) acc[a][b][m][n] = (acc_t){0, 0, 0, 0};
        cur = nxt; cA = nA; cB = nB; ++ui;
#pragma unroll
        for (int i = 0; i < 2; ++i) { vA0[i] = vA0n[i]; vA1[i] = vA1n[i]; }
        if (wr == 1) PG8_BAR;
    }
    PG8_WAIT_V(0);
    PG8_BAR;
#undef PG8_SA
#undef PG8_SB
#undef PG8_STAGE
#undef PG8_LDA
#undef PG8_LDB
#undef PG8_MMA
#undef PG8_WAIT_V
#undef PG8_WAIT_L
#undef PG8_BAR
#undef PG8_SCHED
}

struct EpiBf16Store {
    static constexpr bool PERM = true; static constexpr bool SCALES = false;
    bf16_t* O; int ldo; float sc; bf16_t* YP;
    __device__ __forceinline__ void operator()(const f32x4 (&acc)[2][2][4][2], const Unit& u, int wr, int wc, int fr, int fq) const {
        const bool pt = u.part > 0;
        bf16_t* base = pt ? YP + ((size_t)(u.part - 1) * MD_QMAX + u.q) * (BM * BM) : O; const int ld = pt ? BM : ldo;
        const int row0 = (pt ? 0 : u.pm * BM) + wr * 64 + fr, col0 = (pt ? 0 : u.pn * BM) + wc * 32 + 8 * fq;
#pragma unroll
        for (int ai = 0; ai < 2; ++ai)
#pragma unroll
            for (int m = 0; m < 4; ++m) { bf16_t* rowp = base + (size_t)(row0 + ai * HALF + m * 16) * ld + col0;
#pragma unroll
                for (int bj = 0; bj < 2; ++bj) { const f32x4 v0 = acc[ai][bj][m][0] * sc, v1 = acc[ai][bj][m][1] * sc;
                    u32x4 w; w.x = cvt_pk_bf16(v0[0], v0[1]); w.y = cvt_pk_bf16(v0[2], v0[3]); w.z = cvt_pk_bf16(v1[0], v1[1]); w.w = cvt_pk_bf16(v1[2], v1[3]);
                    *(u32x4*)(rowp + bj * HALF) = w; } }
    }
};
struct EpiRes {
    static constexpr bool PERM = false; static constexpr bool SCALES = false;
    const float* xin_l; const float* xin_c; float* xout_l; float* xout_c; const float* gate; float sc; int nt_in;
    __device__ __forceinline__ void operator()(const f32x4 (&acc)[2][2][4][2], const Unit& u, int wr, int wc, int fr, int fq) const {
        const int trow = u.pm * BM; const bool isc = trow >= ML;
        const int modrow = isc ? 4 : trow / SEQ;
        const float* xi = isc ? xin_c : xin_l; float* xo = isc ? xout_c : xout_l;
        const int row0 = (isc ? trow - ML : trow) + wr * 64 + fr, col0 = u.pn * BM + wc * 32 + 4 * fq;
        const float* gp = gate + (size_t)modrow * 6144 + col0;
        f32x4 gv[2][2];
#pragma unroll
        for (int bj = 0; bj < 2; ++bj)
#pragma unroll
            for (int n = 0; n < 2; ++n) gv[bj][n] = *(const f32x4*)(gp + bj * HALF + n * 16) * sc;
#pragma unroll
        for (int ai = 0; ai < 2; ++ai) {
            f32x4 xv[4][2][2];
#pragma unroll
            for (int m = 0; m < 4; ++m) { const size_t off = (size_t)(row0 + ai * HALF + m * 16) * D + col0;
#pragma unroll
                for (int bj = 0; bj < 2; ++bj)
#pragma unroll
                    for (int n = 0; n < 2; ++n) xv[m][bj][n] = nt_in ? __builtin_nontemporal_load((const f32x4*)(xi + off + bj * HALF + n * 16)) : *(const f32x4*)(xi + off + bj * HALF + n * 16); }
            asm volatile("s_waitcnt vmcnt(0)" ::: "memory");
#pragma unroll
            for (int m = 0; m < 4; ++m) { const size_t off = (size_t)(row0 + ai * HALF + m * 16) * D + col0;
#pragma unroll
                for (int bj = 0; bj < 2; ++bj)
#pragma unroll
                    for (int n = 0; n < 2; ++n) *(f32x4*)(xo + off + bj * HALF + n * 16) = xv[m][bj][n] + gv[bj][n] * acc[ai][bj][m][n]; }
        }
    }
};
template <bool IN_F32>
struct EpiRes16 {
    static constexpr bool PERM = true; static constexpr bool SCALES = false;
    const float* xin_l; const float* xin_c; bf16_t* x16; const float* gate; float sc; int pad;
    __device__ __forceinline__ void operator()(const f32x4 (&acc)[2][2][4][2], const Unit& u, int wr, int wc, int fr, int fq) const {
        const int trow = u.pm * BM; const bool isc = trow >= ML;
        const int modrow = isc ? 4 : trow / SEQ;
        const int row0 = trow + wr * 64 + fr, col0 = u.pn * BM + wc * 32 + 8 * fq;
        const float* gp = gate + (size_t)modrow * 6144 + col0;
        f32x4 gv[2][2];
#pragma unroll
        for (int bj = 0; bj < 2; ++bj)
#pragma unroll
            for (int n = 0; n < 2; ++n) gv[bj][n] = *(const f32x4*)(gp + bj * HALF + n * 4) * sc;
        if constexpr (IN_F32) {
            const float* xi = isc ? xin_c : xin_l; const int rb = isc ? row0 - ML : row0;
#pragma unroll
            for (int ai = 0; ai < 2; ++ai) {
                f32x4 xv[4][2][2];
#pragma unroll
                for (int m = 0; m < 4; ++m) { const size_t off = (size_t)(rb + ai * HALF + m * 16) * D + col0;
#pragma unroll
                    for (int bj = 0; bj < 2; ++bj)
#pragma unroll
                        for (int n = 0; n < 2; ++n) xv[m][bj][n] = __builtin_nontemporal_load((const f32x4*)(xi + off + bj * HALF + n * 4)); }
                asm volatile("s_waitcnt vmcnt(0)" ::: "memory");
#pragma unroll
                for (int m = 0; m < 4; ++m) { const size_t off = (size_t)(row0 + ai * HALF + m * 16) * D + col0;
#pragma unroll
                    for (int bj = 0; bj < 2; ++bj) { const f32x4 o0 = xv[m][bj][0] + gv[bj][0] * acc[ai][bj][m][0], o1 = xv[m][bj][1] + gv[bj][1] * acc[ai][bj][m][1];
                        u32x4 w; w.x = cvt_pk_bf16(o0[0], o0[1]); w.y = cvt_pk_bf16(o0[2], o0[3]); w.z = cvt_pk_bf16(o1[0], o1[1]); w.w = cvt_pk_bf16(o1[2], o1[3]);
                        *(u32x4*)(x16 + off + bj * HALF) = w; } }
            }
        } else {
#pragma unroll
            for (int ai = 0; ai < 2; ++ai) {
                u32x4 xr[4][2];
#pragma unroll
                for (int m = 0; m < 4; ++m) { const size_t off = (size_t)(row0 + ai * HALF + m * 16) * D + col0;
#pragma unroll
                    for (int bj = 0; bj < 2; ++bj) xr[m][bj] = *(const u32x4*)(x16 + off + bj * HALF); }
                asm volatile("s_waitcnt vmcnt(0)" ::: "memory");
#pragma unroll
                for (int m = 0; m < 4; ++m) { const size_t off = (size_t)(row0 + ai * HALF + m * 16) * D + col0;
#pragma unroll
                    for (int bj = 0; bj < 2; ++bj) { const u32x4 r = xr[m][bj]; f32x4 x0, x1;
                        x0[0] = __builtin_bit_cast(float, r.x << 16); x0[1] = __builtin_bit_cast(float, r.x & 0xffff0000u); x0[2] = __builtin_bit_cast(float, r.y << 16); x0[3] = __builtin_bit_cast(float, r.y & 0xffff0000u);
                        x1[0] = __builtin_bit_cast(float, r.z << 16); x1[1] = __builtin_bit_cast(float, r.z & 0xffff0000u); x1[2] = __builtin_bit_cast(float, r.w << 16); x1[3] = __builtin_bit_cast(float, r.w & 0xffff0000u);
                        const f32x4 o0 = x0 + gv[bj][0] * acc[ai][bj][m][0], o1 = x1 + gv[bj][1] * acc[ai][bj][m][1];
                        u32x4 w; w.x = cvt_pk_bf16(o0[0], o0[1]); w.y = cvt_pk_bf16(o0[2], o0[3]); w.z = cvt_pk_bf16(o1[0], o1[1]); w.w = cvt_pk_bf16(o1[2], o1[3]);
                        *(u32x4*)(x16 + off + bj * HALF) = w; } }
            }
        }
    }
};
struct EpiSwiglu {
    static constexpr bool PERM = true; static constexpr bool SCALES = false;
    bf16_t* H; int ldo; float sin;
    __device__ __forceinline__ void operator()(const f32x4 (&acc)[2][2][4][2], const Unit& u, int wr, int wc, int fr, int fq) const {
        const int row0 = u.pm * BM + wr * 64 + fr, col0 = u.pn * HALF + wc * 32 + 8 * fq;
#pragma unroll
        for (int ai = 0; ai < 2; ++ai)
#pragma unroll
            for (int m = 0; m < 4; ++m) { bf16_t* rowp = H + (size_t)(row0 + ai * HALF + m * 16) * ldo + col0;
                float o[8];
#pragma unroll
                for (int n = 0; n < 2; ++n)
#pragma unroll
                    for (int j = 0; j < 4; j += 2) {
                        const f32x2 G = {acc[ai][0][m][n][j], acc[ai][0][m][n][j + 1]}, U = {acc[ai][1][m][n][j], acc[ai][1][m][n][j + 1]};
                        const f32x2 Ee = G * (-1.4426950408889634f * sin); f32x2 T = {__builtin_amdgcn_exp2f(Ee.x), __builtin_amdgcn_exp2f(Ee.y)}; T = T + 1.0f;
                        const f32x2 R = {__builtin_amdgcn_rcpf(T.x), __builtin_amdgcn_rcpf(T.y)};
                        const f32x2 Q = (G * U) * (R * (sin * sin));
                        o[n * 4 + j] = Q.x; o[n * 4 + j + 1] = Q.y; }
                u32x4 w; w.x = cvt_pk_bf16(o[0], o[1]); w.y = cvt_pk_bf16(o[2], o[3]); w.z = cvt_pk_bf16(o[4], o[5]); w.w = cvt_pk_bf16(o[6], o[7]);
                *(u32x4*)rowp = w; }
    }
};
__device__ __forceinline__ unsigned pack4_fp8(float a, float b, float c, float d) {
    int p = 0; p = __builtin_amdgcn_cvt_pk_fp8_f32(a, b, p, false); p = __builtin_amdgcn_cvt_pk_fp8_f32(c, d, p, true); return (unsigned)p; }
struct EpiSwiglu8 {
    static constexpr bool PERM = true; static constexpr bool SCALES = false;
    unsigned char* H; int ldo; float sin, sout;
    __device__ __forceinline__ void operator()(const f32x4 (&acc)[2][2][4][2], const Unit& u, int wr, int wc, int fr, int fq) const {
        const int row0 = u.pm * BM + wr * 64 + fr, col0 = u.pn * HALF + wc * 32 + 8 * fq;
        const float c1 = -1.4426950408889634f * sin, c2 = sin * sin * sout;
#pragma unroll
        for (int ai = 0; ai < 2; ++ai)
#pragma unroll
            for (int m = 0; m < 4; ++m) { unsigned char* rowp = H + (size_t)(row0 + ai * HALF + m * 16) * ldo + col0;
                float o[8];
#pragma unroll
                for (int n = 0; n < 2; ++n)
#pragma unroll
                    for (int j = 0; j < 4; j += 2) {
                        const f32x2 G = {acc[ai][0][m][n][j], acc[ai][0][m][n][j + 1]}, U = {acc[ai][1][m][n][j], acc[ai][1][m][n][j + 1]};
                        const f32x2 Ee = G * c1; f32x2 T = {__builtin_amdgcn_exp2f(Ee.x), __builtin_amdgcn_exp2f(Ee.y)}; T = T + 1.0f;
                        const f32x2 R = {__builtin_amdgcn_rcpf(T.x), __builtin_amdgcn_rcpf(T.y)};
                        const f32x2 Q = (G * U) * (R * c2);
                        o[n * 4 + j] = __builtin_amdgcn_fmed3f(Q.x, -448.f, 448.f); o[n * 4 + j + 1] = __builtin_amdgcn_fmed3f(Q.y, -448.f, 448.f); }
                u32x2 w; w.x = pack4_fp8(o[0], o[1], o[2], o[3]); w.y = pack4_fp8(o[4], o[5], o[6], o[7]);
                *(u32x2*)rowp = w; }
    }
};
template <bool F8>
struct EpiSwigluI8 {
    static constexpr bool PERM = true; static constexpr bool SCALES = true;
    void* H; int ldo; const float* rs; const float* cs;
    __device__ __forceinline__ void dma(const Unit& u, LAS unsigned char* slot, int wid, int lane) const {
        const float* src = wid == 0 ? rs + (size_t)u.pm * BM + 4 * lane : cs + (size_t)u.pn * BM + 4 * lane;
        __builtin_amdgcn_global_load_lds((const unsigned*)src, (LAS unsigned*)(slot + wid * 1024), 16, 0, 0); }
    __device__ __forceinline__ void operator()(const v4i_t (&acc)[2][2][4][2], const Unit& u, int wr, int wc, int fr, int fq, const LAS float* sl) const {
        const int row0 = u.pm * BM + wr * 64 + fr, col0 = u.pn * HALF + wc * 32 + 8 * fq, cc0 = u.pn * BM + wc * 32 + 8 * fq;
        const LAS float* cl = sl + 256 + wc * 32 + 8 * fq; const f32x4 cg0 = *(const LAS f32x4*)cl, cg1 = *(const LAS f32x4*)(cl + 4), cu0 = *(const LAS f32x4*)(cl + HALF), cu1 = *(const LAS f32x4*)(cl + HALF + 4);
        f32x2 ce[2][2], cq[2][2];
#pragma unroll
        for (int n = 0; n < 2; ++n)
#pragma unroll
            for (int jp = 0; jp < 2; ++jp) { const f32x2 g2 = {n ? cg1[2 * jp] : cg0[2 * jp], n ? cg1[2 * jp + 1] : cg0[2 * jp + 1]}, u2 = {n ? cu1[2 * jp] : cu0[2 * jp], n ? cu1[2 * jp + 1] : cu0[2 * jp + 1]};
                ce[n][jp] = g2 * -1.4426950408889634f; cq[n][jp] = g2 * u2; }
#pragma unroll
        for (int ai = 0; ai < 2; ++ai)
#pragma unroll
            for (int m = 0; m < 4; ++m) { const int row = row0 + ai * HALF + m * 16; const float r = sl[wr * 64 + fr + ai * HALF + m * 16], r2 = F8 ? r * r * FP8_SH : r * r;
                float o[8];
#pragma unroll
                for (int n = 0; n < 2; ++n)
#pragma unroll
                    for (int jp = 0; jp < 2; ++jp) {
                        const f32x2 G = {(float)acc[ai][0][m][n][2 * jp], (float)acc[ai][0][m][n][2 * jp + 1]}, U = {(float)acc[ai][1][m][n][2 * jp], (float)acc[ai][1][m][n][2 * jp + 1]};
                        const f32x2 Ee = G * (ce[n][jp] * r); f32x2 T = {__builtin_amdgcn_exp2f(Ee.x), __builtin_amdgcn_exp2f(Ee.y)}; T = T + 1.0f;
                        const f32x2 R = {__builtin_amdgcn_rcpf(T.x), __builtin_amdgcn_rcpf(T.y)};
                        const f32x2 Q = (G * U) * (R * (cq[n][jp] * r2));
                        o[n * 4 + 2 * jp] = Q.x; o[n * 4 + 2 * jp + 1] = Q.y; }
                if constexpr (F8) {
#pragma unroll
                    for (int j = 0; j < 8; ++j) o[j] = __builtin_amdgcn_fmed3f(o[j], -448.f, 448.f);
                    u32x2 w; w.x = pack4_fp8(o[0], o[1], o[2], o[3]); w.y = pack4_fp8(o[4], o[5], o[6], o[7]);
                    *(u32x2*)((unsigned char*)H + (size_t)row * ldo + col0) = w;
                } else {
                    u32x4 w; w.x = cvt_pk_bf16(o[0], o[1]); w.y = cvt_pk_bf16(o[2], o[3]); w.z = cvt_pk_bf16(o[4], o[5]); w.w = cvt_pk_bf16(o[6], o[7]);
                    *(u32x4*)((bf16_t*)H + (size_t)row * ldo + col0) = w; } }
    }
};
struct EpiProjFused {
    static constexpr bool PERM = true; static constexpr bool SCALES = false;
    bf16_t* O;
    __device__ __forceinline__ void operator()(const f32x4 (&acc)[2][2][4][2], const Unit& u, int wr, int wc, int fr, int fq) const {
        const int row0 = u.pm * BM + wr * 64 + fr;
        if (u.pn < 4) {
            const int col0 = (u.pn < 2 ? P_GLU : P_V) + (u.pn & 1) * HALF + wc * 32 + 8 * fq;
#pragma unroll
            for (int ai = 0; ai < 2; ++ai)
#pragma unroll
                for (int m = 0; m < 4; ++m) { bf16_t* rowp = O + (size_t)(row0 + ai * HALF + m * 16) * PW + col0;
                    float o[8];
#pragma unroll
                    for (int n = 0; n < 2; ++n)
#pragma unroll
                        for (int j = 0; j < 4; j += 2) { const f32x2 a = {acc[ai][0][m][n][j], acc[ai][0][m][n][j + 1]}, b = {acc[ai][1][m][n][j], acc[ai][1][m][n][j + 1]};
                            f32x2 q;
                            if (u.pn < 2) { const f32x2 e = b * -1.4426950408889634f; f32x2 t = {__builtin_amdgcn_exp2f(e.x), __builtin_amdgcn_exp2f(e.y)}; t = t + 1.0f;
                                const f32x2 r = {__builtin_amdgcn_rcpf(t.x), __builtin_amdgcn_rcpf(t.y)}; q = a * r; }
                            else q = a * b;
                            o[n * 4 + j] = q.x; o[n * 4 + j + 1] = q.y; }
                    u32x4 w; w.x = cvt_pk_bf16(o[0], o[1]); w.y = cvt_pk_bf16(o[2], o[3]); w.z = cvt_pk_bf16(o[4], o[5]); w.w = cvt_pk_bf16(o[6], o[7]);
                    *(u32x4*)rowp = w; }
        } else {
            const int col0 = P_SBG + (u.pn - 4) * BM + wc * 32 + 8 * fq; const bool gl = u.pn >= 7;
#pragma unroll
            for (int ai = 0; ai < 2; ++ai)
#pragma unroll
                for (int m = 0; m < 4; ++m) { bf16_t* rowp = O + (size_t)(row0 + ai * HALF + m * 16) * PW + col0;
#pragma unroll
                    for (int bj = 0; bj < 2; ++bj) { f32x4 v0 = acc[ai][bj][m][0], v1 = acc[ai][bj][m][1];
                        if (gl) {
#pragma unroll
                            for (int j = 0; j < 4; ++j) { const f32x2 x = {v0[j], v1[j]};
                                const f32x2 e = x * ((x * x) * (-2.302208198f * 0.044715f) + -2.302208198f); f32x2 t = {__builtin_amdgcn_exp2f(e.x), __builtin_amdgcn_exp2f(e.y)}; t = t + 1.0f;
                                const f32x2 r = {__builtin_amdgcn_rcpf(t.x), __builtin_amdgcn_rcpf(t.y)}, q = x * r; v0[j] = q.x; v1[j] = q.y; } }
                        u32x4 w; w.x = cvt_pk_bf16(v0[0], v0[1]); w.y = cvt_pk_bf16(v0[2], v0[3]); w.z = cvt_pk_bf16(v1[0], v1[1]); w.w = cvt_pk_bf16(v1[2], v1[3]);
                        *(u32x4*)(rowp + bj * HALF) = w; } }
        }
    }
};
struct EpiProjFusedI8 {
    static constexpr bool PERM = true; static constexpr bool SCALES = true;
    bf16_t* O; const float* rs; const float* cs;
    __device__ __forceinline__ void dma(const Unit& u, LAS unsigned char* slot, int wid, int lane) const {
        const float* src = wid == 0 ? rs + (size_t)u.pm * BM + 4 * lane : cs + (size_t)u.pn * BM + 4 * lane;
        __builtin_amdgcn_global_load_lds((const unsigned*)src, (LAS unsigned*)(slot + wid * 1024), 16, 0, 0); }
    __device__ __forceinline__ void operator()(const v4i_t (&acc)[2][2][4][2], const Unit& u, int wr, int wc, int fr, int fq, const LAS float* sl) const {
        const int row0 = u.pm * BM + wr * 64 + fr, cc0 = u.pn * BM + wc * 32 + 8 * fq;
        const LAS float* cl = sl + 256 + wc * 32 + 8 * fq; const f32x4 ca0 = *(const LAS f32x4*)cl, ca1 = *(const LAS f32x4*)(cl + 4), cb0 = *(const LAS f32x4*)(cl + HALF), cb1 = *(const LAS f32x4*)(cl + HALF + 4);
        f32x2 ca[2][2], cb[2][2];
#pragma unroll
        for (int jp = 0; jp < 2; ++jp) { ca[0][jp] = (f32x2){ca0[2 * jp], ca0[2 * jp + 1]}; ca[1][jp] = (f32x2){ca1[2 * jp], ca1[2 * jp + 1]}; cb[0][jp] = (f32x2){cb0[2 * jp], cb0[2 * jp + 1]}; cb[1][jp] = (f32x2){cb1[2 * jp], cb1[2 * jp + 1]}; }
        if (u.pn < 4) {
            const int col0 = (u.pn < 2 ? P_GLU : P_V) + (u.pn & 1) * HALF + wc * 32 + 8 * fq;
#pragma unroll
            for (int ai = 0; ai < 2; ++ai)
#pragma unroll
                for (int m = 0; m < 4; ++m) { const int row = row0 + ai * HALF + m * 16; bf16_t* rowp = O + (size_t)row * PW + col0; const float r = sl[wr * 64 + fr + ai * HALF + m * 16];
                    float o[8];
#pragma unroll
                    for (int n = 0; n < 2; ++n)
#pragma unroll
                        for (int jp = 0; jp < 2; ++jp) {
                            const f32x2 a = (f32x2){(float)acc[ai][0][m][n][2 * jp], (float)acc[ai][0][m][n][2 * jp + 1]} * (ca[n][jp] * r);
                            const f32x2 b = (f32x2){(float)acc[ai][1][m][n][2 * jp], (float)acc[ai][1][m][n][2 * jp + 1]} * (cb[n][jp] * r);
                            f32x2 q;
                            if (u.pn < 2) { const f32x2 e = b * -1.4426950408889634f; f32x2 t = {__builtin_amdgcn_exp2f(e.x), __builtin_amdgcn_exp2f(e.y)}; t = t + 1.0f;
                                const f32x2 rr = {__builtin_amdgcn_rcpf(t.x), __builtin_amdgcn_rcpf(t.y)}; q = a * rr; }
                            else q = a * b;
                            o[n * 4 + 2 * jp] = q.x; o[n * 4 + 2 * jp + 1] = q.y; }
                    u32x4 w; w.x = cvt_pk_bf16(o[0], o[1]); w.y = cvt_pk_bf16(o[2], o[3]); w.z = cvt_pk_bf16(o[4], o[5]); w.w = cvt_pk_bf16(o[6], o[7]);
                    *(u32x4*)rowp = w; }
        } else {
            const int col0 = P_SBG + (u.pn - 4) * BM + wc * 32 + 8 * fq; const bool gl = u.pn >= 7;
#pragma unroll
            for (int ai = 0; ai < 2; ++ai)
#pragma unroll
                for (int m = 0; m < 4; ++m) { const int row = row0 + ai * HALF + m * 16; bf16_t* rowp = O + (size_t)row * PW + col0; const float r = sl[wr * 64 + fr + ai * HALF + m * 16];
#pragma unroll
                    for (int bj = 0; bj < 2; ++bj) { float o[8];
#pragma unroll
                        for (int n = 0; n < 2; ++n)
#pragma unroll
                            for (int jp = 0; jp < 2; ++jp) {
                                f32x2 x = (f32x2){(float)acc[ai][bj][m][n][2 * jp], (float)acc[ai][bj][m][n][2 * jp + 1]} * ((bj ? cb[n][jp] : ca[n][jp]) * r);
                                if (gl) { const f32x2 e = x * ((x * x) * (-2.302208198f * 0.044715f) + -2.302208198f); f32x2 t = {__builtin_amdgcn_exp2f(e.x), __builtin_amdgcn_exp2f(e.y)}; t = t + 1.0f;
                                    const f32x2 rr = {__builtin_amdgcn_rcpf(t.x), __builtin_amdgcn_rcpf(t.y)}; x = x * rr; }
                                o[n * 4 + 2 * jp] = x.x; o[n * 4 + 2 * jp + 1] = x.y; }
                        u32x4 w; w.x = cvt_pk_bf16(o[0], o[1]); w.y = cvt_pk_bf16(o[2], o[3]); w.z = cvt_pk_bf16(o[4], o[5]); w.w = cvt_pk_bf16(o[6], o[7]);
                        *(u32x4*)(rowp + bj * HALF) = w; } }
        }
    }
};
}

constexpr size_t MiB = 1u << 20;
constexpr size_t WS_CTL = 0;
constexpr size_t WS_MODV = 1 * MiB;
constexpr size_t WS_LRUW = 2 * MiB;
constexpr size_t WS_GCONST = 2 * MiB + 512 * 1024;
constexpr size_t WS_XCTX = 4 * MiB;
constexpr size_t WS_SUMM = 8 * MiB;
constexpr size_t WS_CR = 13 * MiB;
constexpr size_t WS_WIN = 16 * MiB;
constexpr size_t WS_WOUT = 25 * MiB;
constexpr bool WIN8 = false;
constexpr bool WINI8_L0 = true, WINI8_L1 = true;
constexpr bool DENSE_UPI8 = true;
constexpr bool DENSE_UP8 = false, DENSE_DOWN8 = true;
constexpr size_t WS_W13 = 29 * MiB;
constexpr size_t WS_W2 = 40 * MiB;
constexpr size_t WS_ROUTE = 45 * MiB + 512 * 1024;
constexpr size_t WS_WMOE = 48 * MiB;
constexpr size_t WS_HBUF = 114 * MiB;
constexpr size_t WS_BIG = 180 * MiB;
constexpr size_t WS_X16 = WS_BIG + 250 * MiB;
constexpr size_t WS_W13Q = WS_BIG + 317 * MiB;
constexpr size_t WS_W13QS = WS_W13Q + (size_t)2 * DFF * D;
constexpr size_t WS_RS = WS_W13QS + 64 * 1024;
constexpr size_t WS_YP = 16 * MiB;
constexpr size_t WS_WINQ = WS_BIG + 324 * MiB;
constexpr size_t WS_WINQS = WS_BIG + 329 * MiB;
constexpr size_t WS_RS1 = WS_WINQS + 64 * 1024;

__device__ __forceinline__ unsigned pk2(float lo, float hi) { return (unsigned)f2bf(lo) | ((unsigned)f2bf(hi) << 16); }
__device__ __forceinline__ int win_row(int n0) {
    if (n0 < 256) return 256 * (n0 >> 7) + (n0 & 127);
    if (n0 < 512) { const int q = n0 - 256; return 256 * (q >> 7) + 128 + (q & 127); }
    if (n0 < 768) return 1024 + (n0 - 512);
    if (n0 < 1024) { const int q = n0 - 768; return 512 + 256 * (q >> 7) + (q & 127); }
    if (n0 < 1280) { const int q = n0 - 1024; return 512 + 256 * (q >> 7) + 128 + (q & 127); }
    return n0;
}
__device__ __forceinline__ void transpose_item(const float* W, int K, int N, bf16_t* WT, int mode, LAS float* scr, int item, int lane) {
    const int nblk = N / 32, kb = item / nblk, nb = item % nblk, k0 = 64 * kb, n0 = 32 * nb;
    const int drow0 = (mode == 0) ? n0 : (mode == 3 ? win_row(n0) : (256 * (n0 >> 7) + (n0 & 127) + (mode == 2 ? 128 : 0)));
#pragma unroll 8
    for (int i = 0; i < 32; ++i) { const int kk = 2 * i + (lane >> 5); scr[kk * 33 + (lane & 31)] = __builtin_nontemporal_load(W + (size_t)(k0 + kk) * N + n0 + (lane & 31)); }
    asm volatile("s_waitcnt lgkmcnt(0)" ::: "memory");
    const int c = lane & 7;
#pragma unroll
    for (int j = 0; j < 4; ++j) { const int n = (lane >> 3) + 8 * j; const LAS float* s = scr + (8 * c) * 33 + n;
        u32x4 o; o.x = pk2(s[0 * 33], s[1 * 33]); o.y = pk2(s[2 * 33], s[3 * 33]); o.z = pk2(s[4 * 33], s[5 * 33]); o.w = pk2(s[6 * 33], s[7 * 33]);
        *(u32x4*)(WT + (size_t)(drow0 + n) * K + k0 + 8 * c) = o; }
    asm volatile("s_waitcnt lgkmcnt(0)" ::: "memory");
}


constexpr int XS = 68;
constexpr int NPOS = 132;
constexpr int CW_BYTES = 16896;
constexpr int CWL_OFF = NWAVES * CW_BYTES;
constexpr float LOG2E = 1.4426950408889634f;
struct MixArgs {
    const bf16_t* proj; bf16_t* ybuf;
    const float* conf_w; const float* conf_b; const float* ln_g; const float* ln_b;
    const float* sconv_w; const float* g_mix;
    const float* cw; const float* cb; const bf16_t* gwt; const float* gconst;
    float* SA; float* SB; float* CR;
    unsigned* AB;
};
__device__ __forceinline__ void unpack8(const u32x4 r, float (&v)[8]) {
    v[0] = __builtin_bit_cast(float, r.x << 16); v[1] = __builtin_bit_cast(float, r.x & 0xffff0000u);
    v[2] = __builtin_bit_cast(float, r.y << 16); v[3] = __builtin_bit_cast(float, r.y & 0xffff0000u);
    v[4] = __builtin_bit_cast(float, r.z << 16); v[5] = __builtin_bit_cast(float, r.z & 0xffff0000u);
    v[6] = __builtin_bit_cast(float, r.w << 16); v[7] = __builtin_bit_cast(float, r.w & 0xffff0000u);
}
__device__ __forceinline__ float fast_exp2(float x) { return __builtin_amdgcn_exp2f(x); }
__device__ __forceinline__ float fast_rcp(float x) { return __builtin_amdgcn_rcpf(x); }
__device__ __forceinline__ float fast_sigmoid(float x) { return fast_rcp(1.0f + fast_exp2(-LOG2E * x)); }
__device__ __forceinline__ float fast_gelu_tanh(float x) { return x * fast_sigmoid(1.5957691216057308f * (x + 0.044715f * x * x * x)); }

__device__ __forceinline__ void a_unit(LAS unsigned char* lds, int tid, int ua, const MixArgs& m) {
    LAS float* g = (LAS float*)lds;
    const int r0 = ua * 32;
    int lo, hi; if (r0 < ML) { lo = (r0 / GW) * GW; hi = lo + GW; } else { lo = ML + ((r0 - ML) / CTXL) * CTXL; hi = lo + CTXL; }
    {
        u32x4 rv[4];
#pragma unroll
        for (int i = 0; i < 4; ++i) {
            const int it = tid + NTHREADS * i, sr = it >> 5, cg = it & 31; int s = r0 - 15 + sr; s = s < lo ? lo : (s >= hi ? hi - 1 : s);
            rv[i] = *(const u32x4*)(m.proj + (size_t)s * PW + P_GLU + 8 * cg);
        }
#pragma unroll
        for (int i = 0; i < 4; ++i) {
            const int it = tid + NTHREADS * i, sr = it >> 5, cg = it & 31, s = r0 - 15 + sr;
            if (it < 62 * 32) {
                float av[8], o[8]; unpack8(rv[i], av);
                const bool ok = (s >= lo && s < hi);
#pragma unroll
                for (int j = 0; j < 8; ++j) o[j] = ok ? av[j] : 0.f;
                *(LAS f32x4*)(g + sr * 256 + 8 * cg) = (f32x4){o[0], o[1], o[2], o[3]};
                *(LAS f32x4*)(g + sr * 256 + 8 * cg + 4) = (f32x4){o[4], o[5], o[6], o[7]};
            }
        }
    }
    const int c = tid & 255, half = tid >> 8;
    float acc[16];
    {
        float w[CONFK];
#pragma unroll
        for (int k = 0; k < CONFK; ++k) w[k] = m.conf_w[k * 256 + c];
        const float cb = m.conf_b[c];
        f32x2 wp[CONFK + 1];
#pragma unroll
        for (int k = 0; k <= CONFK; ++k) wp[k] = (f32x2){k < CONFK ? w[k] : 0.f, k > 0 ? w[k - 1] : 0.f};
        __syncthreads();
        f32x2 ac2[8];
#pragma unroll
        for (int t = 0; t < 8; ++t) ac2[t] = (f32x2){cb, cb};
#pragma unroll
        for (int j = 0; j < 46; ++j) {
            const float gv = g[(half * 16 + j) * 256 + c];
#pragma unroll
            for (int tp = 0; tp < 8; ++tp) { const int k = j - 2 * tp; if (k >= 0 && k <= CONFK) ac2[tp] = wp[k] * gv + ac2[tp]; }
        }
#pragma unroll
        for (int t = 0; t < 8; ++t) { acc[2 * t] = ac2[t].x; acc[2 * t + 1] = ac2[t].y; }
    }
    __syncthreads();
#pragma unroll
    for (int t = 0; t < 16; ++t) g[(half * 16 + t) * 256 + c] = acc[t];
    __syncthreads();
    {
        const int wave = tid >> 6, lane = tid & 63;
        const f32x4 lg = *(const f32x4*)(m.ln_g + 4 * lane), lb = *(const f32x4*)(m.ln_b + 4 * lane), gm = *(const f32x4*)(m.g_mix + 4 * lane);
#pragma unroll
        for (int q = 0; q < 4; ++q) {
            const int t = wave * 4 + q;
            const f32x4 u4 = *(const LAS f32x4*)(g + t * 256 + 4 * lane);
            const float mean = wave_sum((u4[0] + u4[1]) + (u4[2] + u4[3])) * (1.0f / 256.0f);
            const f32x4 d = u4 - mean;
            const float var = wave_sum((d[0] * d[0] + d[1] * d[1]) + (d[2] * d[2] + d[3] * d[3])) * (1.0f / 256.0f);
            const float rstd = rsqrtf(var + EPS);
            f32x4 ya;
#pragma unroll
            for (int j = 0; j < 4; ++j) { const float ln = d[j] * rstd * lg[j] + lb[j]; ya[j] = ln * fast_sigmoid(ln); }
            float hs = (ya[0] * ya[0] + ya[1] * ya[1]) + (ya[2] * ya[2] + ya[3] * ya[3]);
            hs += __shfl_xor(hs, 1); hs += __shfl_xor(hs, 2); hs += __shfl_xor(hs, 4); hs += __shfl_xor(hs, 8);
            const float hr = rsqrtf(hs * (1.0f / 64.0f) + EPS);
            u32x2 o; o.x = cvt_pk_bf16(ya[0] * hr * gm[0], ya[1] * hr * gm[1]); o.y = cvt_pk_bf16(ya[2] * hr * gm[2], ya[3] * hr * gm[3]);
            *(u32x2*)(m.ybuf + (size_t)(r0 + t) * D + 4 * lane) = o;
        }
    }
    __syncthreads();
}
__device__ __forceinline__ void b_unit(int tid, int ub, const MixArgs& m) {
    const int r0 = ub * 64;
#pragma unroll
    for (int i = 0; i < 4; ++i) {
        const int it = tid + NTHREADS * i, r = r0 + (it >> 5), cg = it & 31;
        int lo, hi, step; if (r < ML) { lo = (r / SEQ) * SEQ; hi = lo + SEQ; step = GW; } else { lo = ML + ((r - ML) / CTXL) * CTXL; hi = lo + CTXL; step = 1; }
        u32x4 rc[3];
#pragma unroll
        for (int k = 0; k < 3; ++k) { int s = r + (k - 1) * step; s = (s >= lo && s < hi) ? s : r; rc[k] = *(const u32x4*)(m.proj + (size_t)s * PW + P_V + 8 * cg); }
        const u32x4 rb = *(const u32x4*)(m.proj + (size_t)r * PW + P_SBG + 8 * cg);
        float acc[8];
#pragma unroll
        for (int j = 0; j < 8; ++j) acc[j] = 0.f;
#pragma unroll
        for (int k = 0; k < 3; ++k) {
            const int s = r + (k - 1) * step; const float ok = (s >= lo && s < hi) ? 1.f : 0.f;
            float cv[8]; unpack8(rc[k], cv);
            const f32x4 w0 = *(const f32x4*)(m.sconv_w + k * 256 + 8 * cg) * ok, w1 = *(const f32x4*)(m.sconv_w + k * 256 + 8 * cg + 4) * ok;
#pragma unroll
            for (int j = 0; j < 4; ++j) { acc[j] += w0[j] * cv[j]; acc[4 + j] += w1[j] * cv[4 + j]; }
        }
        float bg[8]; unpack8(rb, bg);
        float ss = 0.f;
#pragma unroll
        for (int j = 0; j < 8; ++j) { acc[j] *= bg[j]; ss += acc[j] * acc[j]; }
        ss += __shfl_xor(ss, 1); ss += __shfl_xor(ss, 2); ss += __shfl_xor(ss, 4);
        const float hr = rsqrtf(ss * (1.0f / 64.0f) + EPS);
        const f32x4 g0 = *(const f32x4*)(m.g_mix + 256 + 8 * cg), g1 = *(const f32x4*)(m.g_mix + 256 + 8 * cg + 4);
        u32x4 o; o.x = cvt_pk_bf16(acc[0] * hr * g0[0], acc[1] * hr * g0[1]); o.y = cvt_pk_bf16(acc[2] * hr * g0[2], acc[3] * hr * g0[3]);
        o.z = cvt_pk_bf16(acc[4] * hr * g1[0], acc[5] * hr * g1[1]); o.w = cvt_pk_bf16(acc[6] * hr * g1[2], acc[7] * hr * g1[3]);
        *(u32x4*)(m.ybuf + (size_t)r * D + 256 + 8 * cg) = o;
    }
}
__device__ __forceinline__ void c_prep(LAS unsigned char* lds, int tid, const MixArgs& m) {
    LAS float* cwl = (LAS float*)(lds + CWL_OFF);
    for (int i = tid; i < 5 * LRU; i += NTHREADS) cwl[i] = i < 4 * LRU ? m.cw[i] : m.cb[i - 4 * LRU];
    __syncthreads();
}
__device__ __forceinline__ void c_summary_unit(LAS unsigned char* lds, int wave, int lane, int b, int p, const MixArgs& m) {
    const int ch0 = 64 * wave, fr = lane & 15, fq = lane >> 4, ch = ch0 + lane;
    LAS float* As = (LAS float*)(lds + wave * CW_BYTES);
    LAS float* Bs = As + 16 * XS;
    const LAS float* cwl = (const LAS float*)(lds + CWL_OFF);
    const int r0 = p < 4 ? ML + b * CTXL + 64 * p : b * SEQ + 64 * (p - 4);
    const int seq_lo = p < 4 ? ML + b * CTXL : b * SEQ, seq_hi = seq_lo + (p < 4 ? CTXL : SEQ);
    const int cl = ch0 + 8 * (lane & 7);
    const bf16_t* pcx = m.proj + P_CX + cl;
#pragma unroll 1
    for (int dir = 0; dir < 2; ++dir) {
        bf16x8 fa[4][2], fx[4][2]; float bav[4], bxv[4], c1v[4];
        {
            const bf16_t* wA = m.gwt + ((size_t)((dir * 2 + 0) * 8 + wave) * 64 + fr) * 64 + 8 * fq;
            const bf16_t* wX = m.gwt + ((size_t)((dir * 2 + 1) * 8 + wave) * 64 + fr) * 64 + 8 * fq;
#pragma unroll
            for (int nt = 0; nt < 4; ++nt) {
#pragma unroll
                for (int ks = 0; ks < 2; ++ks) { fa[nt][ks] = *(const bf16x8*)(wA + (size_t)nt * 16 * 64 + 32 * ks); fx[nt][ks] = *(const bf16x8*)(wX + (size_t)nt * 16 * 64 + 32 * ks); }
                const int cc = ch0 + 16 * nt + fr;
                bav[nt] = m.gconst[(dir * 3 + 0) * LRU + cc]; bxv[nt] = m.gconst[(dir * 3 + 1) * LRU + cc]; c1v[nt] = m.gconst[(dir * 3 + 2) * LRU + cc];
            }
        }
        float H = 0.f, P = 1.f;
        unsigned* abp = m.AB + ((size_t)dir * MA + r0) * LRU + ch;
        u32x4 raw[2][4];
        auto issue = [&](int blk) __attribute__((always_inline)) {
#pragma unroll
            for (int ps = 0; ps < 2; ++ps) { const int r = r0 + 16 * blk + ps * 8 + (lane >> 3);
#pragma unroll
                for (int k = 0; k < 4; ++k) { int s = r + k - 2; s = s < seq_lo ? seq_lo : (s >= seq_hi ? seq_hi - 1 : s); raw[ps][k] = *(const u32x4*)(pcx + (size_t)s * PW); } }
        };
        issue(dir == 0 ? 0 : 3);
#pragma unroll 1
        for (int ib = 0; ib < 4; ++ib) {
            const int blk = dir == 0 ? ib : 3 - ib;
#pragma unroll
            for (int ps = 0; ps < 2; ++ps) {
                const int tt = ps * 8 + (lane >> 3), r = r0 + 16 * blk + tt;
                const f32x4 b0 = *(const LAS f32x4*)(cwl + 4 * LRU + cl), b1 = *(const LAS f32x4*)(cwl + 4 * LRU + cl + 4);
                f32x2 a2[4] = {{b0[0], b0[1]}, {b0[2], b0[3]}, {b1[0], b1[1]}, {b1[2], b1[3]}};
#pragma unroll
                for (int k = 0; k < 4; ++k) { const int s = r + k - 2; const bool ok = (s >= seq_lo && s < seq_hi);
                    u32x4 rv = raw[ps][k]; if (!ok) rv = (u32x4){0u, 0u, 0u, 0u};
                    const f32x4 w0 = *(const LAS f32x4*)(cwl + k * LRU + cl), w1 = *(const LAS f32x4*)(cwl + k * LRU + cl + 4);
                    const f32x2 v0 = {__uint_as_float(rv.x << 16), __uint_as_float(rv.x & 0xffff0000u)}, v1 = {__uint_as_float(rv.y << 16), __uint_as_float(rv.y & 0xffff0000u)};
                    const f32x2 v2 = {__uint_as_float(rv.z << 16), __uint_as_float(rv.z & 0xffff0000u)}, v3 = {__uint_as_float(rv.w << 16), __uint_as_float(rv.w & 0xffff0000u)};
                    a2[0] = (f32x2){w0[0], w0[1]} * v0 + a2[0]; a2[1] = (f32x2){w0[2], w0[3]} * v1 + a2[1]; a2[2] = (f32x2){w1[0], w1[1]} * v2 + a2[2]; a2[3] = (f32x2){w1[2], w1[3]} * v3 + a2[3]; }
                *(LAS f32x4*)(Bs + tt * XS + 8 * (lane & 7)) = (f32x4){a2[0].x, a2[0].y, a2[1].x, a2[1].y};
                *(LAS f32x4*)(Bs + tt * XS + 8 * (lane & 7) + 4) = (f32x4){a2[2].x, a2[2].y, a2[3].x, a2[3].y};
            }
            if (ib < 3) issue(dir == 0 ? ib + 1 : 2 - ib);
            bf16x8 xa[2]; float xcv[4][4];
#pragma unroll
            for (int ks = 0; ks < 2; ++ks) {
                const f32x4 lo4 = *(const LAS f32x4*)(Bs + fr * XS + 32 * ks + 8 * fq), hi4 = *(const LAS f32x4*)(Bs + fr * XS + 32 * ks + 8 * fq + 4);
                const unsigned p0 = cvt_pk_bf16(lo4[0], lo4[1]), p1 = cvt_pk_bf16(lo4[2], lo4[3]), p2 = cvt_pk_bf16(hi4[0], hi4[1]), p3 = cvt_pk_bf16(hi4[2], hi4[3]);
                xa[ks] = __builtin_bit_cast(bf16x8, (u32x4){p0, p1, p2, p3});
            }
#pragma unroll
            for (int nt = 0; nt < 4; ++nt)
#pragma unroll
                for (int j = 0; j < 4; ++j) xcv[nt][j] = Bs[(4 * fq + j) * XS + 16 * nt + fr];
#pragma unroll
            for (int nt = 0; nt < 4; ++nt) {
                f32x4 ga = (f32x4){0.f, 0.f, 0.f, 0.f}, gx = (f32x4){0.f, 0.f, 0.f, 0.f};
#pragma unroll
                for (int ks = 0; ks < 2; ++ks) { ga = __builtin_amdgcn_mfma_f32_16x16x32_bf16(xa[ks], fa[nt][ks], ga, 0, 0, 0); gx = __builtin_amdgcn_mfma_f32_16x16x32_bf16(xa[ks], fx[nt][ks], gx, 0, 0, 0); }
#pragma unroll
                for (int j = 0; j < 4; j += 2) {
                    const f32x2 ea = (f32x2){ga[j], ga[j + 1]} + bav[nt], ex = (f32x2){gx[j], gx[j + 1]} + bxv[nt];
                    f32x2 ta = {fast_exp2(ea.x), fast_exp2(ea.y)}, tx = {fast_exp2(ex.x), fast_exp2(ex.y)}; ta = ta + 1.0f; tx = tx + 1.0f;
                    const f32x2 rr = {fast_rcp(ta.x), fast_rcp(ta.y)}, ii = {fast_rcp(tx.x), fast_rcp(tx.y)};
                    const f32x2 la = rr * c1v[nt]; const f32x2 a = {fast_exp2(la.x), fast_exp2(la.y)};
                    const f32x2 om = 1.0f - a * a;
                    const f32x2 mult = {__builtin_amdgcn_sqrtf(fmaxf(om.x, 0.f)), __builtin_amdgcn_sqrtf(fmaxf(om.y, 0.f))};
                    const f32x2 bb = mult * (ii * (f32x2){xcv[nt][j], xcv[nt][j + 1]});
                    As[(4 * fq + j) * XS + 16 * nt + fr] = a.x; As[(4 * fq + j + 1) * XS + 16 * nt + fr] = a.y;
                    Bs[(4 * fq + j) * XS + 16 * nt + fr] = bb.x; Bs[(4 * fq + j + 1) * XS + 16 * nt + fr] = bb.y;
                }
            }
            unsigned* abb = abp + (size_t)(16 * blk) * LRU;
            if (dir == 0) {
#pragma unroll
                for (int tt = 0; tt < 16; ++tt) { const float a = As[tt * XS + lane], bb = Bs[tt * XS + lane]; H = a * H + bb; P *= a; abb[(size_t)tt * LRU] = cvt_pk_bf16(bb, 1.0f - a); }
            } else {
#pragma unroll
                for (int tt = 15; tt >= 0; --tt) { const float a = As[tt * XS + lane], bb = Bs[tt * XS + lane]; H = a * H + bb; P *= a; abb[(size_t)tt * LRU] = cvt_pk_bf16(bb, 1.0f - a); }
            }
        }
        const size_t o = ((size_t)(dir * NB + b) * NPOS + p) * LRU + ch; m.SA[o] = P; m.SB[o] = H;
    }
}
__device__ __forceinline__ void c_final_unit(LAS unsigned char* lds, int wave, int lane, int b, int p, const MixArgs& m, bool self_fold) {
    const int ch0 = 64 * wave, ch = ch0 + lane;
    LAS float* As = (LAS float*)(lds + wave * CW_BYTES);
    LAS bf16_t* hfb = (LAS bf16_t*)(lds + wave * CW_BYTES + 2 * 16 * XS * 4);
    const int r0 = p < 4 ? ML + b * CTXL + 64 * p : b * SEQ + 64 * (p - 4);
    float hf = 0.f, hb = 0.f;
    if (self_fold) {
        const float* sa0 = m.SA + (size_t)(0 * NB + b) * NPOS * LRU + ch; const float* sb0 = m.SB + (size_t)(0 * NB + b) * NPOS * LRU + ch;
        const float* sa1 = m.SA + (size_t)(1 * NB + b) * NPOS * LRU + ch; const float* sb1 = m.SB + (size_t)(1 * NB + b) * NPOS * LRU + ch;
        for (int j = 0; j < p; ++j) hf = sa0[(size_t)j * LRU] * hf + sb0[(size_t)j * LRU];
        for (int j = 3; j > p; --j) hb = sa1[(size_t)j * LRU] * hb + sb1[(size_t)j * LRU];
    } else {
        hf = m.CR[((size_t)(0 * NB + b) * NPOS + p) * LRU + ch]; hb = m.CR[((size_t)(1 * NB + b) * NPOS + p) * LRU + ch];
    }
    const unsigned* ab0 = m.AB + ((size_t)0 * MA + r0) * LRU + ch; const unsigned* ab1 = m.AB + ((size_t)1 * MA + r0) * LRU + ch;
    unsigned wf[64], wb[64];
#pragma unroll
    for (int t = 0; t < 64; ++t) wf[t] = ab0[(size_t)t * LRU];
#pragma unroll
    for (int t = 0; t < 64; ++t) wb[t] = ab1[(size_t)t * LRU];
#pragma unroll
    for (int t = 0; t < 64; ++t) { const float bb = __builtin_bit_cast(float, wf[t] << 16), om = __builtin_bit_cast(float, wf[t] & 0xffff0000u); hf = (1.0f - om) * hf + bb; hfb[t * 64 + lane] = f2bf(hf); }
    const f32x4 gm0 = *(const f32x4*)(m.g_mix + 512 + ch0 + 16 * (lane & 3)), gm1 = *(const f32x4*)(m.g_mix + 512 + ch0 + 16 * (lane & 3) + 4),
                gm2 = *(const f32x4*)(m.g_mix + 512 + ch0 + 16 * (lane & 3) + 8), gm3 = *(const f32x4*)(m.g_mix + 512 + ch0 + 16 * (lane & 3) + 12);
    const float gm[16] = {gm0[0], gm0[1], gm0[2], gm0[3], gm1[0], gm1[1], gm1[2], gm1[3], gm2[0], gm2[1], gm2[2], gm2[3], gm3[0], gm3[1], gm3[2], gm3[3]};
    u32x4 cgr[4][2];
#pragma unroll
    for (int blk = 0; blk < 4; ++blk) { const bf16_t* pg = m.proj + (size_t)(r0 + 16 * blk + (lane >> 2)) * PW + P_CG + ch0 + 16 * (lane & 3); cgr[blk][0] = *(const u32x4*)pg; cgr[blk][1] = *(const u32x4*)(pg + 8); }
#pragma unroll
    for (int blk = 3; blk >= 0; --blk) {
#pragma unroll
        for (int tt = 15; tt >= 0; --tt) { const unsigned w = wb[16 * blk + tt]; const float bb = __builtin_bit_cast(float, w << 16), om = __builtin_bit_cast(float, w & 0xffff0000u); hb = (1.0f - om) * hb + bb;
            As[tt * XS + lane] = hb + bf2f(hfb[(16 * blk + tt) * 64 + lane]); }
        {
            const int tt = lane >> 2, q = lane & 3, r = r0 + 16 * blk + tt;
            float ys[16], cg[16];
#pragma unroll
            for (int v4 = 0; v4 < 4; ++v4) { const f32x4 t4 = *(const LAS f32x4*)(As + tt * XS + 16 * q + 4 * v4); ys[4 * v4] = t4[0]; ys[4 * v4 + 1] = t4[1]; ys[4 * v4 + 2] = t4[2]; ys[4 * v4 + 3] = t4[3]; }
            { float t8[8]; unpack8(cgr[blk][0], t8);
#pragma unroll
              for (int j = 0; j < 8; ++j) cg[j] = t8[j];
              unpack8(cgr[blk][1], t8);
#pragma unroll
              for (int j = 0; j < 8; ++j) cg[8 + j] = t8[j]; }
            float ss = 0.f;
#pragma unroll
            for (int j = 0; j < 16; ++j) { ys[j] *= cg[j]; ss += ys[j] * ys[j]; }
            ss += __shfl_xor(ss, 1); ss += __shfl_xor(ss, 2);
            const float hr = rsqrtf(ss * (1.0f / 64.0f) + EPS);
            u32x4 o0, o1;
            o0.x = cvt_pk_bf16(ys[0] * hr * gm[0], ys[1] * hr * gm[1]); o0.y = cvt_pk_bf16(ys[2] * hr * gm[2], ys[3] * hr * gm[3]);
            o0.z = cvt_pk_bf16(ys[4] * hr * gm[4], ys[5] * hr * gm[5]); o0.w = cvt_pk_bf16(ys[6] * hr * gm[6], ys[7] * hr * gm[7]);
            o1.x = cvt_pk_bf16(ys[8] * hr * gm[8], ys[9] * hr * gm[9]); o1.y = cvt_pk_bf16(ys[10] * hr * gm[10], ys[11] * hr * gm[11]);
            o1.z = cvt_pk_bf16(ys[12] * hr * gm[12], ys[13] * hr * gm[13]); o1.w = cvt_pk_bf16(ys[14] * hr * gm[14], ys[15] * hr * gm[15]);
            bf16_t* yo = m.ybuf + (size_t)r * D + 512 + ch0 + 16 * q;
            *(u32x4*)yo = o0; *(u32x4*)(yo + 8) = o1;
        }
    }
}
__device__ __forceinline__ void carry_task(int gid, const MixArgs& m) {
    const int ch = gid & 511, dir = (gid >> 9) & 1, b = gid >> 10;
    const float* sa = m.SA + (size_t)(dir * NB + b) * NPOS * LRU + ch; const float* sb = m.SB + (size_t)(dir * NB + b) * NPOS * LRU + ch;
    float* cr = m.CR + (size_t)(dir * NB + b) * NPOS * LRU + ch;
    float h = 0.f;
    if (dir == 0) {
#pragma unroll 33
        for (int p = 0; p < NPOS; ++p) { const float a = sa[(size_t)p * LRU], bb = sb[(size_t)p * LRU]; cr[(size_t)p * LRU] = h; h = a * h + bb; }
    } else {
#pragma unroll
        for (int p = 3; p >= 0; --p) { const float a = sa[(size_t)p * LRU], bb = sb[(size_t)p * LRU]; cr[(size_t)p * LRU] = h; h = a * h + bb; }
#pragma unroll 32
        for (int p = NPOS - 1; p >= 4; --p) { const float a = sa[(size_t)p * LRU], bb = sb[(size_t)p * LRU]; cr[(size_t)p * LRU] = h; h = a * h + bb; }
    }
}
constexpr int REP_CS = 1, REP_B = 1, REP_CF = 1;
__device__ __forceinline__ void mix_phase(LAS unsigned char* lds, int tid, int wave, int lane, int G, const MixArgs& m, int n_a_units, unsigned* ctr) {
    const int nC = NB * NPOS, total = nC + n_a_units;
    volatile LAS int* nxt = (volatile LAS int*)(lds + LDS_BYTES - 32);
    c_prep(lds, tid, m);
    int u = blockIdx.x;
#pragma unroll 1
    for (int rep = 0; rep < REP_CS; ++rep) {
#pragma unroll 1
        while (u < nC) {
            if (tid == 0) *nxt = G + (int)__hip_atomic_fetch_add(ctr, 1u, __ATOMIC_RELAXED, __HIP_MEMORY_SCOPE_AGENT);
            c_summary_unit(lds, wave, lane, u / NPOS, u % NPOS, m);
            __syncthreads();
            u = *nxt;
            __syncthreads();
        }
        if (rep + 1 < REP_CS) u = blockIdx.x;
    }
#pragma unroll 1
    while (u < total) {
        if (tid == 0) *nxt = G + (int)__hip_atomic_fetch_add(ctr, 1u, __ATOMIC_RELAXED, __HIP_MEMORY_SCOPE_AGENT);
        a_unit(lds, tid, u - nC, m);
        u = *nxt;
        __syncthreads();
    }
}
__device__ __forceinline__ void carry_phase(LAS unsigned char* lds, int tid, int wave, int lane, int G, const MixArgs& m, int ctx_too, int n_b_units) {
    if (blockIdx.x < 8) carry_task((int)blockIdx.x * NTHREADS + tid, m);
    else if (ctx_too && blockIdx.x < 24) { const int u = (int)blockIdx.x - 8; c_final_unit(lds, wave, lane, u >> 2, u & 3, m, true); }
#pragma unroll 1
    for (int rep = 0; rep < REP_B; ++rep)
#pragma unroll 1
    for (int u = (int)((blockIdx.x + G - 24) % G); u < n_b_units; u += G) b_unit(tid, u, m);
}
__device__ __forceinline__ void cfin_phase(LAS unsigned char* lds, int tid, int wave, int lane, int G, const MixArgs& m) {
    const int nC = NB * (NPOS - 4);
#pragma unroll 1
    for (int rep = 0; rep < REP_CF; ++rep)
#pragma unroll 1
    for (int u = blockIdx.x; u < nC; u += G) c_final_unit(lds, wave, lane, u / (NPOS - 4), 4 + u % (NPOS - 4), m, false);
}

constexpr int CW_WQ = 2048;
constexpr int CW_CNT = 1024;
constexpr size_t EXP_STRIDE = (size_t)(2 * DFF * D + D * DFF);
constexpr size_t EXP_W2_OFF = (size_t)2 * DFF * D;
constexpr size_t RT_E = 0;
constexpr size_t RT_P = 256 * 1024;
constexpr size_t RT_POS = 512 * 1024;
constexpr size_t RT_IDX = 1024 * 1024;
constexpr int MAXT = 264;
constexpr size_t WS_Y = WS_HBUF;
constexpr size_t WS_H8MOE = WS_BIG + 66 * MiB;

typedef int i32x2 __attribute__((ext_vector_type(2)));

template <bool ROUTE, int OUTM  >
__device__ __forceinline__ void norm_phase(LAS unsigned char* lds, int tid, int wave, int lane, int G, const float* xl, const float* xc, const float* g, const float* modv_l, int sh_off, int sc_off,
                                           bf16_t* out, int rows, const float* wr, const float* br, unsigned* ctl, unsigned char* route, float* rsc = nullptr, bool nt_x = false, const bf16_t* xs16 = nullptr,
                                           int first_block = 0, int nblocks = 0, int row_lo = 0) {
    LAS float* wrT = (LAS float*)lds;
    LAS unsigned* lcnt = (LAS unsigned*)(lds + 32768);
    if (ROUTE) {
        for (int i = tid; i < D * NE; i += NTHREADS) wrT[(i & 7) * D + (i >> 3)] = wr[i];
        if (tid < 32) lcnt[tid] = 0u;
        __syncthreads();
    }
    const int gw = ((int)blockIdx.x - first_block) * NWAVES + wave, NGW = (nblocks ? nblocks : G) * NWAVES;
    const int rpw = (rows + NGW - 1) / NGW;
    const int rbeg0 = gw * rpw, rbeg = row_lo + (rbeg0 < rows ? rbeg0 : rows), rend = row_lo + ((rbeg0 + rpw < rows) ? rbeg0 + rpw : rows);
    int cur_mod = -1; f32x4 Gv[4], Sv[4];
    int my_e0 = 0, my_e1 = 0, my_l0 = 0, my_l1 = 0; float my_p0 = 0.f, my_p1 = 0.f;
#pragma unroll 1
    for (int row = rbeg; row < rend; ++row) {
        const int mr = row_modidx(row);
        if (mr != cur_mod) { cur_mod = mr; const float* mv = modv_l + (size_t)mr * 6144;
#pragma unroll
            for (int j = 0; j < 4; ++j) { const int c = 4 * lane + 256 * j; const f32x4 gg = *(const f32x4*)(g + c), sc = *(const f32x4*)(mv + sc_off + c); Gv[j] = gg * (sc + 1.0f); Sv[j] = *(const f32x4*)(mv + sh_off + c); } }
        const float* xr = row < ML ? xl + (size_t)row * D : xc + (size_t)(row - ML) * D;
        f32x4 v[4]; float ss = 0.f;
#pragma unroll
        for (int j = 0; j < 4; ++j) {
            if (xs16) { const u32x2 r = *(const u32x2*)(xs16 + (size_t)row * D + 4 * lane + 256 * j); v[j][0] = __builtin_bit_cast(float, r.x << 16); v[j][1] = __builtin_bit_cast(float, r.x & 0xffff0000u); v[j][2] = __builtin_bit_cast(float, r.y << 16); v[j][3] = __builtin_bit_cast(float, r.y & 0xffff0000u); }
            else v[j] = nt_x ? __builtin_nontemporal_load((const f32x4*)(xr + 4 * lane + 256 * j)) : *(const f32x4*)(xr + 4 * lane + 256 * j);
            ss += (v[j][0] * v[j][0] + v[j][1] * v[j][1]) + (v[j][2] * v[j][2] + v[j][3] * v[j][3]); }
        ss = wave_sum(ss);
        const float rstd = rsqrtf(ss * (1.0f / D) + EPS);
#pragma unroll
        for (int j = 0; j < 4; ++j) { v[j] = (v[j] * rstd) * Gv[j] + Sv[j];
            if (OUTM == 1) *(unsigned*)((unsigned char*)out + (size_t)row * D + 4 * lane + 256 * j) = pg8::pack4_fp8(v[j][0], v[j][1], v[j][2], v[j][3]);
            else if (OUTM == 0) { u32x2 o; o.x = cvt_pk_bf16(v[j][0], v[j][1]); o.y = cvt_pk_bf16(v[j][2], v[j][3]); *(u32x2*)(out + (size_t)row * D + 4 * lane + 256 * j) = o; } }
        if (OUTM == 2) {
            float am = 0.f;
#pragma unroll
            for (int j = 0; j < 4; ++j) am = fmaxf(am, fmaxf(fmaxf(fabsf(v[j][0]), fabsf(v[j][1])), fmaxf(fabsf(v[j][2]), fabsf(v[j][3]))));
#pragma unroll
            for (int o = 1; o < 64; o <<= 1) am = fmaxf(am, __shfl_xor(am, o));
            am = fmaxf(am, 1e-20f);
            const float qs = 127.0f / am;
#pragma unroll
            for (int j = 0; j < 4; ++j) { const int q0 = (int)__builtin_rintf(v[j][0] * qs), q1 = (int)__builtin_rintf(v[j][1] * qs), q2 = (int)__builtin_rintf(v[j][2] * qs), q3 = (int)__builtin_rintf(v[j][3] * qs);
                *(unsigned*)((unsigned char*)out + (size_t)row * D + 4 * lane + 256 * j) = (unsigned)(q0 & 0xff) | ((unsigned)(q1 & 0xff) << 8) | ((unsigned)(q2 & 0xff) << 16) | ((unsigned)(q3 & 0xff) << 24); }
            if (lane == 0) rsc[row] = am * (1.0f / 127.0f);
        }
        if (ROUTE) {
            float lg[NE];
#pragma unroll
            for (int e = 0; e < NE; ++e) { float a = 0.f;
#pragma unroll
                for (int j = 0; j < 4; ++j) { const f32x4 w4 = *(const LAS f32x4*)(wrT + e * D + 4 * lane + 256 * j); a += (v[j][0] * w4[0] + v[j][1] * w4[1]) + (v[j][2] * w4[2] + v[j][3] * w4[3]); }
                lg[e] = wave_sum(a) + br[e]; }
            int i0 = 0; float v0 = lg[0];
#pragma unroll
            for (int e = 1; e < NE; ++e) if (lg[e] > v0) { v0 = lg[e]; i0 = e; }
            int i1 = 0; float v1 = -3.0e38f;
#pragma unroll
            for (int e = 0; e < NE; ++e) if (e != i0 && lg[e] > v1) { v1 = lg[e]; i1 = e; }
            const float e1 = __expf(v1 - v0), p0 = 1.0f / (1.0f + e1), p1 = e1 / (1.0f + e1);
            if (lane == row - rbeg) {
                my_e0 = i0; my_e1 = i1; my_p0 = p0; my_p1 = p1;
                my_l0 = (int)__hip_atomic_fetch_add(lcnt + i0, 1u, __ATOMIC_RELAXED, __HIP_MEMORY_SCOPE_WORKGROUP);
                my_l1 = (int)__hip_atomic_fetch_add(lcnt + i1, 1u, __ATOMIC_RELAXED, __HIP_MEMORY_SCOPE_WORKGROUP);
            }
        }
    }
    if (ROUTE) {
        __syncthreads();
        if (tid < 8) { const unsigned n = lcnt[tid]; lcnt[16 + tid] = n ? __hip_atomic_fetch_add(ctl + CW_CNT + tid * 64, n, __ATOMIC_RELAXED, __HIP_MEMORY_SCOPE_AGENT) : 0u; }
        __syncthreads();
        const int row = rbeg + lane;
        if (row < rend) {
            const int pos0 = (int)lcnt[16 + my_e0] + my_l0, pos1 = (int)lcnt[16 + my_e1] + my_l1;
            ((i32x2*)(route + RT_E))[row] = (i32x2){my_e0, my_e1};
            ((f32x2*)(route + RT_P))[row] = (f32x2){my_p0, my_p1};
            ((i32x2*)(route + RT_POS))[row] = (i32x2){pos0, pos1};
            int* ridx = (int*)(route + RT_IDX);
            ridx[(size_t)my_e0 * ML + pos0] = row;
            ridx[(size_t)my_e1 * ML + pos1] = row;
        }
    }
}

struct MoeTiles { int toff[9]; };
__device__ __forceinline__ void moe_tiles(const unsigned* ctl, MoeTiles& t) {
    int acc = 0;
#pragma unroll
    for (int e = 0; e < 8; ++e) { const int c = (int)__builtin_amdgcn_readfirstlane(__hip_atomic_load(ctl + CW_CNT + e * 64, __ATOMIC_RELAXED, __HIP_MEMORY_SCOPE_AGENT)); t.toff[e] = acc; acc += (c + 255) >> 8; }
    t.toff[8] = acc;
}
namespace pg8 {
struct MoeUpSched {
    static constexpr bool GATHER = true; static constexpr bool VARNT = false;
    Order o; MoeTiles t; const char* hb; const char* wmoe; const int* ridx; const unsigned* cntp; size_t tstepB;
    __device__ __forceinline__ void init(const void* hbuf8, const unsigned char* wmoe_, const int* ridx_, const unsigned* ctl, int G, int c) {
        moe_tiles(ctl, t); o.init(t.toff[8], (2 * DFF) / BM, G, c); cntp = ctl + CW_CNT; hb = (const char*)hbuf8; wmoe = (const char*)wmoe_; ridx = ridx_; tstepB = (size_t)BM * D; }
    __device__ __forceinline__ bool next(int i, Unit& u) const {
        if (!o.lin(i, u.pm, u.pn)) return false;
        int e = 0, ts = 0;
#pragma unroll
        for (int k = 1; k < 8; ++k) if (u.pm >= t.toff[k]) { e = k; ts = t.toff[k]; }
        u.e = e; u.rb = (u.pm - ts) * BM; u.cnt = (int)cntp[e * 64];
        u.a = hb; u.b = wmoe + (size_t)e * EXP_STRIDE + (size_t)u.pn * tstepB; return true;
    }
    __device__ __forceinline__ unsigned arow(const Unit& u, int r) const { const int idx = u.rb + r; return (unsigned)ridx[(size_t)u.e * ML + (idx < u.cnt ? idx : 0)]; }
    __device__ __forceinline__ void idx_dma(const Unit& u, LAS unsigned char* slot, int lane) const {
        __builtin_amdgcn_global_load_lds((const unsigned*)(ridx + (size_t)u.e * ML + u.rb + lane * 4), (LAS unsigned*)slot, 16, 0, 0); }
    __device__ __forceinline__ unsigned arow_lds(const Unit& u, int r, const LAS int* ix) const { return (unsigned)ix[(u.rb + r < u.cnt) ? r : 0]; }
    __device__ __forceinline__ void a_ready(const Unit&) const {}
    __device__ __forceinline__ void done(const Unit&) const {}
};
static_assert((DFF / 128) - (MD_SPLIT - 1) * MD_NT0 >= 2 && ((DFF / 128) - (MD_SPLIT - 1) * MD_NT0) % 2 == 0 && MD_NT0 % 2 == 0, "K pieces: even K-tile counts");
struct MoeTail { int NU, NF, NT, split; };
__device__ __forceinline__ void moe_tail(int tiles, int G, MoeTail& mt) { mt.NU = tiles * (D / BM); mt.NF = (mt.NU / G) * G; mt.NT = mt.NU - mt.NF; mt.split = (mt.NT > 0 && mt.NT <= MD_QMAX) ? MD_SPLIT : 1; }
struct MoeDownSched {
    static constexpr bool GATHER = false; static constexpr bool VARNT = true;
    Order o; MoeTiles t; MoeTail mt; const char* H; const char* wmoe; size_t tstep;
    __device__ __forceinline__ void init(const void* Hc, const unsigned char* wmoe_, const unsigned* ctl, int G, int c) {
        moe_tiles(ctl, t); o.init(t.toff[8], D / BM, G, c); moe_tail(t.toff[8], G, mt); H = (const char*)Hc; wmoe = (const char*)wmoe_; tstep = (size_t)BM * DFF; }
    __device__ __forceinline__ bool next(int i, Unit& u) const {
        const int L = i * o.G + o.c; int Lu = L, s = 0; u.q = 0;
        if (L >= mt.NF) { const int j = L - mt.NF; if (j >= mt.NT * mt.split) return false; u.q = j / mt.split; s = j % mt.split; Lu = mt.NF + u.q; }
        o.lin_abs(Lu, u.pm, u.pn);
        int e = 0;
#pragma unroll
        for (int k = 1; k < 8; ++k) if (u.pm >= t.toff[k]) e = k;
        u.e = e; u.rb = 0; u.cnt = 0; u.part = s;
        const int k0 = s * MD_NT0; u.nt = (L < mt.NF || mt.split == 1) ? DFF / 128 : (s < MD_SPLIT - 1 ? MD_NT0 : DFF / 128 - (MD_SPLIT - 1) * MD_NT0);
        u.a = H + (size_t)u.pm * tstep + (size_t)k0 * 128; u.b = wmoe + (size_t)e * EXP_STRIDE + EXP_W2_OFF + (size_t)u.pn * tstep + (size_t)k0 * 128; return true;
    }
    __device__ __forceinline__ unsigned arow(const Unit&, int r) const { return (unsigned)r; }
    __device__ __forceinline__ void a_ready(const Unit&) const {}
    __device__ __forceinline__ void done(const Unit&) const {}
};
}

__device__ __forceinline__ void final_phase(LAS unsigned char* lds, int tid, const bf16_t* YP, int wave, int lane, int G, float* x, const bf16_t* x16, const bf16_t* Y, const float* gt2  , const float* g_final, const unsigned* ctl, const unsigned char* route) {
    MoeTiles t; moe_tiles(ctl, t);
    pg8::MoeTail mt; pg8::moe_tail(t.toff[8], G, mt);
    LAS unsigned char* tmap = lds;
    if (mt.split > 1) {
        for (int i = tid; i < t.toff[8] * (D / 256); i += NTHREADS) tmap[i] = 255;
        __syncthreads();
        if (tid < mt.NT) { pg8::Order o; o.init(t.toff[8], D / 256, G, 0); int pm, pn; o.lin_abs(mt.NF + tid, pm, pn); tmap[pm * (D / 256) + pn] = (unsigned char)tid; }
        __syncthreads();
    }
    const int gw = blockIdx.x * NWAVES + wave, NGW = G * NWAVES;
    const int rpw = (ML + NGW - 1) / NGW;
    const int rbeg = gw * rpw, rend = (rbeg + rpw < ML) ? rbeg + rpw : ML;
    f32x4 gf[4];
#pragma unroll
    for (int j = 0; j < 4; ++j) gf[j] = *(const f32x4*)(g_final + 4 * lane + 256 * j);
#pragma unroll 1
    for (int row = rbeg; row < rend; ++row) {
        const i32x2 ee = ((const i32x2*)(route + RT_E))[row]; const f32x2 pp = ((const f32x2*)(route + RT_P))[row]; const i32x2 ps = ((const i32x2*)(route + RT_POS))[row];
        int t0 = 0, t1 = 0;
#pragma unroll
        for (int k = 1; k < 8; ++k) { if (ee[0] >= k) t0 = t.toff[k]; if (ee[1] >= k) t1 = t.toff[k]; }
        const bf16_t* y0 = Y + ((size_t)t0 * 256 + ps[0]) * D; const bf16_t* y1 = Y + ((size_t)t1 * 256 + ps[1]) * D;
        const int pm0 = t0 + (ps[0] >> 8), pm1 = t1 + (ps[1] >> 8), r0 = ps[0] & 255, r1 = ps[1] & 255;
        const float* gt = gt2 + (size_t)(row / SEQ) * 6144;
        f32x4 v[4]; float ss = 0.f;
#pragma unroll
        for (int j = 0; j < 4; ++j) {
            const int c = 4 * lane + 256 * j;
            const u32x2 xr_ = *(const u32x2*)(x16 + (size_t)row * D + c); f32x4 xv; xv[0] = __builtin_bit_cast(float, xr_.x << 16); xv[1] = __builtin_bit_cast(float, xr_.x & 0xffff0000u); xv[2] = __builtin_bit_cast(float, xr_.y << 16); xv[3] = __builtin_bit_cast(float, xr_.y & 0xffff0000u);
            const f32x4 gv = *(const f32x4*)(gt + c);
            const u32x2 a = *(const u32x2*)(y0 + c), b2 = *(const u32x2*)(y1 + c);
            f32x4 ya, yb;
            ya[0] = __builtin_bit_cast(float, a.x << 16); ya[1] = __builtin_bit_cast(float, a.x & 0xffff0000u); ya[2] = __builtin_bit_cast(float, a.y << 16); ya[3] = __builtin_bit_cast(float, a.y & 0xffff0000u);
            yb[0] = __builtin_bit_cast(float, b2.x << 16); yb[1] = __builtin_bit_cast(float, b2.x & 0xffff0000u); yb[2] = __builtin_bit_cast(float, b2.y << 16); yb[3] = __builtin_bit_cast(float, b2.y & 0xffff0000u);
            if (mt.split > 1) {
                const int q0 = __builtin_amdgcn_readfirstlane((int)tmap[pm0 * (D / 256) + j]), q1 = __builtin_amdgcn_readfirstlane((int)tmap[pm1 * (D / 256) + j]);
                if (q0 != 255) {
#pragma unroll
                    for (int sp = 0; sp < MD_SPLIT - 1; ++sp) { const u32x2 pa = *(const u32x2*)(YP + ((size_t)sp * MD_QMAX + q0) * 65536 + (size_t)r0 * 256 + 4 * lane);
                        ya[0] += __builtin_bit_cast(float, pa.x << 16); ya[1] += __builtin_bit_cast(float, pa.x & 0xffff0000u); ya[2] += __builtin_bit_cast(float, pa.y << 16); ya[3] += __builtin_bit_cast(float, pa.y & 0xffff0000u); } }
                if (q1 != 255) {
#pragma unroll
                    for (int sp = 0; sp < MD_SPLIT - 1; ++sp) { const u32x2 pb = *(const u32x2*)(YP + ((size_t)sp * MD_QMAX + q1) * 65536 + (size_t)r1 * 256 + 4 * lane);
                        yb[0] += __builtin_bit_cast(float, pb.x << 16); yb[1] += __builtin_bit_cast(float, pb.x & 0xffff0000u); yb[2] += __builtin_bit_cast(float, pb.y << 16); yb[3] += __builtin_bit_cast(float, pb.y & 0xffff0000u); } }
            }
            v[j] = xv + gv * (ya * pp[0] + yb * pp[1]);
            ss += (v[j][0] * v[j][0] + v[j][1] * v[j][1]) + (v[j][2] * v[j][2] + v[j][3] * v[j][3]);
        }
        ss = wave_sum(ss);
        const float rstd = rsqrtf(ss * (1.0f / D) + EPS);
#pragma unroll
        for (int j = 0; j < 4; ++j) *(f32x4*)(x + (size_t)row * D + 4 * lane + 256 * j) = (v[j] * rstd) * gf[j];
    }
}

__device__ __forceinline__ void mod_task(LAS unsigned char* lds, int tid, int wave, int lane, int task, const float* c, const float* c_ctx, const float* w_mod, const float* b_mod, float* modv) {
    LAS float* sl = (LAS float*)lds;
    LAS float* red = (LAS float*)(lds + 20480);
    for (int i = tid; i < 5 * D; i += NTHREADS) { const float v = i < 4 * D ? c[i] : c_ctx[i - 4 * D]; sl[i] = v / (1.0f + __expf(-v)); }
    __syncthreads();
    const int l = task / 96, n = (task % 96) * 64 + lane;
    const float* w = w_mod + (size_t)l * D * 6144 + n;
    float acc[5] = {0.f, 0.f, 0.f, 0.f, 0.f};
#pragma unroll 16
    for (int kk = 0; kk < 128; ++kk) { const int k = wave * 128 + kk; const float wv = w[(size_t)k * 6144];
#pragma unroll
        for (int r = 0; r < 5; ++r) acc[r] += sl[r * D + k] * wv; }
#pragma unroll
    for (int r = 0; r < 5; ++r) red[(wave * 5 + r) * 64 + lane] = acc[r];
    __syncthreads();
    if (tid < 320) { const int r = tid >> 6, ln = tid & 63; float s = 0.f;
#pragma unroll
        for (int w8 = 0; w8 < 8; ++w8) s += red[(w8 * 5 + r) * 64 + ln];
        const int nn = (task % 96) * 64 + ln; modv[((size_t)l * 5 + r) * 6144 + nn] = s + b_mod[l * 6144 + nn]; }
    __syncthreads();
}

constexpr unsigned DUPMASK = 0u;
constexpr int CW_BAR = 4096;
#define XB_TMO      128
#define XB_XCNT(j)  (256  + 64 * (j))
#define XB_XSUB(j)  (1280 + 64 * (j))
#define XB_XGEN(j)  (2304 + 64 * (j))
#define XB_TOP      3328
#define XB_TOPGEN   3392
#define XCD_BAR_WORDS 3456
#define XB_SPIN_CAP (1u << 18)

__device__ __forceinline__ unsigned xb_ld(unsigned* p)              { return __hip_atomic_load(p, __ATOMIC_RELAXED, __HIP_MEMORY_SCOPE_AGENT); }
__device__ __forceinline__ unsigned xb_add(unsigned* p, unsigned v) { return __hip_atomic_fetch_add(p, v, __ATOMIC_RELAXED, __HIP_MEMORY_SCOPE_AGENT); }
__device__ __forceinline__ unsigned xb_xcc_id() { return (unsigned)__builtin_amdgcn_s_getreg((3 << 11) | 20) & 0xFu; }
#define XB_SPIN(cond, bar) do { unsigned _sp = 0; while (cond) { __builtin_amdgcn_s_sleep(1); \
    if ((++_sp & 255u) == 0u) { if (xb_ld(&(bar)[XB_TMO])) break; if (_sp > XB_SPIN_CAP) { atomicAdd(&(bar)[XB_TMO], 1u); break; } } } } while (0)

struct XcdBarrier {
    unsigned* bar; unsigned x;
    volatile LAS unsigned* st;
};

__device__ __forceinline__ XcdBarrier xcd_barrier_post(unsigned* bar, volatile LAS unsigned* st) {
    XcdBarrier b; b.bar = bar; b.x = xb_xcc_id(); b.st = st;
    if (threadIdx.x == 0) (void)xb_add(&bar[XB_XCNT(b.x)], 1u);
    return b;
}
__device__ __forceinline__ void xcd_barrier_complete(unsigned* bar, unsigned x, unsigned& nloc, unsigned& nx) {
    const unsigned G = gridDim.x * gridDim.y * gridDim.z;
    unsigned sum, cnt, mine, sp = 0u;
    for (;;) {
        sum = 0u; cnt = 0u; mine = 0u;
#pragma unroll
        for (unsigned j = 0; j < 16; ++j) { const unsigned c = xb_ld(&bar[XB_XCNT(j)]); sum += c; cnt += (c > 0u) ? 1u : 0u; mine = (j == x) ? c : mine; }
        if (sum == G) break;
        __builtin_amdgcn_s_sleep(1);
        if ((++sp & 255u) == 0u) { if (xb_ld(&bar[XB_TMO])) break; if (sp > XB_SPIN_CAP) { atomicAdd(&bar[XB_TMO], 1u); break; } }
    }
    nloc = mine > 0u ? mine : 1u; nx = cnt > 0u ? cnt : 1u;
}

__device__ __forceinline__ void xcd_barrier(const XcdBarrier& b) {
    asm volatile("s_waitcnt vmcnt(0)" ::: "memory");
    __syncthreads();
    if (threadIdx.x == 0) {
        unsigned* bar = b.bar;
        __builtin_amdgcn_s_waitcnt(0);
        unsigned nloc = b.st[0], nx = b.st[1];
        if (nloc == 0u) { xcd_barrier_complete(bar, b.x, nloc, nx); b.st[0] = nloc; b.st[1] = nx; }
        const unsigned old = xb_add(&bar[XB_XSUB(b.x)], 1u);
        const unsigned gen = old / nloc;
        if (old + 1u == (gen + 1u) * nloc) {
            __builtin_amdgcn_fence(__ATOMIC_RELEASE, "agent");
            asm volatile("s_waitcnt vmcnt(0)" ::: "memory");
            const unsigned og = xb_add(&bar[XB_TOP], 1u);
            const unsigned tg = og / nx;
            if (og + 1u == (tg + 1u) * nx) xb_add(&bar[XB_TOPGEN], 1u);
            else XB_SPIN(xb_ld(&bar[XB_TOPGEN]) == tg, bar);
            __builtin_amdgcn_fence(__ATOMIC_ACQUIRE, "agent");
            xb_add(&bar[XB_XGEN(b.x)], 1u);
            asm volatile("s_waitcnt vmcnt(0)" ::: "memory");
        } else {
            XB_SPIN(xb_ld(&bar[XB_XGEN(b.x)]) == gen, bar);
            __builtin_amdgcn_fence(__ATOMIC_ACQUIRE, "agent");
            asm volatile("s_waitcnt vmcnt(0)" ::: "memory");
        }
    }
    __syncthreads();
}


__device__ __forceinline__ void transpose_item8(const float* W, int K, int N, unsigned char* WT, int mode, LAS float* scr, int item, int lane) {
    const int nblk = N / 32, kb = item / nblk, nb = item % nblk, k0 = 64 * kb, n0 = 32 * nb;
    const int drow0 = (mode == 0) ? n0 : (mode == 3 ? win_row(n0) : (256 * (n0 >> 7) + (n0 & 127) + (mode == 2 ? 128 : 0)));
    {
        f32x4 v[8];
#pragma unroll
        for (int i = 0; i < 8; ++i) v[i] = __builtin_nontemporal_load((const f32x4*)(W + (size_t)(k0 + 8 * i + (lane >> 3)) * N + n0 + 4 * (lane & 7)));
#pragma unroll
        for (int i = 0; i < 8; ++i) { LAS float* d = scr + (8 * i + (lane >> 3)) * 33 + 4 * (lane & 7);
#pragma unroll
            for (int j = 0; j < 4; ++j) d[j] = v[i][j] * FP8_SW; }
    }
    asm volatile("s_waitcnt lgkmcnt(0)" ::: "memory");
    const int c = lane & 7;
#pragma unroll
    for (int j = 0; j < 4; ++j) { const int n = (lane >> 3) + 8 * j; const LAS float* q = scr + (8 * c) * 33 + n;
        u32x2 o; o.x = pg8::pack4_fp8(q[0 * 33], q[1 * 33], q[2 * 33], q[3 * 33]); o.y = pg8::pack4_fp8(q[4 * 33], q[5 * 33], q[6 * 33], q[7 * 33]);
        *(u32x2*)(WT + (size_t)(drow0 + n) * K + k0 + 8 * c) = o; }
    asm volatile("s_waitcnt lgkmcnt(0)" ::: "memory");
}

__device__ __forceinline__ void quant_rows_i8(const bf16_t* W, unsigned char* Q, float* scale, int nrows, int gw, int NGW, int lane) {
#pragma unroll 1
    for (int r = gw; r < nrows; r += NGW) {
        const u32x4 a = *(const u32x4*)(W + (size_t)r * D + 16 * lane), b = *(const u32x4*)(W + (size_t)r * D + 16 * lane + 8);
        float v[16]; { float t[8]; unpack8(a, t);
#pragma unroll
            for (int j = 0; j < 8; ++j) v[j] = t[j];
            unpack8(b, t);
#pragma unroll
            for (int j = 0; j < 8; ++j) v[8 + j] = t[j]; }
        float am = 0.f;
#pragma unroll
        for (int j = 0; j < 16; ++j) am = fmaxf(am, fabsf(v[j]));
#pragma unroll
        for (int o = 1; o < 64; o <<= 1) am = fmaxf(am, __shfl_xor(am, o));
        am = fmaxf(am, 1e-30f);
        const float qs = 127.0f / am;
        unsigned w[4];
#pragma unroll
        for (int g4 = 0; g4 < 4; ++g4) { const int q0 = (int)__builtin_rintf(v[4 * g4] * qs), q1 = (int)__builtin_rintf(v[4 * g4 + 1] * qs), q2 = (int)__builtin_rintf(v[4 * g4 + 2] * qs), q3 = (int)__builtin_rintf(v[4 * g4 + 3] * qs);
            w[g4] = (unsigned)(q0 & 0xff) | ((unsigned)(q1 & 0xff) << 8) | ((unsigned)(q2 & 0xff) << 16) | ((unsigned)(q3 & 0xff) << 24); }
        *(u32x4*)(Q + (size_t)r * D + 16 * lane) = (u32x4){w[0], w[1], w[2], w[3]};
        if (lane == 0) scale[r] = am * (1.0f / 127.0f);
    }
}

constexpr int CW_TEAM = 3200;
__device__ __forceinline__ void team_barrier(unsigned* ctr, unsigned n, int tid) {
    asm volatile("s_waitcnt vmcnt(0)" ::: "memory");
    __syncthreads();
    if (tid == 0) {
        __builtin_amdgcn_fence(__ATOMIC_RELEASE, "agent");
        asm volatile("s_waitcnt vmcnt(0)" ::: "memory");
        (void)__hip_atomic_fetch_add(ctr, 1u, __ATOMIC_RELAXED, __HIP_MEMORY_SCOPE_AGENT);
        unsigned sp = 0;
        while (__hip_atomic_load(ctr, __ATOMIC_RELAXED, __HIP_MEMORY_SCOPE_AGENT) < n) { __builtin_amdgcn_s_sleep(2); if (++sp > (1u << 20)) break; }
        __builtin_amdgcn_fence(__ATOMIC_ACQUIRE, "agent");
        asm volatile("s_waitcnt vmcnt(0)" ::: "memory");
    }
    __syncthreads();
}

struct Args { const float* in[32]; float* out; unsigned char* ws; int ph_lo, ph_hi; };

enum Phase { PH_PRO = 0, PH_NORM1_L0, PH_WIN_L0, PH_MIX_L0, PH_CARRY_L0, PH_CFIN_L0, PH_WOUT_L0, PH_NORM2_L0, PH_FFNUP, PH_FFNDOWN,
             PH_NORM1_L1, PH_WIN_L1, PH_MIX_L1, PH_CARRY_L1, PH_CFIN_L1, PH_WOUT_L1, PH_NORM2_L1, PH_MOE_UP, PH_MOE_DOWN, PH_FINAL, PH_COUNT };

constexpr int I_IN = (D / 64) * (WIN / 32), I_OUT = (D / 64) * (D / 32), I_13 = (D / 64) * (DFF / 32), I_2 = (DFF / 64) * (D / 32), I_E = 2 * I_13 + I_2;
constexpr int CONV_Q0 = I_IN;
constexpr int CONV_DENSE_END = 2 * I_IN + 2 * I_OUT + 2 * I_13 + I_2;
constexpr int CONV_TOTAL = CONV_DENSE_END + NE * I_E;
constexpr int CW_CQ = 3072;
__device__ __forceinline__ void conv_item(const float* const* in, unsigned char* ws, int r, LAS float* scr, int lane) {
    if (r < 2 * I_IN) { const int l = r / I_IN; if (WIN8) transpose_item8(in[8] + (size_t)l * D * WIN, D, WIN, ws + WS_WIN + (size_t)l * WIN * D, 0, scr, r % I_IN, lane); else transpose_item(in[8] + (size_t)l * D * WIN, D, WIN, (bf16_t*)(ws + WS_WIN) + (size_t)l * WIN * D, 3, scr, r % I_IN, lane); return; } r -= 2 * I_IN;
    if (r < 2 * I_OUT) { const int l = r / I_OUT; transpose_item(in[22] + (size_t)l * D * D, D, D, (bf16_t*)(ws + WS_WOUT) + (size_t)l * D * D, 0, scr, r % I_OUT, lane); return; } r -= 2 * I_OUT;
    if (r < I_13) { if (DENSE_UP8) transpose_item8(in[23], D, DFF, ws + WS_W13, 1, scr, r, lane); else transpose_item(in[23], D, DFF, (bf16_t*)(ws + WS_W13), 1, scr, r, lane); return; } r -= I_13;
    if (r < I_13) { if (DENSE_UP8) transpose_item8(in[24], D, DFF, ws + WS_W13, 2, scr, r, lane); else transpose_item(in[24], D, DFF, (bf16_t*)(ws + WS_W13), 2, scr, r, lane); return; } r -= I_13;
    if (r < I_2) { if (DENSE_DOWN8) transpose_item8(in[25], DFF, D, ws + WS_W2, 0, scr, r, lane); else transpose_item(in[25], DFF, D, (bf16_t*)(ws + WS_W2), 0, scr, r, lane); return; } r -= I_2;
    { const int e = r / I_E; int q = r % I_E; unsigned char* eb = ws + WS_WMOE + (size_t)e * EXP_STRIDE;
      if (q < I_13) { transpose_item8(in[28] + (size_t)e * D * DFF, D, DFF, eb, 1, scr, q, lane); return; } q -= I_13;
      if (q < I_13) { transpose_item8(in[29] + (size_t)e * D * DFF, D, DFF, eb, 2, scr, q, lane); return; } q -= I_13;
      transpose_item8(in[30] + (size_t)e * DFF * D, DFF, D, eb + EXP_W2_OFF, 0, scr, q, lane); }
}
__device__ __forceinline__ void conv_static(const float* const* in, unsigned char* ws, int lo, int hi, int first_block, int G, LAS unsigned char* lds, int wave, int lane) {
    if ((int)blockIdx.x < first_block) return;
    LAS float* scr = (LAS float*)(lds + wave * 16384);
    const int rank = ((int)blockIdx.x - first_block) * NWAVES + wave, stride = (G - first_block) * NWAVES;
#pragma unroll 1
    for (int it = lo + rank; it < hi; it += stride) conv_item(in, ws, it, scr, lane);
}

constexpr int CQ_CH = 2 * NWAVES, CQ_NCHUNK = (NE * I_E) / CQ_CH, CW_CQ2 = 7552, CW_DONE = 8064;
static_assert((NE * I_E) % CQ_CH == 0 && CQ_NCHUNK % 8 == 0, "conversion chunks");
__device__ __forceinline__ void conv_pull(const float* const* in, unsigned char* ws, unsigned* ctl, LAS unsigned char* lds, int tid, int wave, int lane, unsigned* done_ctr, unsigned done_target) {
    LAS float* scr = (LAS float*)(lds + wave * 16384);
    volatile LAS int* slot = (volatile LAS int*)(lds + LDS_BYTES - 64);
    const int x = (int)blockIdx.x & 7;
#pragma unroll 1
    for (;;) {
        __syncthreads();
        if (tid == 0) {
            int c = -1;
            const bool stop = done_ctr != nullptr && __hip_atomic_load(done_ctr, __ATOMIC_RELAXED, __HIP_MEMORY_SCOPE_AGENT) >= done_target;
            if (!stop) { const unsigned j = __hip_atomic_fetch_add(ctl + CW_CQ2 + x * 64, 1u, __ATOMIC_RELAXED, __HIP_MEMORY_SCOPE_AGENT); if (j < (unsigned)(CQ_NCHUNK / 8)) c = (int)(j * 8u) + x; }
            *slot = c;
        }
        __syncthreads();
        const int c = *slot;
        if (c < 0) break;
#pragma unroll 1
        for (int k = 0; k < CQ_CH / NWAVES; ++k) conv_item(in, ws, CONV_DENSE_END + c * CQ_CH + k * NWAVES + wave, scr, lane);
    }
}

__global__ void __launch_bounds__(NTHREADS, 2) fwd(Args args) {
    extern __shared__ __attribute__((aligned(16))) unsigned char lds_raw[];
    LAS unsigned char* lds = (LAS unsigned char*)lds_raw;
    const int tid = threadIdx.x, lane = tid & 63, wave = __builtin_amdgcn_readfirstlane(tid >> 6);
    const int G = gridDim.x;
    unsigned char* ws = args.ws;
    const int lo = args.ph_lo, hi = args.ph_hi;
#ifdef ONLY_PHASE
#define IN(k) ((k) == ONLY_PHASE && lo <= (k) && (k) < hi)
#else
#define IN(k) (lo <= (k) && (k) < hi)
#endif
    float* xl = args.out; float* xctx = (float*)(ws + WS_XCTX);
    float* modv = (float*)(ws + WS_MODV);
    unsigned* ctl = (unsigned*)(ws + WS_CTL);
    unsigned char* route = ws + WS_ROUTE;
    bf16_t* hbuf = (bf16_t*)(ws + WS_HBUF);
    bf16_t* proj = (bf16_t*)(ws + WS_BIG);
    unsigned char* H8 = ws + WS_BIG;
    bf16_t* Yb = (bf16_t*)(ws + WS_Y);
    unsigned char* H8m = ws + WS_H8MOE;
    bf16_t* x16 = (bf16_t*)(ws + WS_X16);
    volatile LAS unsigned* xb_st = (volatile LAS unsigned*)(lds + LDS_BYTES - 16);
    if (tid == 0) { xb_st[0] = 0u; xb_st[1] = 0u; xb_st[2] = 0u; xb_st[3] = 0u; }
    __syncthreads();
    XcdBarrier bar = xcd_barrier_post(ctl + CW_BAR, xb_st);
#define SEAM(k) if (IN(k) && IN((k) + 1)) xcd_barrier(bar);
#define REP(k) for (int rep_ = 0, nrep_ = ((DUPMASK >> (k)) & 1u) ? 2 : 1; rep_ < nrep_; ++rep_, (rep_ < nrep_ ? xcd_barrier(bar) : (void)0))

    if (IN(PH_PRO)) REP(PH_PRO) {
        if (blockIdx.x < 192) mod_task(lds, tid, wave, lane, (int)blockIdx.x, args.in[1], args.in[3], args.in[4], args.in[5], modv);
        LAS float* scr = (LAS float*)(lds + wave * 16384);
        const int gw = blockIdx.x * NWAVES + wave, NGW = G * NWAVES;
#pragma unroll 1
        for (int it = gw; it < CONV_DENSE_END; it += NGW) conv_item(args.in, ws, it, scr, lane);
        bf16_t* gwt = (bf16_t*)(ws + WS_LRUW);
        for (int i = blockIdx.x * NTHREADS + tid; i < 2 * 2 * 2 * 8 * 4096; i += G * NTHREADS) {
            const int k = i & 63, n = (i >> 6) & 63, h = (i >> 12) & 7, mat = (i >> 15) & 1, dir = (i >> 16) & 1, l = i >> 17;
            const float* src = (mat == 0 ? args.in[16] : args.in[18]) + ((size_t)((l * 2 + dir) * 8 + h) * 64 + k) * 64 + n;
            gwt[i] = f2bf(-LOG2E * *src);
        }
        float* gconst = (float*)(ws + WS_GCONST);
        for (int i = blockIdx.x * NTHREADS + tid; i < 2 * 2 * 3 * LRU; i += G * NTHREADS) {
            const int c = i & 511, which = (i >> 9) % 3, ld = (i >> 9) / 3;
            float v;
            if (which == 0) v = -LOG2E * args.in[17][ld * LRU + c];
            else if (which == 1) v = -LOG2E * args.in[19][ld * LRU + c];
            else { const float L = args.in[20][ld * LRU + c]; v = 8.0f * LOG2E * (fminf(L, 0.f) - log1pf(__expf(-fabsf(L)))); }
            gconst[i] = v;
        }
    }
#define GEMM_WIN(l) { constexpr int KB = WIN8 ? D : 2 * D; pg8::DenseSched S; S.init(hbuf, ws + WS_WIN + (size_t)(l) * WIN * KB, MA, WIN, KB, G, (int)blockIdx.x); \
        pg8::EpiProjFused E{proj}; pg8::gemm_phase<WIN8>(lds, KB, S, E); }
#define TAILFILL(k) { if (tid == 0) (void)__hip_atomic_fetch_add(ctl + CW_DONE + (k) * 16, 1u, __ATOMIC_RELAXED, __HIP_MEMORY_SCOPE_AGENT); \
        conv_pull(args.in, ws, ctl, lds, tid, wave, lane, ctl + CW_DONE + (k) * 16, (unsigned)G); }
#define GEMM_WIN_I8(l) { pg8::DenseSched S; S.init(hbuf, ws + WS_WINQ + (size_t)(l) * WIN * D, MA, WIN, D, G, (int)blockIdx.x); \
        pg8::EpiProjFusedI8 E{proj, (const float*)(ws + WS_RS1), (const float*)(ws + WS_WINQS) + (l) * WIN}; pg8::gemm_phase<2>(lds + 4096, D, S, E); }
#define MIXARGS(l) MixArgs m; m.proj = proj; m.ybuf = hbuf; m.conf_w = args.in[9] + (l) * CONFK * 256; m.conf_b = args.in[10] + (l) * 256; m.ln_g = args.in[11] + (l) * 256; m.ln_b = args.in[12] + (l) * 256; \
        m.sconv_w = args.in[13] + (l) * 3 * 256; m.g_mix = args.in[21] + (l) * D; m.cw = args.in[14] + (l) * 4 * LRU; m.cb = args.in[15] + (l) * LRU; \
        m.gwt = (const bf16_t*)(ws + WS_LRUW) + (size_t)(l) * 2 * 2 * 8 * 4096; m.gconst = (const float*)(ws + WS_GCONST) + (l) * 2 * 3 * LRU; \
        m.SA = (float*)(ws + WS_SUMM); m.SB = (float*)(ws + WS_SUMM) + 2 * NB * NPOS * LRU; m.CR = (float*)(ws + WS_CR); m.AB = (unsigned*)(ws + WS_BIG + 116 * MiB);
    SEAM(PH_PRO)
    if (IN(PH_NORM1_L0)) REP(PH_NORM1_L0) { norm_phase<false, WINI8_L0 ? 2 : (WIN8 ? 1 : 0)>(lds, tid, wave, lane, G, args.in[0], args.in[2], args.in[6], modv, M_SH1, M_SC1, hbuf, MA, nullptr, nullptr, ctl, route, (float*)(ws + WS_RS1), true);
        if (DENSE_UPI8) quant_rows_i8((const bf16_t*)(ws + WS_W13), ws + WS_W13Q, (float*)(ws + WS_W13QS), 2 * DFF, (int)blockIdx.x * NWAVES + wave, G * NWAVES, lane);
        if (WINI8_L0) quant_rows_i8((const bf16_t*)(ws + WS_WIN), ws + WS_WINQ, (float*)(ws + WS_WINQS), WIN, (int)blockIdx.x * NWAVES + wave, G * NWAVES, lane);
        if (WINI8_L1) quant_rows_i8((const bf16_t*)(ws + WS_WIN) + (size_t)WIN * D, ws + WS_WINQ + (size_t)WIN * D, (float*)(ws + WS_WINQS) + WIN, WIN, (int)blockIdx.x * NWAVES + wave, G * NWAVES, lane); }
    SEAM(PH_NORM1_L0)
    if (IN(PH_WIN_L0)) REP(PH_WIN_L0) { if constexpr (WINI8_L0) GEMM_WIN_I8(0) else GEMM_WIN(0) TAILFILL(0) }
    SEAM(PH_WIN_L0)
    if (IN(PH_MIX_L0)) REP(PH_MIX_L0) { MIXARGS(0) mix_phase(lds, tid, wave, lane, G, m, MA / 32, ctl + CW_WQ); }
    SEAM(PH_MIX_L0)
    if (IN(PH_CARRY_L0)) REP(PH_CARRY_L0) { MIXARGS(0) carry_phase(lds, tid, wave, lane, G, m, 1, MA / 64); }
    SEAM(PH_CARRY_L0)
    if (IN(PH_CFIN_L0)) REP(PH_CFIN_L0) { MIXARGS(0) cfin_phase(lds, tid, wave, lane, G, m); }
    SEAM(PH_CFIN_L0)
    if (IN(PH_WOUT_L0)) REP(PH_WOUT_L0) { pg8::DenseSched S; S.init(hbuf, (const bf16_t*)(ws + WS_WOUT), ML, D, 2 * D, G, (int)blockIdx.x);
        pg8::EpiRes16<true> E{args.in[0], args.in[2], x16, modv + M_GT1, 1.0f, 0}; pg8::gemm_phase<false>(lds, 2 * D, S, E); }
    SEAM(PH_WOUT_L0)
    if (IN(PH_NORM2_L0)) {
        constexpr int OM = DENSE_UPI8 ? 2 : (DENSE_UP8 ? 1 : 0);
        if (blockIdx.x < 16) {
            { pg8::DenseSched S; S.init(hbuf, (const bf16_t*)(ws + WS_WOUT), MC, D, 2 * D, 16, (int)blockIdx.x, ML / 256);
              pg8::EpiRes16<true> E{args.in[0], args.in[2], x16, modv + M_GT1, 1.0f, 0}; pg8::gemm_phase<false>(lds, 2 * D, S, E); }
            team_barrier(ctl + CW_TEAM, 16u, tid);
            norm_phase<false, OM>(lds, tid, wave, lane, G, xl, xctx, args.in[7], modv, M_SH2, M_SC2, hbuf, MC, nullptr, nullptr, ctl, route, (float*)(ws + WS_RS), false, x16, 0, 16, ML);
        } else norm_phase<false, OM>(lds, tid, wave, lane, G, xl, xctx, args.in[7], modv, M_SH2, M_SC2, hbuf, ML, nullptr, nullptr, ctl, route, (float*)(ws + WS_RS), false, x16, 16, G - 16, 0);
        TAILFILL(4)
    }
    SEAM(PH_NORM2_L0)
    if (IN(PH_FFNUP)) REP(PH_FFNUP) {
        if constexpr (DENSE_UPI8) { pg8::DenseSched S; S.init(hbuf, ws + WS_W13Q, MA, 2 * DFF, D, G, (int)blockIdx.x);
            pg8::EpiSwigluI8<DENSE_DOWN8> E{(void*)H8, DFF, (const float*)(ws + WS_RS), (const float*)(ws + WS_W13QS)}; pg8::gemm_phase<2>(lds + 4096, D, S, E); }
        else { constexpr int KB = DENSE_UP8 ? D : 2 * D; pg8::DenseSched S; S.init(hbuf, ws + WS_W13, MA, 2 * DFF, KB, G, (int)blockIdx.x);
        if constexpr (DENSE_DOWN8) { pg8::EpiSwiglu8 E{H8, DFF, DENSE_UP8 ? 1.0f / FP8_SW : 1.0f, FP8_SH}; pg8::gemm_phase<DENSE_UP8>(lds, KB, S, E); }
        else { pg8::EpiSwiglu E{(bf16_t*)H8, DFF, DENSE_UP8 ? 1.0f / FP8_SW : 1.0f}; pg8::gemm_phase<DENSE_UP8>(lds, KB, S, E); } }
        TAILFILL(2) }
    SEAM(PH_FFNUP)
    if (IN(PH_FFNDOWN)) REP(PH_FFNDOWN) { constexpr int KB = DENSE_DOWN8 ? DFF : 2 * DFF; pg8::DenseSched S; S.init(H8, ws + WS_W2, ML, D, KB, G, (int)blockIdx.x);
        pg8::EpiRes16<false> E{nullptr, nullptr, x16, modv + M_GT2, DENSE_DOWN8 ? 1.0f / (FP8_SW * FP8_SH) : 1.0f, 0}; pg8::gemm_phase<DENSE_DOWN8>(lds, KB, S, E); }
    SEAM(PH_FFNDOWN)
    if (IN(PH_NORM1_L1)) {
        if (blockIdx.x < 16) {
            { constexpr int KB = DENSE_DOWN8 ? DFF : 2 * DFF; pg8::DenseSched S; S.init(H8, ws + WS_W2, MC, D, KB, 16, (int)blockIdx.x, ML / 256);
              pg8::EpiRes16<false> E{nullptr, nullptr, x16, modv + M_GT2, DENSE_DOWN8 ? 1.0f / (FP8_SW * FP8_SH) : 1.0f, 0}; pg8::gemm_phase<DENSE_DOWN8>(lds, KB, S, E); }
            team_barrier(ctl + CW_TEAM + 64, 16u, tid);
            norm_phase<false, WINI8_L1 ? 2 : (WIN8 ? 1 : 0)>(lds, tid, wave, lane, G, xl, xctx, args.in[6] + D, modv + 5 * 6144, M_SH1, M_SC1, hbuf, MC, nullptr, nullptr, ctl, route, (float*)(ws + WS_RS1), false, x16, 0, 16, ML);
        } else {
            norm_phase<false, WINI8_L1 ? 2 : (WIN8 ? 1 : 0)>(lds, tid, wave, lane, G, xl, xctx, args.in[6] + D, modv + 5 * 6144, M_SH1, M_SC1, hbuf, ML, nullptr, nullptr, ctl, route, (float*)(ws + WS_RS1), false, x16, 16, G - 16, 0);
        }
        TAILFILL(3)
    }
    SEAM(PH_NORM1_L1)
    if (IN(PH_WIN_L1)) REP(PH_WIN_L1) { if constexpr (WINI8_L1) GEMM_WIN_I8(1) else GEMM_WIN(1) TAILFILL(1) }
    SEAM(PH_WIN_L1)
    if (IN(PH_MIX_L1)) REP(PH_MIX_L1) { MIXARGS(1) mix_phase(lds, tid, wave, lane, G, m, ML / 32, ctl + CW_WQ + 64); }
    SEAM(PH_MIX_L1)
    if (IN(PH_CARRY_L1)) REP(PH_CARRY_L1) { MIXARGS(1) carry_phase(lds, tid, wave, lane, G, m, 0, ML / 64); }
    SEAM(PH_CARRY_L1)
    if (IN(PH_CFIN_L1)) REP(PH_CFIN_L1) { MIXARGS(1) cfin_phase(lds, tid, wave, lane, G, m); }
    SEAM(PH_CFIN_L1)
    if (IN(PH_WOUT_L1)) REP(PH_WOUT_L1) { pg8::DenseSched S; S.init(hbuf, (const bf16_t*)(ws + WS_WOUT) + (size_t)D * D, ML, D, 2 * D, G, (int)blockIdx.x);
        pg8::EpiRes16<false> E{nullptr, nullptr, x16, modv + 5 * 6144 + M_GT1, 1.0f, 0}; pg8::gemm_phase<false>(lds, 2 * D, S, E); }
    SEAM(PH_WOUT_L1)
    if (IN(PH_NORM2_L1)) REP(PH_NORM2_L1) { norm_phase<true, 1>(lds, tid, wave, lane, G, xl, xctx, args.in[7] + D, modv + 5 * 6144, M_SH2, M_SC2, hbuf, ML, args.in[26], args.in[27], ctl, route, nullptr, false, x16);
        conv_pull(args.in, ws, ctl, lds, tid, wave, lane, nullptr, 0u); }
    SEAM(PH_NORM2_L1)
    if (IN(PH_MOE_UP)) REP(PH_MOE_UP) { pg8::MoeUpSched S; S.init(hbuf, ws + WS_WMOE, (const int*)(route + RT_IDX), ctl, G, (int)blockIdx.x);
        pg8::EpiSwiglu8 E{H8m, DFF, 1.0f / FP8_SW, FP8_SH}; pg8::gemm_phase<true>(lds + 2048, D, S, E); }
    SEAM(PH_MOE_UP)
    if (IN(PH_MOE_DOWN)) REP(PH_MOE_DOWN) { pg8::MoeDownSched S; S.init(H8m, ws + WS_WMOE, ctl, G, (int)blockIdx.x);
        pg8::EpiBf16Store E{Yb, D, 1.0f / (FP8_SW * FP8_SH), (bf16_t*)(ws + WS_YP)}; pg8::gemm_phase<true>(lds, DFF, S, E); }
    SEAM(PH_MOE_DOWN)
    if (IN(PH_FINAL)) REP(PH_FINAL) final_phase(lds, tid, (const bf16_t*)(ws + WS_YP), wave, lane, G, xl, x16, Yb, modv + 5 * 6144 + M_GT2, args.in[31], ctl, route);
#undef IN
}

static_assert(CW_CQ2 >= CW_BAR + XCD_BAR_WORDS && CW_CQ2 + 8 * 64 <= CW_DONE && (CW_DONE + 8 * 16) * 4 <= 32 * 1024 && (CW_BAR + XCD_BAR_WORDS) * 4 <= 32 * 1024 && (CW_TEAM + 3 * 64) < CW_BAR && CW_CQ < CW_TEAM && (CW_WQ + 128) <= CW_CQ && (CW_CNT + 8 * 64) <= CW_WQ, "control words inside the per-call memset");
extern "C" void kernel_launch(void* const* d_in, const int* in_sizes, int n_in, void* d_out, int out_size, void* d_ws, size_t ws_size, hipStream_t stream) {
    static int grid = 0;
    if (grid == 0) {
        int dev = 0, cus = 0; (void)hipGetDevice(&dev); (void)hipDeviceGetAttribute(&cus, hipDeviceAttributeMultiprocessorCount, dev);
        (void)hipFuncSetAttribute((const void*)fwd, hipFuncAttributeMaxDynamicSharedMemorySize, LDS_BYTES);
        int per_cu = 0;
        (void)hipOccupancyMaxActiveBlocksPerMultiprocessor(&per_cu, (const void*)fwd, NTHREADS, LDS_BYTES);
        grid = cus > 0 ? cus : 256;
        if (per_cu < 1) fprintf(stderr, "kernel_launch: occupancy query reports %d blocks per CU\n", per_cu);
    }
    Args a{};
    for (int i = 0; i < 32; ++i) a.in[i] = (const float*)d_in[i];
    a.out = (float*)d_out; a.ws = (unsigned char*)d_ws;
    (void)hipMemsetAsync((char*)d_ws + WS_CTL, 0, 32 * 1024, stream);
#ifdef MULTI_LAUNCH
    for (int ph = 0; ph < PH_COUNT; ++ph) { a.ph_lo = ph; a.ph_hi = ph + 1; hipLaunchKernelGGL(fwd, dim3(grid), dim3(NTHREADS), LDS_BYTES, stream, a); }
#else
    a.ph_lo = 0; a.ph_hi = PH_COUNT; hipLaunchKernelGGL(fwd, dim3(grid), dim3(NTHREADS), LDS_BYTES, stream, a);
#endif
}
```

```cpp
#include <hip/hip_runtime.h>
#include <stdint.h>
#include <cstdio>

constexpr int D = 1024, NB = 4, SEQ = 8192, CTXL = 256, GW = 64;
constexpr int ML = NB * SEQ;
constexpr int MC = NB * CTXL;
constexpr int MA = ML + MC;
constexpr int WIN = 2304, DFF = 2816, NE = 8, LRU = 512;
constexpr int CONFK = 31;
constexpr float EPS = 1e-6f;
constexpr int C_AVAL = 0, C_AGATE = 256, C_SBG = 512, C_SCG = 768, C_SX = 1024, C_CX = 1280, C_CG = 1792;
constexpr int PW = 1792, P_GLU = 0, P_V = 256, P_SBG = 512, P_CX = 768, P_CG = 1280;
constexpr int M_SH1 = 0, M_SC1 = 1024, M_GT1 = 2048, M_SH2 = 3072, M_SC2 = 4096, M_GT2 = 5120;

typedef unsigned short bf16_t;
typedef short bf16x8 __attribute__((ext_vector_type(8)));
typedef float f32x4 __attribute__((ext_vector_type(4)));
typedef float f32x2 __attribute__((ext_vector_type(2)));

__device__ __forceinline__ bf16_t f2bf(float f) { unsigned u = __builtin_bit_cast(unsigned, f); return (bf16_t)((u + 0x7fffu + ((u >> 16) & 1u)) >> 16); }
__device__ __forceinline__ float bf2f(bf16_t b) { return __builtin_bit_cast(float, ((unsigned)b) << 16); }
__device__ __forceinline__ float sigmoidf_(float x) { return 1.0f / (1.0f + __expf(-x)); }
__device__ __forceinline__ float siluf_(float x) { return x * sigmoidf_(x); }
__device__ __forceinline__ float gelu_tanh(float x) { const float u = 0.7978845608028654f * (x + 0.044715f * x * x * x); return 0.5f * x * (1.0f + tanhf(u)); }
__device__ __forceinline__ float wave_sum(float v) {
#pragma unroll
    for (int o = 1; o < 64; o <<= 1) v += __shfl_xor(v, o);
    return v;
}

__device__ __forceinline__ int row_modidx(int r) { return r < ML ? r / SEQ : 4; }


#define LAS __attribute__((address_space(3)))
typedef unsigned u32x4 __attribute__((ext_vector_type(4)));
typedef unsigned u32x2 __attribute__((ext_vector_type(2)));
typedef int v4i_t __attribute__((ext_vector_type(4)));
typedef int v8i_t __attribute__((ext_vector_type(8)));
constexpr int NWAVES = 8, NTHREADS = 512;
constexpr int LDS_BYTES = 160 * 1024;

__device__ __forceinline__ unsigned cvt_pk_bf16(float lo, float hi) { unsigned r; asm volatile("v_cvt_pk_bf16_f32 %0, %1, %2" : "=v"(r) : "v"(lo), "v"(hi)); return r; }
__device__ __forceinline__ float fast_silu(float x) { return x * __builtin_amdgcn_rcpf(1.0f + __expf(-x)); }

constexpr float FP8_SW = 64.0f, FP8_SH = 8.0f;
namespace pg8 {
constexpr int BM = 256, BK = 64, HALF = 128, HTB = HALF * BK * 2, STAGE_BYTES = 8 * HTB, NXCD = 8, WGM = 4;
__device__ __forceinline__ int lds_byte(int r, int c) { const int st = (r >> 4) * 2 + (c >> 5), rr = r & 15, cc = c & 31, ob = rr * 64 + cc * 2; return st * 1024 + (ob ^ (((ob >> 9) & 1) << 5)); }
__device__ __forceinline__ void stage_rc(int b, int& R, int& C) { const int st = b / 1024, sb = b % 1024, swz = sb ^ (((sb >> 9) & 1) << 5); R = (st >> 1) * 16 + swz / 64; C = (st & 1) * 32 + (swz % 64) / 2; }
__device__ __forceinline__ int perm32(int rho) { const int n = rho >> 4, i = rho & 15; return 8 * (i >> 2) + 4 * n + (i & 3); }

constexpr int SC_OFF = -4096;
constexpr int IDX_OFF = -2048;
struct Unit { int pm, pn; const char* a; const char* b; int e, rb, cnt; };

struct Order {
    int nM, nN, nwg, G, c;
    __device__ __forceinline__ void init(int nM_, int nN_, int G_, int c_) { nM = nM_; nN = nN_; nwg = nM * nN; G = G_; c = c_; }
    __device__ __forceinline__ bool lin(int i, int& pm, int& pn) const {
        const long L = (long)i * G + c; if (L >= nwg) return false;
        int wgid = (int)L; { const int q = nwg / NXCD, r = nwg % NXCD, xcd = wgid % NXCD, off = wgid / NXCD; wgid = (xcd < r ? xcd * (q + 1) : r * (q + 1) + (xcd - r) * q) + off; }
        const int nig = WGM * nN, gid = wgid / nig, fm = gid * WGM, gsz = (nM - fm) < WGM ? (nM - fm) : WGM;
        pm = fm + ((wgid % nig) % gsz); pn = (wgid % nig) / gsz; return true;
    }
};
struct DenseSched {
    static constexpr bool GATHER = false;
    Order o; const char* A; const char* Bt; size_t tstep; int pm_off;
    __device__ __forceinline__ void init(const void* A_, const void* Bt_, int M, int N, int KB, int G, int c, int pm_off_ = 0) { o.init(M / BM, N / BM, G, c); A = (const char*)A_; Bt = (const char*)Bt_; tstep = (size_t)BM * KB; pm_off = pm_off_; }
    __device__ __forceinline__ bool next(int i, Unit& u) const { if (!o.lin(i, u.pm, u.pn)) return false; u.pm += pm_off; u.a = A + (size_t)u.pm * tstep; u.b = Bt + (size_t)u.pn * tstep; u.e = 0; u.rb = 0; u.cnt = 0; return true; }
    __device__ __forceinline__ unsigned arow(const Unit&, int r) const { return (unsigned)r; }
    __device__ __forceinline__ void a_ready(const Unit&) const {}
    __device__ __forceinline__ void done(const Unit&) const {}
};

template <int MODE> struct AccT { typedef f32x4 type; };
template <> struct AccT<2> { typedef v4i_t type; };
template <int MODE, class Epi, class Sched>
__device__ __forceinline__ void gemm_phase(LAS unsigned char* lds, const int KB, const Sched& S, const Epi& E) {
    const int tid = threadIdx.x, wid = __builtin_amdgcn_readfirstlane(tid >> 6), lane = tid & 63, wr = wid >> 2, wc = wid & 3, fr = lane & 15, fq = lane >> 4;
    const int nt = KB / (BK * 2);
    int sR[2], sC[2]; unsigned voffB[2];
#pragma unroll
    for (int i = 0; i < 2; ++i) { stage_rc(tid * 16 + i * 8192, sR[i], sC[i]); const int Rb = Epi::PERM ? ((sR[i] & ~31) + perm32(sR[i] & 31)) : sR[i]; voffB[i] = (unsigned)(Rb * KB) + (unsigned)sC[i] * 2u; }
    const size_t kstep = (size_t)(BK * 2);
    const size_t hstep = (size_t)HALF * KB;
    const unsigned ldsw = (unsigned)wid * 1024u;
    const int aoff = lds_byte(wr * 64 + fr, fq * 8), boff = lds_byte(wc * 32 + fr, fq * 8);
#define PG8_SA(b, h) (((b) * 2 + (h)) * HTB)
#define PG8_SB(b, h) ((4 + (b) * 2 + (h)) * HTB)
#define PG8_STAGE(bufoff, gbase, voff) do { _Pragma("unroll") for (int _i = 0; _i < 2; ++_i) \
        __builtin_amdgcn_global_load_lds((const unsigned*)((const char*)(gbase) + (voff)[_i]), (LAS unsigned*)(lds + (bufoff) + ldsw + _i * 8192), 16, 0, 0); } while (0)
#define PG8_LDA(dst, b, h) do { _Pragma("unroll") for (int m = 0; m < 4; ++m) _Pragma("unroll") for (int k = 0; k < 2; ++k) dst[m][k] = *(const LAS bf16x8*)(lds + PG8_SA(b, h) + aoff + m * 2048 + k * 1024); } while (0)
#define PG8_LDB(dst, b, h) do { _Pragma("unroll") for (int n = 0; n < 2; ++n) _Pragma("unroll") for (int k = 0; k < 2; ++k) dst[n][k] = *(const LAS bf16x8*)(lds + PG8_SB(b, h) + boff + n * 2048 + k * 1024); } while (0)
#define PG8_MMA(ai, bj, At, Bt) do { __builtin_amdgcn_s_setprio(1); _Pragma("unroll") for (int m = 0; m < 4; ++m) _Pragma("unroll") for (int n = 0; n < 2; ++n) { \
        if constexpr (MODE == 1) { const v8i_t b8 = __builtin_shufflevector(__builtin_bit_cast(v4i_t, Bt[n][0]), __builtin_bit_cast(v4i_t, Bt[n][1]), 0, 1, 2, 3, 4, 5, 6, 7), a8 = __builtin_shufflevector(__builtin_bit_cast(v4i_t, At[m][0]), __builtin_bit_cast(v4i_t, At[m][1]), 0, 1, 2, 3, 4, 5, 6, 7); \
            asm volatile("v_mfma_scale_f32_16x16x128_f8f6f4 %0, %1, %2, %0, %3, %3 op_sel_hi:[0,0,0]" : "+v"(acc[ai][bj][m][n]) : "v"(b8), "v"(a8), "v"(fp8_one)); } \
        else if constexpr (MODE == 2) { _Pragma("unroll") for (int k = 0; k < 2; ++k) acc[ai][bj][m][n] = __builtin_amdgcn_mfma_i32_16x16x64_i8(__builtin_bit_cast(v4i_t, Bt[n][k]), __builtin_bit_cast(v4i_t, At[m][k]), acc[ai][bj][m][n], 0, 0, 0); } \
        else { _Pragma("unroll") for (int k = 0; k < 2; ++k) acc[ai][bj][m][n] = __builtin_amdgcn_mfma_f32_16x16x32_bf16(Bt[n][k], At[m][k], acc[ai][bj][m][n], 0, 0, 0); } } \
        __builtin_amdgcn_s_setprio(0); } while (0)
#define PG8_WAIT_V(n) asm volatile("s_waitcnt vmcnt(" #n ")" ::: "memory")
#define PG8_WAIT_L(n) asm volatile("s_waitcnt lgkmcnt(" #n ")" ::: "memory")
#define PG8_BAR __builtin_amdgcn_s_barrier()
#define PG8_SCHED __builtin_amdgcn_sched_barrier(0)
    const int fp8_one = 0x7f7f7f7f;
    Unit cur, nxt; int ui = 0;
    if (!S.next(0, cur)) return;
    typedef typename AccT<MODE>::type acc_t;
    acc_t acc[2][2][4][2];
#pragma unroll
    for (int a = 0; a < 2; ++a)
#pragma unroll
        for (int b = 0; b < 2; ++b)
#pragma unroll
            for (int m = 0; m < 4; ++m)
#pragma unroll
                for (int n = 0; n < 2; ++n) acc[a][b][m][n] = (acc_t){0, 0, 0, 0};
    bf16x8 At[4][2], B0[2][2], B1[2][2];
    unsigned vA0[2], vA1[2], vA0n[2], vA1n[2];
#pragma unroll
    for (int i = 0; i < 2; ++i) {
        vA0[i] = S.arow(cur, sR[i]) * (unsigned)KB + (unsigned)sC[i] * 2u;
        vA1[i] = S.arow(cur, HALF + sR[i]) * (unsigned)KB + (unsigned)sC[i] * 2u;
        vA0n[i] = vA0[i]; vA1n[i] = vA1[i];
    }
    const char* cA = cur.a; const char* cB = cur.b;
    S.a_ready(cur);
    PG8_STAGE(PG8_SB(0, 0), cB, voffB); PG8_STAGE(PG8_SB(0, 1), cB + hstep, voffB); PG8_STAGE(PG8_SA(0, 0), cA, vA0); PG8_STAGE(PG8_SA(0, 1), cA, vA1);
    if (wr == 1) PG8_BAR;
    PG8_WAIT_V(2); PG8_BAR;
    PG8_STAGE(PG8_SB(1, 0), cB + kstep, voffB); PG8_STAGE(PG8_SA(1, 0), cA + kstep, vA0); PG8_STAGE(PG8_SB(1, 1), cB + hstep + kstep, voffB);
    PG8_WAIT_V(6); PG8_BAR;
    for (;;) {
        const bool has_next = S.next(ui + 1, nxt);
        const char* nA = has_next ? nxt.a : cA; const char* nB = has_next ? nxt.b : cB;
        if constexpr (Epi::SCALES) { if (wid < 2) E.dma(cur, lds + SC_OFF + (ui & 1) * 2048, wid, lane); }
        if constexpr (Sched::GATHER) {
            if (has_next && wid == 0) S.idx_dma(nxt, lds + IDX_OFF + ((ui + 1) & 1) * 1024, lane);
        }
#pragma unroll 1
        for (int t = 0; t < nt; t += 2) {
            const bool last = (t == nt - 2);
            const char* a1 = cA + (size_t)(t + 1) * kstep;
            const char* a2 = last ? nA : cA + (size_t)(t + 2) * kstep; const char* b2 = last ? nB : cB + (size_t)(t + 2) * kstep;
            const char* a3 = a2 + kstep; const char* b3 = b2 + kstep;
            if constexpr (Sched::GATHER) {
                if (last && has_next) {
                    const LAS int* ix = (const LAS int*)(lds + IDX_OFF + ((ui + 1) & 1) * 1024);
#pragma unroll
                    for (int i = 0; i < 2; ++i) {
                        vA0n[i] = S.arow_lds(nxt, sR[i], ix) * (unsigned)KB + (unsigned)sC[i] * 2u;
                        vA1n[i] = S.arow_lds(nxt, HALF + sR[i], ix) * (unsigned)KB + (unsigned)sC[i] * 2u;
                    }
                }
            }
            unsigned w0[2], w1[2];
#pragma unroll
            for (int i = 0; i < 2; ++i) { w0[i] = (Sched::GATHER && last) ? vA0n[i] : vA0[i]; w1[i] = (Sched::GATHER && last) ? vA1n[i] : vA1[i]; }
            if (last && has_next) S.a_ready(nxt);
            PG8_LDB(B0, 0, 0); PG8_LDB(B1, 0, 1); PG8_SCHED; PG8_LDA(At, 0, 0); PG8_STAGE(PG8_SA(1, 1), a1, vA1);
            PG8_WAIT_V(8); PG8_WAIT_L(0); PG8_BAR; PG8_MMA(0, 0, At, B0); PG8_MMA(0, 1, At, B1); PG8_BAR; PG8_SCHED;
            PG8_LDA(At, 0, 1); PG8_STAGE(PG8_SB(0, 0), b2, voffB); PG8_STAGE(PG8_SB(0, 1), b2 + hstep, voffB); PG8_STAGE(PG8_SA(0, 0), a2, w0);
            PG8_WAIT_V(8); PG8_WAIT_L(0); PG8_BAR; PG8_MMA(1, 0, At, B0); PG8_MMA(1, 1, At, B1); PG8_BAR; PG8_SCHED;
            PG8_LDB(B0, 1, 0); PG8_LDB(B1, 1, 1); PG8_SCHED; PG8_LDA(At, 1, 0); PG8_STAGE(PG8_SA(0, 1), a2, w1);
            PG8_WAIT_V(8); PG8_WAIT_L(0); PG8_BAR; PG8_MMA(0, 0, At, B0); PG8_MMA(0, 1, At, B1); PG8_BAR; PG8_SCHED;
            PG8_LDA(At, 1, 1); PG8_STAGE(PG8_SB(1, 0), b3, voffB); PG8_STAGE(PG8_SB(1, 1), b3 + hstep, voffB); PG8_STAGE(PG8_SA(1, 0), a3, w0);
            PG8_WAIT_V(8); PG8_WAIT_L(0); PG8_BAR; PG8_MMA(1, 0, At, B0); PG8_MMA(1, 1, At, B1); PG8_BAR; PG8_SCHED;
        }
        if constexpr (MODE == 1) asm volatile("s_nop 15\n\ts_nop 15" ::: "memory");
        if (wr == 0) PG8_BAR;
        if constexpr (Epi::SCALES) E(acc, cur, wr, wc, fr, fq, (const LAS float*)(lds + SC_OFF + (ui & 1) * 2048)); else E(acc, cur, wr, wc, fr, fq);
        S.done(cur);
        if (!has_next) break;
#pragma unroll
        for (int a = 0; a < 2; ++a)
#pragma unroll
            for (int b = 0; b < 2; ++b)
#pragma unroll
                for (int m = 0; m < 4; ++m)
#pragma unroll
                    for (int n = 0; n < 2; ++n) acc[a][b][m][n] = (acc_t){0, 0, 0, 0};
        cur = nxt; cA = nA; cB = nB; ++ui;
#pragma unroll
        for (int i = 0; i < 2; ++i) { vA0[i] = vA0n[i]; vA1[i] = vA1n[i]; }
        if (wr == 1) PG8_BAR;
    }
    PG8_WAIT_V(0);
    PG8_BAR;
#undef PG8_SA
#undef PG8_SB
#undef PG8_STAGE
#undef PG8_LDA
#undef PG8_LDB
#undef PG8_MMA
#undef PG8_WAIT_V
#undef PG8_WAIT_L
#undef PG8_BAR
#undef PG8_SCHED
}

struct EpiBf16Store {
    static constexpr bool PERM = true; static constexpr bool SCALES = false;
    bf16_t* O; int ldo; float sc;
    __device__ __forceinline__ void operator()(const f32x4 (&acc)[2][2][4][2], const Unit& u, int wr, int wc, int fr, int fq) const {
        const int row0 = u.pm * BM + wr * 64 + fr, col0 = u.pn * BM + wc * 32 + 8 * fq;
#pragma unroll
        for (int ai = 0; ai < 2; ++ai)
#pragma unroll
            for (int m = 0; m < 4; ++m) { bf16_t* rowp = O + (size_t)(row0 + ai * HALF + m * 16) * ldo + col0;
#pragma unroll
                for (int bj = 0; bj < 2; ++bj) { const f32x4 v0 = acc[ai][bj][m][0] * sc, v1 = acc[ai][bj][m][1] * sc;
                    u32x4 w; w.x = cvt_pk_bf16(v0[0], v0[1]); w.y = cvt_pk_bf16(v0[2], v0[3]); w.z = cvt_pk_bf16(v1[0], v1[1]); w.w = cvt_pk_bf16(v1[2], v1[3]);
                    *(u32x4*)(rowp + bj * HALF) = w; } }
    }
};
struct EpiRes {
    static constexpr bool PERM = false; static constexpr bool SCALES = false;
    const float* xin_l; const float* xin_c; float* xout_l; float* xout_c; const float* gate; float sc; int nt_in;
    __device__ __forceinline__ void operator()(const f32x4 (&acc)[2][2][4][2], const Unit& u, int wr, int wc, int fr, int fq) const {
        const int trow = u.pm * BM; const bool isc = trow >= ML;
        const int modrow = isc ? 4 : trow / SEQ;
        const float* xi = isc ? xin_c : xin_l; float* xo = isc ? xout_c : xout_l;
        const int row0 = (isc ? trow - ML : trow) + wr * 64 + fr, col0 = u.pn * BM + wc * 32 + 4 * fq;
        const float* gp = gate + (size_t)modrow * 6144 + col0;
        f32x4 gv[2][2];
#pragma unroll
        for (int bj = 0; bj < 2; ++bj)
#pragma unroll
            for (int n = 0; n < 2; ++n) gv[bj][n] = *(const f32x4*)(gp + bj * HALF + n * 16) * sc;
#pragma unroll
        for (int ai = 0; ai < 2; ++ai) {
            f32x4 xv[4][2][2];
#pragma unroll
            for (int m = 0; m < 4; ++m) { const size_t off = (size_t)(row0 + ai * HALF + m * 16) * D + col0;
#pragma unroll
                for (int bj = 0; bj < 2; ++bj)
#pragma unroll
                    for (int n = 0; n < 2; ++n) xv[m][bj][n] = nt_in ? __builtin_nontemporal_load((const f32x4*)(xi + off + bj * HALF + n * 16)) : *(const f32x4*)(xi + off + bj * HALF + n * 16); }
            asm volatile("s_waitcnt vmcnt(0)" ::: "memory");
#pragma unroll
            for (int m = 0; m < 4; ++m) { const size_t off = (size_t)(row0 + ai * HALF + m * 16) * D + col0;
#pragma unroll
                for (int bj = 0; bj < 2; ++bj)
#pragma unroll
                    for (int n = 0; n < 2; ++n) *(f32x4*)(xo + off + bj * HALF + n * 16) = xv[m][bj][n] + gv[bj][n] * acc[ai][bj][m][n]; }
        }
    }
};
template <bool IN_F32>
struct EpiRes16 {
    static constexpr bool PERM = true; static constexpr bool SCALES = false;
    const float* xin_l; const float* xin_c; bf16_t* x16; const float* gate; float sc; int pad;
    __device__ __forceinline__ void operator()(const f32x4 (&acc)[2][2][4][2], const Unit& u, int wr, int wc, int fr, int fq) const {
        const int trow = u.pm * BM; const bool isc = trow >= ML;
        const int modrow = isc ? 4 : trow / SEQ;
        const int row0 = trow + wr * 64 + fr, col0 = u.pn * BM + wc * 32 + 8 * fq;
        const float* gp = gate + (size_t)modrow * 6144 + col0;
        f32x4 gv[2][2];
#pragma unroll
        for (int bj = 0; bj < 2; ++bj)
#pragma unroll
            for (int n = 0; n < 2; ++n) gv[bj][n] = *(const f32x4*)(gp + bj * HALF + n * 4) * sc;
        if constexpr (IN_F32) {
            const float* xi = isc ? xin_c : xin_l; const int rb = isc ? row0 - ML : row0;
#pragma unroll
            for (int ai = 0; ai < 2; ++ai) {
                f32x4 xv[4][2][2];
#pragma unroll
                for (int m = 0; m < 4; ++m) { const size_t off = (size_t)(rb + ai * HALF + m * 16) * D + col0;
#pragma unroll
                    for (int bj = 0; bj < 2; ++bj)
#pragma unroll
                        for (int n = 0; n < 2; ++n) xv[m][bj][n] = __builtin_nontemporal_load((const f32x4*)(xi + off + bj * HALF + n * 4)); }
                asm volatile("s_waitcnt vmcnt(0)" ::: "memory");
#pragma unroll
                for (int m = 0; m < 4; ++m) { const size_t off = (size_t)(row0 + ai * HALF + m * 16) * D + col0;
#pragma unroll
                    for (int bj = 0; bj < 2; ++bj) { const f32x4 o0 = xv[m][bj][0] + gv[bj][0] * acc[ai][bj][m][0], o1 = xv[m][bj][1] + gv[bj][1] * acc[ai][bj][m][1];
                        u32x4 w; w.x = cvt_pk_bf16(o0[0], o0[1]); w.y = cvt_pk_bf16(o0[2], o0[3]); w.z = cvt_pk_bf16(o1[0], o1[1]); w.w = cvt_pk_bf16(o1[2], o1[3]);
                        *(u32x4*)(x16 + off + bj * HALF) = w; } }
            }
        } else {
#pragma unroll
            for (int ai = 0; ai < 2; ++ai) {
                u32x4 xr[4][2];
#pragma unroll
                for (int m = 0; m < 4; ++m) { const size_t off = (size_t)(row0 + ai * HALF + m * 16) * D + col0;
#pragma unroll
                    for (int bj = 0; bj < 2; ++bj) xr[m][bj] = *(const u32x4*)(x16 + off + bj * HALF); }
                asm volatile("s_waitcnt vmcnt(0)" ::: "memory");
#pragma unroll
                for (int m = 0; m < 4; ++m) { const size_t off = (size_t)(row0 + ai * HALF + m * 16) * D + col0;
#pragma unroll
                    for (int bj = 0; bj < 2; ++bj) { const u32x4 r = xr[m][bj]; f32x4 x0, x1;
                        x0[0] = __builtin_bit_cast(float, r.x << 16); x0[1] = __builtin_bit_cast(float, r.x & 0xffff0000u); x0[2] = __builtin_bit_cast(float, r.y << 16); x0[3] = __builtin_bit_cast(float, r.y & 0xffff0000u);
                        x1[0] = __builtin_bit_cast(float, r.z << 16); x1[1] = __builtin_bit_cast(float, r.z & 0xffff0000u); x1[2] = __builtin_bit_cast(float, r.w << 16); x1[3] = __builtin_bit_cast(float, r.w & 0xffff0000u);
                        const f32x4 o0 = x0 + gv[bj][0] * acc[ai][bj][m][0], o1 = x1 + gv[bj][1] * acc[ai][bj][m][1];
                        u32x4 w; w.x = cvt_pk_bf16(o0[0], o0[1]); w.y = cvt_pk_bf16(o0[2], o0[3]); w.z = cvt_pk_bf16(o1[0], o1[1]); w.w = cvt_pk_bf16(o1[2], o1[3]);
                        *(u32x4*)(x16 + off + bj * HALF) = w; } }
            }
        }
    }
};
struct EpiSwiglu {
    static constexpr bool PERM = true; static constexpr bool SCALES = false;
    bf16_t* H; int ldo; float sin;
    __device__ __forceinline__ void operator()(const f32x4 (&acc)[2][2][4][2], const Unit& u, int wr, int wc, int fr, int fq) const {
        const int row0 = u.pm * BM + wr * 64 + fr, col0 = u.pn * HALF + wc * 32 + 8 * fq;
#pragma unroll
        for (int ai = 0; ai < 2; ++ai)
#pragma unroll
            for (int m = 0; m < 4; ++m) { bf16_t* rowp = H + (size_t)(row0 + ai * HALF + m * 16) * ldo + col0;
                float o[8];
#pragma unroll
                for (int n = 0; n < 2; ++n)
#pragma unroll
                    for (int j = 0; j < 4; j += 2) {
                        const f32x2 G = {acc[ai][0][m][n][j], acc[ai][0][m][n][j + 1]}, U = {acc[ai][1][m][n][j], acc[ai][1][m][n][j + 1]};
                        const f32x2 Ee = G * (-1.4426950408889634f * sin); f32x2 T = {__builtin_amdgcn_exp2f(Ee.x), __builtin_amdgcn_exp2f(Ee.y)}; T = T + 1.0f;
                        const f32x2 R = {__builtin_amdgcn_rcpf(T.x), __builtin_amdgcn_rcpf(T.y)};
                        const f32x2 Q = (G * U) * (R * (sin * sin));
                        o[n * 4 + j] = Q.x; o[n * 4 + j + 1] = Q.y; }
                u32x4 w; w.x = cvt_pk_bf16(o[0], o[1]); w.y = cvt_pk_bf16(o[2], o[3]); w.z = cvt_pk_bf16(o[4], o[5]); w.w = cvt_pk_bf16(o[6], o[7]);
                *(u32x4*)rowp = w; }
    }
};
__device__ __forceinline__ unsigned pack4_fp8(float a, float b, float c, float d) {
    int p = 0; p = __builtin_amdgcn_cvt_pk_fp8_f32(a, b, p, false); p = __builtin_amdgcn_cvt_pk_fp8_f32(c, d, p, true); return (unsigned)p; }
struct EpiSwiglu8 {
    static constexpr bool PERM = true; static constexpr bool SCALES = false;
    unsigned char* H; int ldo; float sin, sout;
    __device__ __forceinline__ void operator()(const f32x4 (&acc)[2][2][4][2], const Unit& u, int wr, int wc, int fr, int fq) const {
        const int row0 = u.pm * BM + wr * 64 + fr, col0 = u.pn * HALF + wc * 32 + 8 * fq;
        const float c1 = -1.4426950408889634f * sin, c2 = sin * sin * sout;
#pragma unroll
        for (int ai = 0; ai < 2; ++ai)
#pragma unroll
            for (int m = 0; m < 4; ++m) { unsigned char* rowp = H + (size_t)(row0 + ai * HALF + m * 16) * ldo + col0;
                float o[8];
#pragma unroll
                for (int n = 0; n < 2; ++n)
#pragma unroll
                    for (int j = 0; j < 4; j += 2) {
                        const f32x2 G = {acc[ai][0][m][n][j], acc[ai][0][m][n][j + 1]}, U = {acc[ai][1][m][n][j], acc[ai][1][m][n][j + 1]};
                        const f32x2 Ee = G * c1; f32x2 T = {__builtin_amdgcn_exp2f(Ee.x), __builtin_amdgcn_exp2f(Ee.y)}; T = T + 1.0f;
                        const f32x2 R = {__builtin_amdgcn_rcpf(T.x), __builtin_amdgcn_rcpf(T.y)};
                        const f32x2 Q = (G * U) * (R * c2);
                        o[n * 4 + j] = __builtin_amdgcn_fmed3f(Q.x, -448.f, 448.f); o[n * 4 + j + 1] = __builtin_amdgcn_fmed3f(Q.y, -448.f, 448.f); }
                u32x2 w; w.x = pack4_fp8(o[0], o[1], o[2], o[3]); w.y = pack4_fp8(o[4], o[5], o[6], o[7]);
                *(u32x2*)rowp = w; }
    }
};
template <bool F8>
struct EpiSwigluI8 {
    static constexpr bool PERM = true; static constexpr bool SCALES = true;
    void* H; int ldo; const float* rs; const float* cs;
    __device__ __forceinline__ void dma(const Unit& u, LAS unsigned char* slot, int wid, int lane) const {
        const float* src = wid == 0 ? rs + (size_t)u.pm * BM + 4 * lane : cs + (size_t)u.pn * BM + 4 * lane;
        __builtin_amdgcn_global_load_lds((const unsigned*)src, (LAS unsigned*)(slot + wid * 1024), 16, 0, 0); }
    __device__ __forceinline__ void operator()(const v4i_t (&acc)[2][2][4][2], const Unit& u, int wr, int wc, int fr, int fq, const LAS float* sl) const {
        const int row0 = u.pm * BM + wr * 64 + fr, col0 = u.pn * HALF + wc * 32 + 8 * fq, cc0 = u.pn * BM + wc * 32 + 8 * fq;
        const LAS float* cl = sl + 256 + wc * 32 + 8 * fq; const f32x4 cg0 = *(const LAS f32x4*)cl, cg1 = *(const LAS f32x4*)(cl + 4), cu0 = *(const LAS f32x4*)(cl + HALF), cu1 = *(const LAS f32x4*)(cl + HALF + 4);
        f32x2 ce[2][2], cq[2][2];
#pragma unroll
        for (int n = 0; n < 2; ++n)
#pragma unroll
            for (int jp = 0; jp < 2; ++jp) { const f32x2 g2 = {n ? cg1[2 * jp] : cg0[2 * jp], n ? cg1[2 * jp + 1] : cg0[2 * jp + 1]}, u2 = {n ? cu1[2 * jp] : cu0[2 * jp], n ? cu1[2 * jp + 1] : cu0[2 * jp + 1]};
                ce[n][jp] = g2 * -1.4426950408889634f; cq[n][jp] = g2 * u2; }
#pragma unroll
        for (int ai = 0; ai < 2; ++ai)
#pragma unroll
            for (int m = 0; m < 4; ++m) { const int row = row0 + ai * HALF + m * 16; const float r = sl[wr * 64 + fr + ai * HALF + m * 16], r2 = F8 ? r * r * FP8_SH : r * r;
                float o[8];
#pragma unroll
                for (int n = 0; n < 2; ++n)
#pragma unroll
                    for (int jp = 0; jp < 2; ++jp) {
                        const f32x2 G = {(float)acc[ai][0][m][n][2 * jp], (float)acc[ai][0][m][n][2 * jp + 1]}, U = {(float)acc[ai][1][m][n][2 * jp], (float)acc[ai][1][m][n][2 * jp + 1]};
                        const f32x2 Ee = G * (ce[n][jp] * r); f32x2 T = {__builtin_amdgcn_exp2f(Ee.x), __builtin_amdgcn_exp2f(Ee.y)}; T = T + 1.0f;
                        const f32x2 R = {__builtin_amdgcn_rcpf(T.x), __builtin_amdgcn_rcpf(T.y)};
                        const f32x2 Q = (G * U) * (R * (cq[n][jp] * r2));
                        o[n * 4 + 2 * jp] = Q.x; o[n * 4 + 2 * jp + 1] = Q.y; }
                if constexpr (F8) {
#pragma unroll
                    for (int j = 0; j < 8; ++j) o[j] = __builtin_amdgcn_fmed3f(o[j], -448.f, 448.f);
                    u32x2 w; w.x = pack4_fp8(o[0], o[1], o[2], o[3]); w.y = pack4_fp8(o[4], o[5], o[6], o[7]);
                    *(u32x2*)((unsigned char*)H + (size_t)row * ldo + col0) = w;
                } else {
                    u32x4 w; w.x = cvt_pk_bf16(o[0], o[1]); w.y = cvt_pk_bf16(o[2], o[3]); w.z = cvt_pk_bf16(o[4], o[5]); w.w = cvt_pk_bf16(o[6], o[7]);
                    *(u32x4*)((bf16_t*)H + (size_t)row * ldo + col0) = w; } }
    }
};
struct EpiProjFused {
    static constexpr bool PERM = true; static constexpr bool SCALES = false;
    bf16_t* O;
    __device__ __forceinline__ void operator()(const f32x4 (&acc)[2][2][4][2], const Unit& u, int wr, int wc, int fr, int fq) const {
        const int row0 = u.pm * BM + wr * 64 + fr;
        if (u.pn < 4) {
            const int col0 = (u.pn < 2 ? P_GLU : P_V) + (u.pn & 1) * HALF + wc * 32 + 8 * fq;
#pragma unroll
            for (int ai = 0; ai < 2; ++ai)
#pragma unroll
                for (int m = 0; m < 4; ++m) { bf16_t* rowp = O + (size_t)(row0 + ai * HALF + m * 16) * PW + col0;
                    float o[8];
#pragma unroll
                    for (int n = 0; n < 2; ++n)
#pragma unroll
                        for (int j = 0; j < 4; j += 2) { const f32x2 a = {acc[ai][0][m][n][j], acc[ai][0][m][n][j + 1]}, b = {acc[ai][1][m][n][j], acc[ai][1][m][n][j + 1]};
                            f32x2 q;
                            if (u.pn < 2) { const f32x2 e = b * -1.4426950408889634f; f32x2 t = {__builtin_amdgcn_exp2f(e.x), __builtin_amdgcn_exp2f(e.y)}; t = t + 1.0f;
                                const f32x2 r = {__builtin_amdgcn_rcpf(t.x), __builtin_amdgcn_rcpf(t.y)}; q = a * r; }
                            else q = a * b;
                            o[n * 4 + j] = q.x; o[n * 4 + j + 1] = q.y; }
                    u32x4 w; w.x = cvt_pk_bf16(o[0], o[1]); w.y = cvt_pk_bf16(o[2], o[3]); w.z = cvt_pk_bf16(o[4], o[5]); w.w = cvt_pk_bf16(o[6], o[7]);
                    *(u32x4*)rowp = w; }
        } else {
            const int col0 = P_SBG + (u.pn - 4) * BM + wc * 32 + 8 * fq; const bool gl = u.pn >= 7;
#pragma unroll
            for (int ai = 0; ai < 2; ++ai)
#pragma unroll
                for (int m = 0; m < 4; ++m) { bf16_t* rowp = O + (size_t)(row0 + ai * HALF + m * 16) * PW + col0;
#pragma unroll
                    for (int bj = 0; bj < 2; ++bj) { f32x4 v0 = acc[ai][bj][m][0], v1 = acc[ai][bj][m][1];
                        if (gl) {
#pragma unroll
                            for (int j = 0; j < 4; ++j) { const f32x2 x = {v0[j], v1[j]};
                                const f32x2 e = x * ((x * x) * (-2.302208198f * 0.044715f) + -2.302208198f); f32x2 t = {__builtin_amdgcn_exp2f(e.x), __builtin_amdgcn_exp2f(e.y)}; t = t + 1.0f;
                                const f32x2 r = {__builtin_amdgcn_rcpf(t.x), __builtin_amdgcn_rcpf(t.y)}, q = x * r; v0[j] = q.x; v1[j] = q.y; } }
                        u32x4 w; w.x = cvt_pk_bf16(v0[0], v0[1]); w.y = cvt_pk_bf16(v0[2], v0[3]); w.z = cvt_pk_bf16(v1[0], v1[1]); w.w = cvt_pk_bf16(v1[2], v1[3]);
                        *(u32x4*)(rowp + bj * HALF) = w; } }
        }
    }
};
struct EpiProjFusedI8 {
    static constexpr bool PERM = true; static constexpr bool SCALES = true;
    bf16_t* O; const float* rs; const float* cs;
    __device__ __forceinline__ void dma(const Unit& u, LAS unsigned char* slot, int wid, int lane) const {
        const float* src = wid == 0 ? rs + (size_t)u.pm * BM + 4 * lane : cs + (size_t)u.pn * BM + 4 * lane;
        __builtin_amdgcn_global_load_lds((const unsigned*)src, (LAS unsigned*)(slot + wid * 1024), 16, 0, 0); }
    __device__ __forceinline__ void operator()(const v4i_t (&acc)[2][2][4][2], const Unit& u, int wr, int wc, int fr, int fq, const LAS float* sl) const {
        const int row0 = u.pm * BM + wr * 64 + fr, cc0 = u.pn * BM + wc * 32 + 8 * fq;
        const LAS float* cl = sl + 256 + wc * 32 + 8 * fq; const f32x4 ca0 = *(const LAS f32x4*)cl, ca1 = *(const LAS f32x4*)(cl + 4), cb0 = *(const LAS f32x4*)(cl + HALF), cb1 = *(const LAS f32x4*)(cl + HALF + 4);
        f32x2 ca[2][2], cb[2][2];
#pragma unroll
        for (int jp = 0; jp < 2; ++jp) { ca[0][jp] = (f32x2){ca0[2 * jp], ca0[2 * jp + 1]}; ca[1][jp] = (f32x2){ca1[2 * jp], ca1[2 * jp + 1]}; cb[0][jp] = (f32x2){cb0[2 * jp], cb0[2 * jp + 1]}; cb[1][jp] = (f32x2){cb1[2 * jp], cb1[2 * jp + 1]}; }
        if (u.pn < 4) {
            const int col0 = (u.pn < 2 ? P_GLU : P_V) + (u.pn & 1) * HALF + wc * 32 + 8 * fq;
#pragma unroll
            for (int ai = 0; ai < 2; ++ai)
#pragma unroll
                for (int m = 0; m < 4; ++m) { const int row = row0 + ai * HALF + m * 16; bf16_t* rowp = O + (size_t)row * PW + col0; const float r = sl[wr * 64 + fr + ai * HALF + m * 16];
                    float o[8];
#pragma unroll
                    for (int n = 0; n < 2; ++n)
#pragma unroll
                        for (int jp = 0; jp < 2; ++jp) {
                            const f32x2 a = (f32x2){(float)acc[ai][0][m][n][2 * jp], (float)acc[ai][0][m][n][2 * jp + 1]} * (ca[n][jp] * r);
                            const f32x2 b = (f32x2){(float)acc[ai][1][m][n][2 * jp], (float)acc[ai][1][m][n][2 * jp + 1]} * (cb[n][jp] * r);
                            f32x2 q;
                            if (u.pn < 2) { const f32x2 e = b * -1.4426950408889634f; f32x2 t = {__builtin_amdgcn_exp2f(e.x), __builtin_amdgcn_exp2f(e.y)}; t = t + 1.0f;
                                const f32x2 rr = {__builtin_amdgcn_rcpf(t.x), __builtin_amdgcn_rcpf(t.y)}; q = a * rr; }
                            else q = a * b;
                            o[n * 4 + 2 * jp] = q.x; o[n * 4 + 2 * jp + 1] = q.y; }
                    u32x4 w; w.x = cvt_pk_bf16(o[0], o[1]); w.y = cvt_pk_bf16(o[2], o[3]); w.z = cvt_pk_bf16(o[4], o[5]); w.w = cvt_pk_bf16(o[6], o[7]);
                    *(u32x4*)rowp = w; }
        } else {
            const int col0 = P_SBG + (u.pn - 4) * BM + wc * 32 + 8 * fq; const bool gl = u.pn >= 7;
#pragma unroll
            for (int ai = 0; ai < 2; ++ai)
#pragma unroll
                for (int m = 0; m < 4; ++m) { const int row = row0 + ai * HALF + m * 16; bf16_t* rowp = O + (size_t)row * PW + col0; const float r = sl[wr * 64 + fr + ai * HALF + m * 16];
#pragma unroll
                    for (int bj = 0; bj < 2; ++bj) { float o[8];
#pragma unroll
                        for (int n = 0; n < 2; ++n)
#pragma unroll
                            for (int jp = 0; jp < 2; ++jp) {
                                f32x2 x = (f32x2){(float)acc[ai][bj][m][n][2 * jp], (float)acc[ai][bj][m][n][2 * jp + 1]} * ((bj ? cb[n][jp] : ca[n][jp]) * r);
                                if (gl) { const f32x2 e = x * ((x * x) * (-2.302208198f * 0.044715f) + -2.302208198f); f32x2 t = {__builtin_amdgcn_exp2f(e.x), __builtin_amdgcn_exp2f(e.y)}; t = t + 1.0f;
                                    const f32x2 rr = {__builtin_amdgcn_rcpf(t.x), __builtin_amdgcn_rcpf(t.y)}; x = x * rr; }
                                o[n * 4 + 2 * jp] = x.x; o[n * 4 + 2 * jp + 1] = x.y; }
                        u32x4 w; w.x = cvt_pk_bf16(o[0], o[1]); w.y = cvt_pk_bf16(o[2], o[3]); w.z = cvt_pk_bf16(o[4], o[5]); w.w = cvt_pk_bf16(o[6], o[7]);
                        *(u32x4*)(rowp + bj * HALF) = w; } }
        }
    }
};
}

constexpr size_t MiB = 1u << 20;
constexpr size_t WS_CTL = 0;
constexpr size_t WS_MODV = 1 * MiB;
constexpr size_t WS_LRUW = 2 * MiB;
constexpr size_t WS_GCONST = 2 * MiB + 512 * 1024;
constexpr size_t WS_XCTX = 4 * MiB;
constexpr size_t WS_SUMM = 8 * MiB;
constexpr size_t WS_CR = 13 * MiB;
constexpr size_t WS_WIN = 16 * MiB;
constexpr size_t WS_WOUT = 25 * MiB;
constexpr bool WIN8 = false;
constexpr bool WINI8_L0 = true, WINI8_L1 = true;
constexpr bool DENSE_UPI8 = true;
constexpr bool DENSE_UP8 = false, DENSE_DOWN8 = true;
constexpr size_t WS_W13 = 29 * MiB;
constexpr size_t WS_W2 = 40 * MiB;
constexpr size_t WS_ROUTE = 45 * MiB + 512 * 1024;
constexpr size_t WS_WMOE = 48 * MiB;
constexpr size_t WS_HBUF = 114 * MiB;
constexpr size_t WS_BIG = 180 * MiB;
constexpr size_t WS_X16 = WS_BIG + 250 * MiB;
constexpr size_t WS_W13Q = WS_BIG + 317 * MiB;
constexpr size_t WS_W13QS = WS_W13Q + (size_t)2 * DFF * D;
constexpr size_t WS_RS = WS_W13QS + 64 * 1024;
constexpr size_t WS_WINQ = WS_BIG + 324 * MiB;
constexpr size_t WS_WINQS = WS_BIG + 329 * MiB;
constexpr size_t WS_RS1 = WS_WINQS + 64 * 1024;

__device__ __forceinline__ unsigned pk2(float lo, float hi) { return (unsigned)f2bf(lo) | ((unsigned)f2bf(hi) << 16); }
__device__ __forceinline__ int win_row(int n0) {
    if (n0 < 256) return 256 * (n0 >> 7) + (n0 & 127);
    if (n0 < 512) { const int q = n0 - 256; return 256 * (q >> 7) + 128 + (q & 127); }
    if (n0 < 768) return 1024 + (n0 - 512);
    if (n0 < 1024) { const int q = n0 - 768; return 512 + 256 * (q >> 7) + (q & 127); }
    if (n0 < 1280) { const int q = n0 - 1024; return 512 + 256 * (q >> 7) + 128 + (q & 127); }
    return n0;
}
__device__ __forceinline__ void transpose_item(const float* W, int K, int N, bf16_t* WT, int mode, LAS float* scr, int item, int lane) {
    const int nblk = N / 32, kb = item / nblk, nb = item % nblk, k0 = 64 * kb, n0 = 32 * nb;
    const int drow0 = (mode == 0) ? n0 : (mode == 3 ? win_row(n0) : (256 * (n0 >> 7) + (n0 & 127) + (mode == 2 ? 128 : 0)));
#pragma unroll 8
    for (int i = 0; i < 32; ++i) { const int kk = 2 * i + (lane >> 5); scr[kk * 33 + (lane & 31)] = __builtin_nontemporal_load(W + (size_t)(k0 + kk) * N + n0 + (lane & 31)); }
    asm volatile("s_waitcnt lgkmcnt(0)" ::: "memory");
    const int c = lane & 7;
#pragma unroll
    for (int j = 0; j < 4; ++j) { const int n = (lane >> 3) + 8 * j; const LAS float* s = scr + (8 * c) * 33 + n;
        u32x4 o; o.x = pk2(s[0 * 33], s[1 * 33]); o.y = pk2(s[2 * 33], s[3 * 33]); o.z = pk2(s[4 * 33], s[5 * 33]); o.w = pk2(s[6 * 33], s[7 * 33]);
        *(u32x4*)(WT + (size_t)(drow0 + n) * K + k0 + 8 * c) = o; }
    asm volatile("s_waitcnt lgkmcnt(0)" ::: "memory");
}


constexpr int XS = 68;
constexpr int NPOS = 132;
constexpr int CW_BYTES = 16896;
constexpr int CWL_OFF = NWAVES * CW_BYTES;
constexpr float LOG2E = 1.4426950408889634f;
struct MixArgs {
    const bf16_t* proj; bf16_t* ybuf;
    const float* conf_w; const float* conf_b; const float* ln_g; const float* ln_b;
    const float* sconv_w; const float* g_mix;
    const float* cw; const float* cb; const bf16_t* gwt; const float* gconst;
    float* SA; float* SB; float* CR;
    unsigned* AB;
};
__device__ __forceinline__ void unpack8(const u32x4 r, float (&v)[8]) {
    v[0] = __builtin_bit_cast(float, r.x << 16); v[1] = __builtin_bit_cast(float, r.x & 0xffff0000u);
    v[2] = __builtin_bit_cast(float, r.y << 16); v[3] = __builtin_bit_cast(float, r.y & 0xffff0000u);
    v[4] = __builtin_bit_cast(float, r.z << 16); v[5] = __builtin_bit_cast(float, r.z & 0xffff0000u);
    v[6] = __builtin_bit_cast(float, r.w << 16); v[7] = __builtin_bit_cast(float, r.w & 0xffff0000u);
}
__device__ __forceinline__ float fast_exp2(float x) { return __builtin_amdgcn_exp2f(x); }
__device__ __forceinline__ float fast_rcp(float x) { return __builtin_amdgcn_rcpf(x); }
__device__ __forceinline__ float fast_sigmoid(float x) { return fast_rcp(1.0f + fast_exp2(-LOG2E * x)); }
__device__ __forceinline__ float fast_gelu_tanh(float x) { return x * fast_sigmoid(1.5957691216057308f * (x + 0.044715f * x * x * x)); }

__device__ __forceinline__ void a_unit(LAS unsigned char* lds, int tid, int ua, const MixArgs& m) {
    LAS float* g = (LAS float*)lds;
    const int r0 = ua * 32;
    int lo, hi; if (r0 < ML) { lo = (r0 / GW) * GW; hi = lo + GW; } else { lo = ML + ((r0 - ML) / CTXL) * CTXL; hi = lo + CTXL; }
    {
        u32x4 rv[4];
#pragma unroll
        for (int i = 0; i < 4; ++i) {
            const int it = tid + NTHREADS * i, sr = it >> 5, cg = it & 31; int s = r0 - 15 + sr; s = s < lo ? lo : (s >= hi ? hi - 1 : s);
            rv[i] = *(const u32x4*)(m.proj + (size_t)s * PW + P_GLU + 8 * cg);
        }
#pragma unroll
        for (int i = 0; i < 4; ++i) {
            const int it = tid + NTHREADS * i, sr = it >> 5, cg = it & 31, s = r0 - 15 + sr;
            if (it < 62 * 32) {
                float av[8], o[8]; unpack8(rv[i], av);
                const bool ok = (s >= lo && s < hi);
#pragma unroll
                for (int j = 0; j < 8; ++j) o[j] = ok ? av[j] : 0.f;
                *(LAS f32x4*)(g + sr * 256 + 8 * cg) = (f32x4){o[0], o[1], o[2], o[3]};
                *(LAS f32x4*)(g + sr * 256 + 8 * cg + 4) = (f32x4){o[4], o[5], o[6], o[7]};
            }
        }
    }
    const int c = tid & 255, half = tid >> 8;
    float acc[16];
    {
        float w[CONFK];
#pragma unroll
        for (int k = 0; k < CONFK; ++k) w[k] = m.conf_w[k * 256 + c];
        const float cb = m.conf_b[c];
        f32x2 wp[CONFK + 1];
#pragma unroll
        for (int k = 0; k <= CONFK; ++k) wp[k] = (f32x2){k < CONFK ? w[k] : 0.f, k > 0 ? w[k - 1] : 0.f};
        __syncthreads();
        f32x2 ac2[8];
#pragma unroll
        for (int t = 0; t < 8; ++t) ac2[t] = (f32x2){cb, cb};
#pragma unroll
        for (int j = 0; j < 46; ++j) {
            const float gv = g[(half * 16 + j) * 256 + c];
#pragma unroll
            for (int tp = 0; tp < 8; ++tp) { const int k = j - 2 * tp; if (k >= 0 && k <= CONFK) ac2[tp] = wp[k] * gv + ac2[tp]; }
        }
#pragma unroll
        for (int t = 0; t < 8; ++t) { acc[2 * t] = ac2[t].x; acc[2 * t + 1] = ac2[t].y; }
    }
    __syncthreads();
#pragma unroll
    for (int t = 0; t < 16; ++t) g[(half * 16 + t) * 256 + c] = acc[t];
    __syncthreads();
    {
        const int wave = tid >> 6, lane = tid & 63;
        const f32x4 lg = *(const f32x4*)(m.ln_g + 4 * lane), lb = *(const f32x4*)(m.ln_b + 4 * lane), gm = *(const f32x4*)(m.g_mix + 4 * lane);
#pragma unroll
        for (int q = 0; q < 4; ++q) {
            const int t = wave * 4 + q;
            const f32x4 u4 = *(const LAS f32x4*)(g + t * 256 + 4 * lane);
            const float mean = wave_sum((u4[0] + u4[1]) + (u4[2] + u4[3])) * (1.0f / 256.0f);
            const f32x4 d = u4 - mean;
            const float var = wave_sum((d[0] * d[0] + d[1] * d[1]) + (d[2] * d[2] + d[3] * d[3])) * (1.0f / 256.0f);
            const float rstd = rsqrtf(var + EPS);
            f32x4 ya;
#pragma unroll
            for (int j = 0; j < 4; ++j) { const float ln = d[j] * rstd * lg[j] + lb[j]; ya[j] = ln * fast_sigmoid(ln); }
            float hs = (ya[0] * ya[0] + ya[1] * ya[1]) + (ya[2] * ya[2] + ya[3] * ya[3]);
            hs += __shfl_xor(hs, 1); hs += __shfl_xor(hs, 2); hs += __shfl_xor(hs, 4); hs += __shfl_xor(hs, 8);
            const float hr = rsqrtf(hs * (1.0f / 64.0f) + EPS);
            u32x2 o; o.x = cvt_pk_bf16(ya[0] * hr * gm[0], ya[1] * hr * gm[1]); o.y = cvt_pk_bf16(ya[2] * hr * gm[2], ya[3] * hr * gm[3]);
            *(u32x2*)(m.ybuf + (size_t)(r0 + t) * D + 4 * lane) = o;
        }
    }
    __syncthreads();
}
__device__ __forceinline__ void b_unit(int tid, int ub, const MixArgs& m) {
    const int r0 = ub * 64;
#pragma unroll
    for (int i = 0; i < 4; ++i) {
        const int it = tid + NTHREADS * i, r = r0 + (it >> 5), cg = it & 31;
        int lo, hi, step; if (r < ML) { lo = (r / SEQ) * SEQ; hi = lo + SEQ; step = GW; } else { lo = ML + ((r - ML) / CTXL) * CTXL; hi = lo + CTXL; step = 1; }
        u32x4 rc[3];
#pragma unroll
        for (int k = 0; k < 3; ++k) { int s = r + (k - 1) * step; s = (s >= lo && s < hi) ? s : r; rc[k] = *(const u32x4*)(m.proj + (size_t)s * PW + P_V + 8 * cg); }
        const u32x4 rb = *(const u32x4*)(m.proj + (size_t)r * PW + P_SBG + 8 * cg);
        float acc[8];
#pragma unroll
        for (int j = 0; j < 8; ++j) acc[j] = 0.f;
#pragma unroll
        for (int k = 0; k < 3; ++k) {
            const int s = r + (k - 1) * step; const float ok = (s >= lo && s < hi) ? 1.f : 0.f;
            float cv[8]; unpack8(rc[k], cv);
            const f32x4 w0 = *(const f32x4*)(m.sconv_w + k * 256 + 8 * cg) * ok, w1 = *(const f32x4*)(m.sconv_w + k * 256 + 8 * cg + 4) * ok;
#pragma unroll
            for (int j = 0; j < 4; ++j) { acc[j] += w0[j] * cv[j]; acc[4 + j] += w1[j] * cv[4 + j]; }
        }
        float bg[8]; unpack8(rb, bg);
        float ss = 0.f;
#pragma unroll
        for (int j = 0; j < 8; ++j) { acc[j] *= bg[j]; ss += acc[j] * acc[j]; }
        ss += __shfl_xor(ss, 1); ss += __shfl_xor(ss, 2); ss += __shfl_xor(ss, 4);
        const float hr = rsqrtf(ss * (1.0f / 64.0f) + EPS);
        const f32x4 g0 = *(const f32x4*)(m.g_mix + 256 + 8 * cg), g1 = *(const f32x4*)(m.g_mix + 256 + 8 * cg + 4);
        u32x4 o; o.x = cvt_pk_bf16(acc[0] * hr * g0[0], acc[1] * hr * g0[1]); o.y = cvt_pk_bf16(acc[2] * hr * g0[2], acc[3] * hr * g0[3]);
        o.z = cvt_pk_bf16(acc[4] * hr * g1[0], acc[5] * hr * g1[1]); o.w = cvt_pk_bf16(acc[6] * hr * g1[2], acc[7] * hr * g1[3]);
        *(u32x4*)(m.ybuf + (size_t)r * D + 256 + 8 * cg) = o;
    }
}
__device__ __forceinline__ void c_prep(LAS unsigned char* lds, int tid, const MixArgs& m) {
    LAS float* cwl = (LAS float*)(lds + CWL_OFF);
    for (int i = tid; i < 5 * LRU; i += NTHREADS) cwl[i] = i < 4 * LRU ? m.cw[i] : m.cb[i - 4 * LRU];
    __syncthreads();
}
__device__ __forceinline__ void c_summary_unit(LAS unsigned char* lds, int wave, int lane, int b, int p, const MixArgs& m) {
    const int ch0 = 64 * wave, fr = lane & 15, fq = lane >> 4, ch = ch0 + lane;
    LAS float* As = (LAS float*)(lds + wave * CW_BYTES);
    LAS float* Bs = As + 16 * XS;
    const LAS float* cwl = (const LAS float*)(lds + CWL_OFF);
    const int r0 = p < 4 ? ML + b * CTXL + 64 * p : b * SEQ + 64 * (p - 4);
    const int seq_lo = p < 4 ? ML + b * CTXL : b * SEQ, seq_hi = seq_lo + (p < 4 ? CTXL : SEQ);
    const int cl = ch0 + 8 * (lane & 7);
    const bf16_t* pcx = m.proj + P_CX + cl;
#pragma unroll 1
    for (int dir = 0; dir < 2; ++dir) {
        bf16x8 fa[4][2], fx[4][2]; float bav[4], bxv[4], c1v[4];
        {
            const bf16_t* wA = m.gwt + ((size_t)((dir * 2 + 0) * 8 + wave) * 64 + fr) * 64 + 8 * fq;
            const bf16_t* wX = m.gwt + ((size_t)((dir * 2 + 1) * 8 + wave) * 64 + fr) * 64 + 8 * fq;
#pragma unroll
            for (int nt = 0; nt < 4; ++nt) {
#pragma unroll
                for (int ks = 0; ks < 2; ++ks) { fa[nt][ks] = *(const bf16x8*)(wA + (size_t)nt * 16 * 64 + 32 * ks); fx[nt][ks] = *(const bf16x8*)(wX + (size_t)nt * 16 * 64 + 32 * ks); }
                const int cc = ch0 + 16 * nt + fr;
                bav[nt] = m.gconst[(dir * 3 + 0) * LRU + cc]; bxv[nt] = m.gconst[(dir * 3 + 1) * LRU + cc]; c1v[nt] = m.gconst[(dir * 3 + 2) * LRU + cc];
            }
        }
        float H = 0.f, P = 1.f;
        unsigned* abp = m.AB + ((size_t)dir * MA + r0) * LRU + ch;
        u32x4 raw[2][4];
        auto issue = [&](int blk) __attribute__((always_inline)) {
#pragma unroll
            for (int ps = 0; ps < 2; ++ps) { const int r = r0 + 16 * blk + ps * 8 + (lane >> 3);
#pragma unroll
                for (int k = 0; k < 4; ++k) { int s = r + k - 2; s = s < seq_lo ? seq_lo : (s >= seq_hi ? seq_hi - 1 : s); raw[ps][k] = *(const u32x4*)(pcx + (size_t)s * PW); } }
        };
        issue(dir == 0 ? 0 : 3);
#pragma unroll 1
        for (int ib = 0; ib < 4; ++ib) {
            const int blk = dir == 0 ? ib : 3 - ib;
#pragma unroll
            for (int ps = 0; ps < 2; ++ps) {
                const int tt = ps * 8 + (lane >> 3), r = r0 + 16 * blk + tt;
                const f32x4 b0 = *(const LAS f32x4*)(cwl + 4 * LRU + cl), b1 = *(const LAS f32x4*)(cwl + 4 * LRU + cl + 4);
                f32x2 a2[4] = {{b0[0], b0[1]}, {b0[2], b0[3]}, {b1[0], b1[1]}, {b1[2], b1[3]}};
#pragma unroll
                for (int k = 0; k < 4; ++k) { const int s = r + k - 2; const bool ok = (s >= seq_lo && s < seq_hi);
                    u32x4 rv = raw[ps][k]; if (!ok) rv = (u32x4){0u, 0u, 0u, 0u};
                    const f32x4 w0 = *(const LAS f32x4*)(cwl + k * LRU + cl), w1 = *(const LAS f32x4*)(cwl + k * LRU + cl + 4);
                    const f32x2 v0 = {__uint_as_float(rv.x << 16), __uint_as_float(rv.x & 0xffff0000u)}, v1 = {__uint_as_float(rv.y << 16), __uint_as_float(rv.y & 0xffff0000u)};
                    const f32x2 v2 = {__uint_as_float(rv.z << 16), __uint_as_float(rv.z & 0xffff0000u)}, v3 = {__uint_as_float(rv.w << 16), __uint_as_float(rv.w & 0xffff0000u)};
                    a2[0] = (f32x2){w0[0], w0[1]} * v0 + a2[0]; a2[1] = (f32x2){w0[2], w0[3]} * v1 + a2[1]; a2[2] = (f32x2){w1[0], w1[1]} * v2 + a2[2]; a2[3] = (f32x2){w1[2], w1[3]} * v3 + a2[3]; }
                *(LAS f32x4*)(Bs + tt * XS + 8 * (lane & 7)) = (f32x4){a2[0].x, a2[0].y, a2[1].x, a2[1].y};
                *(LAS f32x4*)(Bs + tt * XS + 8 * (lane & 7) + 4) = (f32x4){a2[2].x, a2[2].y, a2[3].x, a2[3].y};
            }
            if (ib < 3) issue(dir == 0 ? ib + 1 : 2 - ib);
            bf16x8 xa[2]; float xcv[4][4];
#pragma unroll
            for (int ks = 0; ks < 2; ++ks) {
                const f32x4 lo4 = *(const LAS f32x4*)(Bs + fr * XS + 32 * ks + 8 * fq), hi4 = *(const LAS f32x4*)(Bs + fr * XS + 32 * ks + 8 * fq + 4);
                const unsigned p0 = cvt_pk_bf16(lo4[0], lo4[1]), p1 = cvt_pk_bf16(lo4[2], lo4[3]), p2 = cvt_pk_bf16(hi4[0], hi4[1]), p3 = cvt_pk_bf16(hi4[2], hi4[3]);
                xa[ks] = __builtin_bit_cast(bf16x8, (u32x4){p0, p1, p2, p3});
            }
#pragma unroll
            for (int nt = 0; nt < 4; ++nt)
#pragma unroll
                for (int j = 0; j < 4; ++j) xcv[nt][j] = Bs[(4 * fq + j) * XS + 16 * nt + fr];
#pragma unroll
            for (int nt = 0; nt < 4; ++nt) {
                f32x4 ga = (f32x4){0.f, 0.f, 0.f, 0.f}, gx = (f32x4){0.f, 0.f, 0.f, 0.f};
#pragma unroll
                for (int ks = 0; ks < 2; ++ks) { ga = __builtin_amdgcn_mfma_f32_16x16x32_bf16(xa[ks], fa[nt][ks], ga, 0, 0, 0); gx = __builtin_amdgcn_mfma_f32_16x16x32_bf16(xa[ks], fx[nt][ks], gx, 0, 0, 0); }
#pragma unroll
                for (int j = 0; j < 4; j += 2) {
                    const f32x2 ea = (f32x2){ga[j], ga[j + 1]} + bav[nt], ex = (f32x2){gx[j], gx[j + 1]} + bxv[nt];
                    f32x2 ta = {fast_exp2(ea.x), fast_exp2(ea.y)}, tx = {fast_exp2(ex.x), fast_exp2(ex.y)}; ta = ta + 1.0f; tx = tx + 1.0f;
                    const f32x2 rr = {fast_rcp(ta.x), fast_rcp(ta.y)}, ii = {fast_rcp(tx.x), fast_rcp(tx.y)};
                    const f32x2 la = rr * c1v[nt]; const f32x2 a = {fast_exp2(la.x), fast_exp2(la.y)};
                    const f32x2 om = 1.0f - a * a;
                    const f32x2 mult = {__builtin_amdgcn_sqrtf(fmaxf(om.x, 0.f)), __builtin_amdgcn_sqrtf(fmaxf(om.y, 0.f))};
                    const f32x2 bb = mult * (ii * (f32x2){xcv[nt][j], xcv[nt][j + 1]});
                    As[(4 * fq + j) * XS + 16 * nt + fr] = a.x; As[(4 * fq + j + 1) * XS + 16 * nt + fr] = a.y;
                    Bs[(4 * fq + j) * XS + 16 * nt + fr] = bb.x; Bs[(4 * fq + j + 1) * XS + 16 * nt + fr] = bb.y;
                }
            }
            unsigned* abb = abp + (size_t)(16 * blk) * LRU;
            if (dir == 0) {
#pragma unroll
                for (int tt = 0; tt < 16; ++tt) { const float a = As[tt * XS + lane], bb = Bs[tt * XS + lane]; H = a * H + bb; P *= a; abb[(size_t)tt * LRU] = cvt_pk_bf16(bb, 1.0f - a); }
            } else {
#pragma unroll
                for (int tt = 15; tt >= 0; --tt) { const float a = As[tt * XS + lane], bb = Bs[tt * XS + lane]; H = a * H + bb; P *= a; abb[(size_t)tt * LRU] = cvt_pk_bf16(bb, 1.0f - a); }
            }
        }
        const size_t o = ((size_t)(dir * NB + b) * NPOS + p) * LRU + ch; m.SA[o] = P; m.SB[o] = H;
    }
}
__device__ __forceinline__ void c_final_unit(LAS unsigned char* lds, int wave, int lane, int b, int p, const MixArgs& m, bool self_fold) {
    const int ch0 = 64 * wave, ch = ch0 + lane;
    LAS float* As = (LAS float*)(lds + wave * CW_BYTES);
    LAS bf16_t* hfb = (LAS bf16_t*)(lds + wave * CW_BYTES + 2 * 16 * XS * 4);
    const int r0 = p < 4 ? ML + b * CTXL + 64 * p : b * SEQ + 64 * (p - 4);
    float hf = 0.f, hb = 0.f;
    if (self_fold) {
        const float* sa0 = m.SA + (size_t)(0 * NB + b) * NPOS * LRU + ch; const float* sb0 = m.SB + (size_t)(0 * NB + b) * NPOS * LRU + ch;
        const float* sa1 = m.SA + (size_t)(1 * NB + b) * NPOS * LRU + ch; const float* sb1 = m.SB + (size_t)(1 * NB + b) * NPOS * LRU + ch;
        for (int j = 0; j < p; ++j) hf = sa0[(size_t)j * LRU] * hf + sb0[(size_t)j * LRU];
        for (int j = 3; j > p; --j) hb = sa1[(size_t)j * LRU] * hb + sb1[(size_t)j * LRU];
    } else {
        hf = m.CR[((size_t)(0 * NB + b) * NPOS + p) * LRU + ch]; hb = m.CR[((size_t)(1 * NB + b) * NPOS + p) * LRU + ch];
    }
    const unsigned* ab0 = m.AB + ((size_t)0 * MA + r0) * LRU + ch; const unsigned* ab1 = m.AB + ((size_t)1 * MA + r0) * LRU + ch;
    unsigned wf[64], wb[64];
#pragma unroll
    for (int t = 0; t < 64; ++t) wf[t] = ab0[(size_t)t * LRU];
#pragma unroll
    for (int t = 0; t < 64; ++t) wb[t] = ab1[(size_t)t * LRU];
#pragma unroll
    for (int t = 0; t < 64; ++t) { const float bb = __builtin_bit_cast(float, wf[t] << 16), om = __builtin_bit_cast(float, wf[t] & 0xffff0000u); hf = (1.0f - om) * hf + bb; hfb[t * 64 + lane] = f2bf(hf); }
    const f32x4 gm0 = *(const f32x4*)(m.g_mix + 512 + ch0 + 16 * (lane & 3)), gm1 = *(const f32x4*)(m.g_mix + 512 + ch0 + 16 * (lane & 3) + 4),
                gm2 = *(const f32x4*)(m.g_mix + 512 + ch0 + 16 * (lane & 3) + 8), gm3 = *(const f32x4*)(m.g_mix + 512 + ch0 + 16 * (lane & 3) + 12);
    const float gm[16] = {gm0[0], gm0[1], gm0[2], gm0[3], gm1[0], gm1[1], gm1[2], gm1[3], gm2[0], gm2[1], gm2[2], gm2[3], gm3[0], gm3[1], gm3[2], gm3[3]};
    u32x4 cgr[4][2];
#pragma unroll
    for (int blk = 0; blk < 4; ++blk) { const bf16_t* pg = m.proj + (size_t)(r0 + 16 * blk + (lane >> 2)) * PW + P_CG + ch0 + 16 * (lane & 3); cgr[blk][0] = *(const u32x4*)pg; cgr[blk][1] = *(const u32x4*)(pg + 8); }
#pragma unroll
    for (int blk = 3; blk >= 0; --blk) {
#pragma unroll
        for (int tt = 15; tt >= 0; --tt) { const unsigned w = wb[16 * blk + tt]; const float bb = __builtin_bit_cast(float, w << 16), om = __builtin_bit_cast(float, w & 0xffff0000u); hb = (1.0f - om) * hb + bb;
            As[tt * XS + lane] = hb + bf2f(hfb[(16 * blk + tt) * 64 + lane]); }
        {
            const int tt = lane >> 2, q = lane & 3, r = r0 + 16 * blk + tt;
            float ys[16], cg[16];
#pragma unroll
            for (int v4 = 0; v4 < 4; ++v4) { const f32x4 t4 = *(const LAS f32x4*)(As + tt * XS + 16 * q + 4 * v4); ys[4 * v4] = t4[0]; ys[4 * v4 + 1] = t4[1]; ys[4 * v4 + 2] = t4[2]; ys[4 * v4 + 3] = t4[3]; }
            { float t8[8]; unpack8(cgr[blk][0], t8);
#pragma unroll
              for (int j = 0; j < 8; ++j) cg[j] = t8[j];
              unpack8(cgr[blk][1], t8);
#pragma unroll
              for (int j = 0; j < 8; ++j) cg[8 + j] = t8[j]; }
            float ss = 0.f;
#pragma unroll
            for (int j = 0; j < 16; ++j) { ys[j] *= cg[j]; ss += ys[j] * ys[j]; }
            ss += __shfl_xor(ss, 1); ss += __shfl_xor(ss, 2);
            const float hr = rsqrtf(ss * (1.0f / 64.0f) + EPS);
            u32x4 o0, o1;
            o0.x = cvt_pk_bf16(ys[0] * hr * gm[0], ys[1] * hr * gm[1]); o0.y = cvt_pk_bf16(ys[2] * hr * gm[2], ys[3] * hr * gm[3]);
            o0.z = cvt_pk_bf16(ys[4] * hr * gm[4], ys[5] * hr * gm[5]); o0.w = cvt_pk_bf16(ys[6] * hr * gm[6], ys[7] * hr * gm[7]);
            o1.x = cvt_pk_bf16(ys[8] * hr * gm[8], ys[9] * hr * gm[9]); o1.y = cvt_pk_bf16(ys[10] * hr * gm[10], ys[11] * hr * gm[11]);
            o1.z = cvt_pk_bf16(ys[12] * hr * gm[12], ys[13] * hr * gm[13]); o1.w = cvt_pk_bf16(ys[14] * hr * gm[14], ys[15] * hr * gm[15]);
            bf16_t* yo = m.ybuf + (size_t)r * D + 512 + ch0 + 16 * q;
            *(u32x4*)yo = o0; *(u32x4*)(yo + 8) = o1;
        }
    }
}
__device__ __forceinline__ void carry_task(int gid, const MixArgs& m) {
    const int ch = gid & 511, dir = (gid >> 9) & 1, b = gid >> 10;
    const float* sa = m.SA + (size_t)(dir * NB + b) * NPOS * LRU + ch; const float* sb = m.SB + (size_t)(dir * NB + b) * NPOS * LRU + ch;
    float* cr = m.CR + (size_t)(dir * NB + b) * NPOS * LRU + ch;
    float h = 0.f;
    if (dir == 0) {
#pragma unroll 33
        for (int p = 0; p < NPOS; ++p) { const float a = sa[(size_t)p * LRU], bb = sb[(size_t)p * LRU]; cr[(size_t)p * LRU] = h; h = a * h + bb; }
    } else {
#pragma unroll
        for (int p = 3; p >= 0; --p) { const float a = sa[(size_t)p * LRU], bb = sb[(size_t)p * LRU]; cr[(size_t)p * LRU] = h; h = a * h + bb; }
#pragma unroll 32
        for (int p = NPOS - 1; p >= 4; --p) { const float a = sa[(size_t)p * LRU], bb = sb[(size_t)p * LRU]; cr[(size_t)p * LRU] = h; h = a * h + bb; }
    }
}
constexpr int REP_CS = 1, REP_B = 1, REP_CF = 1;
__device__ __forceinline__ void mix_phase(LAS unsigned char* lds, int tid, int wave, int lane, int G, const MixArgs& m, int n_a_units, unsigned* ctr) {
    const int nC = NB * NPOS, total = nC + n_a_units;
    volatile LAS int* nxt = (volatile LAS int*)(lds + LDS_BYTES - 32);
    c_prep(lds, tid, m);
    int u = blockIdx.x;
#pragma unroll 1
    for (int rep = 0; rep < REP_CS; ++rep) {
#pragma unroll 1
        while (u < nC) {
            if (tid == 0) *nxt = G + (int)__hip_atomic_fetch_add(ctr, 1u, __ATOMIC_RELAXED, __HIP_MEMORY_SCOPE_AGENT);
            c_summary_unit(lds, wave, lane, u / NPOS, u % NPOS, m);
            __syncthreads();
            u = *nxt;
            __syncthreads();
        }
        if (rep + 1 < REP_CS) u = blockIdx.x;
    }
#pragma unroll 1
    while (u < total) {
        if (tid == 0) *nxt = G + (int)__hip_atomic_fetch_add(ctr, 1u, __ATOMIC_RELAXED, __HIP_MEMORY_SCOPE_AGENT);
        a_unit(lds, tid, u - nC, m);
        u = *nxt;
        __syncthreads();
    }
}
__device__ __forceinline__ void carry_phase(LAS unsigned char* lds, int tid, int wave, int lane, int G, const MixArgs& m, int ctx_too, int n_b_units) {
    if (blockIdx.x < 8) carry_task((int)blockIdx.x * NTHREADS + tid, m);
    else if (ctx_too && blockIdx.x < 24) { const int u = (int)blockIdx.x - 8; c_final_unit(lds, wave, lane, u >> 2, u & 3, m, true); }
#pragma unroll 1
    for (int rep = 0; rep < REP_B; ++rep)
#pragma unroll 1
    for (int u = (int)((blockIdx.x + G - 24) % G); u < n_b_units; u += G) b_unit(tid, u, m);
}
__device__ __forceinline__ void cfin_phase(LAS unsigned char* lds, int tid, int wave, int lane, int G, const MixArgs& m) {
    const int nC = NB * (NPOS - 4);
#pragma unroll 1
    for (int rep = 0; rep < REP_CF; ++rep)
#pragma unroll 1
    for (int u = blockIdx.x; u < nC; u += G) c_final_unit(lds, wave, lane, u / (NPOS - 4), 4 + u % (NPOS - 4), m, false);
}

constexpr int CW_WQ = 2048;
constexpr int CW_CNT = 1024;
constexpr size_t EXP_STRIDE = (size_t)(2 * DFF * D + D * DFF);
constexpr size_t EXP_W2_OFF = (size_t)2 * DFF * D;
constexpr size_t RT_E = 0;
constexpr size_t RT_P = 256 * 1024;
constexpr size_t RT_POS = 512 * 1024;
constexpr size_t RT_IDX = 1024 * 1024;
constexpr int MAXT = 264;
constexpr size_t WS_Y = WS_HBUF;
constexpr size_t WS_H8MOE = WS_BIG + 66 * MiB;

typedef int i32x2 __attribute__((ext_vector_type(2)));

template <bool ROUTE, int OUTM  >
__device__ __forceinline__ void norm_phase(LAS unsigned char* lds, int tid, int wave, int lane, int G, const float* xl, const float* xc, const float* g, const float* modv_l, int sh_off, int sc_off,
                                           bf16_t* out, int rows, const float* wr, const float* br, unsigned* ctl, unsigned char* route, float* rsc = nullptr, bool nt_x = false, const bf16_t* xs16 = nullptr,
                                           int first_block = 0, int nblocks = 0, int row_lo = 0) {
    LAS float* wrT = (LAS float*)lds;
    LAS unsigned* lcnt = (LAS unsigned*)(lds + 32768);
    if (ROUTE) {
        for (int i = tid; i < D * NE; i += NTHREADS) wrT[(i & 7) * D + (i >> 3)] = wr[i];
        if (tid < 32) lcnt[tid] = 0u;
        __syncthreads();
    }
    const int gw = ((int)blockIdx.x - first_block) * NWAVES + wave, NGW = (nblocks ? nblocks : G) * NWAVES;
    const int rpw = (rows + NGW - 1) / NGW;
    const int rbeg0 = gw * rpw, rbeg = row_lo + (rbeg0 < rows ? rbeg0 : rows), rend = row_lo + ((rbeg0 + rpw < rows) ? rbeg0 + rpw : rows);
    int cur_mod = -1; f32x4 Gv[4], Sv[4];
    int my_e0 = 0, my_e1 = 0, my_l0 = 0, my_l1 = 0; float my_p0 = 0.f, my_p1 = 0.f;
#pragma unroll 1
    for (int row = rbeg; row < rend; ++row) {
        const int mr = row_modidx(row);
        if (mr != cur_mod) { cur_mod = mr; const float* mv = modv_l + (size_t)mr * 6144;
#pragma unroll
            for (int j = 0; j < 4; ++j) { const int c = 4 * lane + 256 * j; const f32x4 gg = *(const f32x4*)(g + c), sc = *(const f32x4*)(mv + sc_off + c); Gv[j] = gg * (sc + 1.0f); Sv[j] = *(const f32x4*)(mv + sh_off + c); } }
        const float* xr = row < ML ? xl + (size_t)row * D : xc + (size_t)(row - ML) * D;
        f32x4 v[4]; float ss = 0.f;
#pragma unroll
        for (int j = 0; j < 4; ++j) {
            if (xs16) { const u32x2 r = *(const u32x2*)(xs16 + (size_t)row * D + 4 * lane + 256 * j); v[j][0] = __builtin_bit_cast(float, r.x << 16); v[j][1] = __builtin_bit_cast(float, r.x & 0xffff0000u); v[j][2] = __builtin_bit_cast(float, r.y << 16); v[j][3] = __builtin_bit_cast(float, r.y & 0xffff0000u); }
            else v[j] = nt_x ? __builtin_nontemporal_load((const f32x4*)(xr + 4 * lane + 256 * j)) : *(const f32x4*)(xr + 4 * lane + 256 * j);
            ss += (v[j][0] * v[j][0] + v[j][1] * v[j][1]) + (v[j][2] * v[j][2] + v[j][3] * v[j][3]); }
        ss = wave_sum(ss);
        const float rstd = rsqrtf(ss * (1.0f / D) + EPS);
#pragma unroll
        for (int j = 0; j < 4; ++j) { v[j] = (v[j] * rstd) * Gv[j] + Sv[j];
            if (OUTM == 1) *(unsigned*)((unsigned char*)out + (size_t)row * D + 4 * lane + 256 * j) = pg8::pack4_fp8(v[j][0], v[j][1], v[j][2], v[j][3]);
            else if (OUTM == 0) { u32x2 o; o.x = cvt_pk_bf16(v[j][0], v[j][1]); o.y = cvt_pk_bf16(v[j][2], v[j][3]); *(u32x2*)(out + (size_t)row * D + 4 * lane + 256 * j) = o; } }
        if (OUTM == 2) {
            float am = 0.f;
#pragma unroll
            for (int j = 0; j < 4; ++j) am = fmaxf(am, fmaxf(fmaxf(fabsf(v[j][0]), fabsf(v[j][1])), fmaxf(fabsf(v[j][2]), fabsf(v[j][3]))));
#pragma unroll
            for (int o = 1; o < 64; o <<= 1) am = fmaxf(am, __shfl_xor(am, o));
            am = fmaxf(am, 1e-20f);
            const float qs = 127.0f / am;
#pragma unroll
            for (int j = 0; j < 4; ++j) { const int q0 = (int)__builtin_rintf(v[j][0] * qs), q1 = (int)__builtin_rintf(v[j][1] * qs), q2 = (int)__builtin_rintf(v[j][2] * qs), q3 = (int)__builtin_rintf(v[j][3] * qs);
                *(unsigned*)((unsigned char*)out + (size_t)row * D + 4 * lane + 256 * j) = (unsigned)(q0 & 0xff) | ((unsigned)(q1 & 0xff) << 8) | ((unsigned)(q2 & 0xff) << 16) | ((unsigned)(q3 & 0xff) << 24); }
            if (lane == 0) rsc[row] = am * (1.0f / 127.0f);
        }
        if (ROUTE) {
            float lg[NE];
#pragma unroll
            for (int e = 0; e < NE; ++e) { float a = 0.f;
#pragma unroll
                for (int j = 0; j < 4; ++j) { const f32x4 w4 = *(const LAS f32x4*)(wrT + e * D + 4 * lane + 256 * j); a += (v[j][0] * w4[0] + v[j][1] * w4[1]) + (v[j][2] * w4[2] + v[j][3] * w4[3]); }
                lg[e] = wave_sum(a) + br[e]; }
            int i0 = 0; float v0 = lg[0];
#pragma unroll
            for (int e = 1; e < NE; ++e) if (lg[e] > v0) { v0 = lg[e]; i0 = e; }
            int i1 = 0; float v1 = -3.0e38f;
#pragma unroll
            for (int e = 0; e < NE; ++e) if (e != i0 && lg[e] > v1) { v1 = lg[e]; i1 = e; }
            const float e1 = __expf(v1 - v0), p0 = 1.0f / (1.0f + e1), p1 = e1 / (1.0f + e1);
            if (lane == row - rbeg) {
                my_e0 = i0; my_e1 = i1; my_p0 = p0; my_p1 = p1;
                my_l0 = (int)__hip_atomic_fetch_add(lcnt + i0, 1u, __ATOMIC_RELAXED, __HIP_MEMORY_SCOPE_WORKGROUP);
                my_l1 = (int)__hip_atomic_fetch_add(lcnt + i1, 1u, __ATOMIC_RELAXED, __HIP_MEMORY_SCOPE_WORKGROUP);
            }
        }
    }
    if (ROUTE) {
        __syncthreads();
        if (tid < 8) { const unsigned n = lcnt[tid]; lcnt[16 + tid] = n ? __hip_atomic_fetch_add(ctl + CW_CNT + tid * 64, n, __ATOMIC_RELAXED, __HIP_MEMORY_SCOPE_AGENT) : 0u; }
        __syncthreads();
        const int row = rbeg + lane;
        if (row < rend) {
            const int pos0 = (int)lcnt[16 + my_e0] + my_l0, pos1 = (int)lcnt[16 + my_e1] + my_l1;
            ((i32x2*)(route + RT_E))[row] = (i32x2){my_e0, my_e1};
            ((f32x2*)(route + RT_P))[row] = (f32x2){my_p0, my_p1};
            ((i32x2*)(route + RT_POS))[row] = (i32x2){pos0, pos1};
            int* ridx = (int*)(route + RT_IDX);
            ridx[(size_t)my_e0 * ML + pos0] = row;
            ridx[(size_t)my_e1 * ML + pos1] = row;
        }
    }
}

struct MoeTiles { int toff[9]; };
__device__ __forceinline__ void moe_tiles(const unsigned* ctl, MoeTiles& t) {
    int acc = 0;
#pragma unroll
    for (int e = 0; e < 8; ++e) { const int c = (int)__builtin_amdgcn_readfirstlane(__hip_atomic_load(ctl + CW_CNT + e * 64, __ATOMIC_RELAXED, __HIP_MEMORY_SCOPE_AGENT)); t.toff[e] = acc; acc += (c + 255) >> 8; }
    t.toff[8] = acc;
}
namespace pg8 {
struct MoeUpSched {
    static constexpr bool GATHER = true;
    Order o; MoeTiles t; const char* hb; const char* wmoe; const int* ridx; const unsigned* cntp; size_t tstepB;
    __device__ __forceinline__ void init(const void* hbuf8, const unsigned char* wmoe_, const int* ridx_, const unsigned* ctl, int G, int c) {
        moe_tiles(ctl, t); o.init(t.toff[8], (2 * DFF) / BM, G, c); cntp = ctl + CW_CNT; hb = (const char*)hbuf8; wmoe = (const char*)wmoe_; ridx = ridx_; tstepB = (size_t)BM * D; }
    __device__ __forceinline__ bool next(int i, Unit& u) const {
        if (!o.lin(i, u.pm, u.pn)) return false;
        int e = 0, ts = 0;
#pragma unroll
        for (int k = 1; k < 8; ++k) if (u.pm >= t.toff[k]) { e = k; ts = t.toff[k]; }
        u.e = e; u.rb = (u.pm - ts) * BM; u.cnt = (int)cntp[e * 64];
        u.a = hb; u.b = wmoe + (size_t)e * EXP_STRIDE + (size_t)u.pn * tstepB; return true;
    }
    __device__ __forceinline__ unsigned arow(const Unit& u, int r) const { const int idx = u.rb + r; return (unsigned)ridx[(size_t)u.e * ML + (idx < u.cnt ? idx : 0)]; }
    __device__ __forceinline__ void idx_dma(const Unit& u, LAS unsigned char* slot, int lane) const {
        __builtin_amdgcn_global_load_lds((const unsigned*)(ridx + (size_t)u.e * ML + u.rb + lane * 4), (LAS unsigned*)slot, 16, 0, 0); }
    __device__ __forceinline__ unsigned arow_lds(const Unit& u, int r, const LAS int* ix) const { return (unsigned)ix[(u.rb + r < u.cnt) ? r : 0]; }
    __device__ __forceinline__ void a_ready(const Unit&) const {}
    __device__ __forceinline__ void done(const Unit&) const {}
};
struct MoeDownSched {
    static constexpr bool GATHER = false;
    Order o; MoeTiles t; const char* H; const char* wmoe; size_t tstep;
    __device__ __forceinline__ void init(const void* Hc, const unsigned char* wmoe_, const unsigned* ctl, int G, int c) {
        moe_tiles(ctl, t); o.init(t.toff[8], D / BM, G, c); H = (const char*)Hc; wmoe = (const char*)wmoe_; tstep = (size_t)BM * DFF; }
    __device__ __forceinline__ bool next(int i, Unit& u) const {
        if (!o.lin(i, u.pm, u.pn)) return false;
        u.pm = t.toff[8] - 1 - u.pm;
        int e = 0;
#pragma unroll
        for (int k = 1; k < 8; ++k) if (u.pm >= t.toff[k]) e = k;
        u.e = e; u.rb = 0; u.cnt = 0;
        u.a = H + (size_t)u.pm * tstep; u.b = wmoe + (size_t)e * EXP_STRIDE + EXP_W2_OFF + (size_t)u.pn * tstep; return true;
    }
    __device__ __forceinline__ unsigned arow(const Unit&, int r) const { return (unsigned)r; }
    __device__ __forceinline__ void a_ready(const Unit&) const {}
    __device__ __forceinline__ void done(const Unit&) const {}
};
}

__device__ __forceinline__ void final_phase(int wave, int lane, int G, float* x, const bf16_t* x16, const bf16_t* Y, const float* gt2  , const float* g_final, const unsigned* ctl, const unsigned char* route) {
    MoeTiles t; moe_tiles(ctl, t);
    const int gw = blockIdx.x * NWAVES + wave, NGW = G * NWAVES;
    const int rpw = (ML + NGW - 1) / NGW;
    const int rbeg = gw * rpw, rend = (rbeg + rpw < ML) ? rbeg + rpw : ML;
    f32x4 gf[4];
#pragma unroll
    for (int j = 0; j < 4; ++j) gf[j] = *(const f32x4*)(g_final + 4 * lane + 256 * j);
#pragma unroll 1
    for (int row = rbeg; row < rend; ++row) {
        const i32x2 ee = ((const i32x2*)(route + RT_E))[row]; const f32x2 pp = ((const f32x2*)(route + RT_P))[row]; const i32x2 ps = ((const i32x2*)(route + RT_POS))[row];
        int t0 = 0, t1 = 0;
#pragma unroll
        for (int k = 1; k < 8; ++k) { if (ee[0] >= k) t0 = t.toff[k]; if (ee[1] >= k) t1 = t.toff[k]; }
        const bf16_t* y0 = Y + ((size_t)t0 * 256 + ps[0]) * D; const bf16_t* y1 = Y + ((size_t)t1 * 256 + ps[1]) * D;
        const float* gt = gt2 + (size_t)(row / SEQ) * 6144;
        f32x4 v[4]; float ss = 0.f;
#pragma unroll
        for (int j = 0; j < 4; ++j) {
            const int c = 4 * lane + 256 * j;
            const u32x2 xr_ = *(const u32x2*)(x16 + (size_t)row * D + c); f32x4 xv; xv[0] = __builtin_bit_cast(float, xr_.x << 16); xv[1] = __builtin_bit_cast(float, xr_.x & 0xffff0000u); xv[2] = __builtin_bit_cast(float, xr_.y << 16); xv[3] = __builtin_bit_cast(float, xr_.y & 0xffff0000u);
            const f32x4 gv = *(const f32x4*)(gt + c);
            const u32x2 a = *(const u32x2*)(y0 + c), b2 = *(const u32x2*)(y1 + c);
            f32x4 ya, yb;
            ya[0] = __builtin_bit_cast(float, a.x << 16); ya[1] = __builtin_bit_cast(float, a.x & 0xffff0000u); ya[2] = __builtin_bit_cast(float, a.y << 16); ya[3] = __builtin_bit_cast(float, a.y & 0xffff0000u);
            yb[0] = __builtin_bit_cast(float, b2.x << 16); yb[1] = __builtin_bit_cast(float, b2.x & 0xffff0000u); yb[2] = __builtin_bit_cast(float, b2.y << 16); yb[3] = __builtin_bit_cast(float, b2.y & 0xffff0000u);
            v[j] = xv + gv * (ya * pp[0] + yb * pp[1]);
            ss += (v[j][0] * v[j][0] + v[j][1] * v[j][1]) + (v[j][2] * v[j][2] + v[j][3] * v[j][3]);
        }
        ss = wave_sum(ss);
        const float rstd = rsqrtf(ss * (1.0f / D) + EPS);
#pragma unroll
        for (int j = 0; j < 4; ++j) *(f32x4*)(x + (size_t)row * D + 4 * lane + 256 * j) = (v[j] * rstd) * gf[j];
    }
}

__device__ __forceinline__ void mod_task(LAS unsigned char* lds, int tid, int wave, int lane, int task, const float* c, const float* c_ctx, const float* w_mod, const float* b_mod, float* modv) {
    LAS float* sl = (LAS float*)lds;
    LAS float* red = (LAS float*)(lds + 20480);
    for (int i = tid; i < 5 * D; i += NTHREADS) { const float v = i < 4 * D ? c[i] : c_ctx[i - 4 * D]; sl[i] = v / (1.0f + __expf(-v)); }
    __syncthreads();
    const int l = task / 96, n = (task % 96) * 64 + lane;
    const float* w = w_mod + (size_t)l * D * 6144 + n;
    float acc[5] = {0.f, 0.f, 0.f, 0.f, 0.f};
#pragma unroll 16
    for (int kk = 0; kk < 128; ++kk) { const int k = wave * 128 + kk; const float wv = w[(size_t)k * 6144];
#pragma unroll
        for (int r = 0; r < 5; ++r) acc[r] += sl[r * D + k] * wv; }
#pragma unroll
    for (int r = 0; r < 5; ++r) red[(wave * 5 + r) * 64 + lane] = acc[r];
    __syncthreads();
    if (tid < 320) { const int r = tid >> 6, ln = tid & 63; float s = 0.f;
#pragma unroll
        for (int w8 = 0; w8 < 8; ++w8) s += red[(w8 * 5 + r) * 64 + ln];
        const int nn = (task % 96) * 64 + ln; modv[((size_t)l * 5 + r) * 6144 + nn] = s + b_mod[l * 6144 + nn]; }
    __syncthreads();
}

constexpr unsigned DUPMASK = 0u;
constexpr int CW_BAR = 4096;
#define XB_TMO      128
#define XB_XCNT(j)  (256  + 64 * (j))
#define XB_XSUB(j)  (1280 + 64 * (j))
#define XB_XGEN(j)  (2304 + 64 * (j))
#define XB_TOP      3328
#define XB_TOPGEN   3392
#define XCD_BAR_WORDS 3456
#define XB_SPIN_CAP (1u << 18)

__device__ __forceinline__ unsigned xb_ld(unsigned* p)              { return __hip_atomic_load(p, __ATOMIC_RELAXED, __HIP_MEMORY_SCOPE_AGENT); }
__device__ __forceinline__ unsigned xb_add(unsigned* p, unsigned v) { return __hip_atomic_fetch_add(p, v, __ATOMIC_RELAXED, __HIP_MEMORY_SCOPE_AGENT); }
__device__ __forceinline__ unsigned xb_xcc_id() { return (unsigned)__builtin_amdgcn_s_getreg((3 << 11) | 20) & 0xFu; }
#define XB_SPIN(cond, bar) do { unsigned _sp = 0; while (cond) { __builtin_amdgcn_s_sleep(1); \
    if ((++_sp & 255u) == 0u) { if (xb_ld(&(bar)[XB_TMO])) break; if (_sp > XB_SPIN_CAP) { atomicAdd(&(bar)[XB_TMO], 1u); break; } } } } while (0)

struct XcdBarrier {
    unsigned* bar; unsigned x;
    volatile LAS unsigned* st;
};

__device__ __forceinline__ XcdBarrier xcd_barrier_post(unsigned* bar, volatile LAS unsigned* st) {
    XcdBarrier b; b.bar = bar; b.x = xb_xcc_id(); b.st = st;
    if (threadIdx.x == 0) (void)xb_add(&bar[XB_XCNT(b.x)], 1u);
    return b;
}
__device__ __forceinline__ void xcd_barrier_complete(unsigned* bar, unsigned x, unsigned& nloc, unsigned& nx) {
    const unsigned G = gridDim.x * gridDim.y * gridDim.z;
    unsigned sum, cnt, mine, sp = 0u;
    for (;;) {
        sum = 0u; cnt = 0u; mine = 0u;
#pragma unroll
        for (unsigned j = 0; j < 16; ++j) { const unsigned c = xb_ld(&bar[XB_XCNT(j)]); sum += c; cnt += (c > 0u) ? 1u : 0u; mine = (j == x) ? c : mine; }
        if (sum == G) break;
        __builtin_amdgcn_s_sleep(1);
        if ((++sp & 255u) == 0u) { if (xb_ld(&bar[XB_TMO])) break; if (sp > XB_SPIN_CAP) { atomicAdd(&bar[XB_TMO], 1u); break; } }
    }
    nloc = mine > 0u ? mine : 1u; nx = cnt > 0u ? cnt : 1u;
}

__device__ __forceinline__ void xcd_barrier(const XcdBarrier& b) {
    asm volatile("s_waitcnt vmcnt(0)" ::: "memory");
    __syncthreads();
    if (threadIdx.x == 0) {
        unsigned* bar = b.bar;
        __builtin_amdgcn_s_waitcnt(0);
        unsigned nloc = b.st[0], nx = b.st[1];
        if (nloc == 0u) { xcd_barrier_complete(bar, b.x, nloc, nx); b.st[0] = nloc; b.st[1] = nx; }
        const unsigned old = xb_add(&bar[XB_XSUB(b.x)], 1u);
        const unsigned gen = old / nloc;
        if (old + 1u == (gen + 1u) * nloc) {
            __builtin_amdgcn_fence(__ATOMIC_RELEASE, "agent");
            asm volatile("s_waitcnt vmcnt(0)" ::: "memory");
            const unsigned og = xb_add(&bar[XB_TOP], 1u);
            const unsigned tg = og / nx;
            if (og + 1u == (tg + 1u) * nx) xb_add(&bar[XB_TOPGEN], 1u);
            else XB_SPIN(xb_ld(&bar[XB_TOPGEN]) == tg, bar);
            __builtin_amdgcn_fence(__ATOMIC_ACQUIRE, "agent");
            xb_add(&bar[XB_XGEN(b.x)], 1u);
            asm volatile("s_waitcnt vmcnt(0)" ::: "memory");
        } else {
            XB_SPIN(xb_ld(&bar[XB_XGEN(b.x)]) == gen, bar);
            __builtin_amdgcn_fence(__ATOMIC_ACQUIRE, "agent");
            asm volatile("s_waitcnt vmcnt(0)" ::: "memory");
        }
    }
    __syncthreads();
}


__device__ __forceinline__ void transpose_item8(const float* W, int K, int N, unsigned char* WT, int mode, LAS float* scr, int item, int lane) {
    const int nblk = N / 32, kb = item / nblk, nb = item % nblk, k0 = 64 * kb, n0 = 32 * nb;
    const int drow0 = (mode == 0) ? n0 : (mode == 3 ? win_row(n0) : (256 * (n0 >> 7) + (n0 & 127) + (mode == 2 ? 128 : 0)));
    {
        f32x4 v[8];
#pragma unroll
        for (int i = 0; i < 8; ++i) v[i] = __builtin_nontemporal_load((const f32x4*)(W + (size_t)(k0 + 8 * i + (lane >> 3)) * N + n0 + 4 * (lane & 7)));
#pragma unroll
        for (int i = 0; i < 8; ++i) { LAS float* d = scr + (8 * i + (lane >> 3)) * 33 + 4 * (lane & 7);
#pragma unroll
            for (int j = 0; j < 4; ++j) d[j] = v[i][j] * FP8_SW; }
    }
    asm volatile("s_waitcnt lgkmcnt(0)" ::: "memory");
    const int c = lane & 7;
#pragma unroll
    for (int j = 0; j < 4; ++j) { const int n = (lane >> 3) + 8 * j; const LAS float* q = scr + (8 * c) * 33 + n;
        u32x2 o; o.x = pg8::pack4_fp8(q[0 * 33], q[1 * 33], q[2 * 33], q[3 * 33]); o.y = pg8::pack4_fp8(q[4 * 33], q[5 * 33], q[6 * 33], q[7 * 33]);
        *(u32x2*)(WT + (size_t)(drow0 + n) * K + k0 + 8 * c) = o; }
    asm volatile("s_waitcnt lgkmcnt(0)" ::: "memory");
}

__device__ __forceinline__ void quant_rows_i8(const bf16_t* W, unsigned char* Q, float* scale, int nrows, int gw, int NGW, int lane) {
#pragma unroll 1
    for (int r = gw; r < nrows; r += NGW) {
        const u32x4 a = *(const u32x4*)(W + (size_t)r * D + 16 * lane), b = *(const u32x4*)(W + (size_t)r * D + 16 * lane + 8);
        float v[16]; { float t[8]; unpack8(a, t);
#pragma unroll
            for (int j = 0; j < 8; ++j) v[j] = t[j];
            unpack8(b, t);
#pragma unroll
            for (int j = 0; j < 8; ++j) v[8 + j] = t[j]; }
        float am = 0.f;
#pragma unroll
        for (int j = 0; j < 16; ++j) am = fmaxf(am, fabsf(v[j]));
#pragma unroll
        for (int o = 1; o < 64; o <<= 1) am = fmaxf(am, __shfl_xor(am, o));
        am = fmaxf(am, 1e-30f);
        const float qs = 127.0f / am;
        unsigned w[4];
#pragma unroll
        for (int g4 = 0; g4 < 4; ++g4) { const int q0 = (int)__builtin_rintf(v[4 * g4] * qs), q1 = (int)__builtin_rintf(v[4 * g4 + 1] * qs), q2 = (int)__builtin_rintf(v[4 * g4 + 2] * qs), q3 = (int)__builtin_rintf(v[4 * g4 + 3] * qs);
            w[g4] = (unsigned)(q0 & 0xff) | ((unsigned)(q1 & 0xff) << 8) | ((unsigned)(q2 & 0xff) << 16) | ((unsigned)(q3 & 0xff) << 24); }
        *(u32x4*)(Q + (size_t)r * D + 16 * lane) = (u32x4){w[0], w[1], w[2], w[3]};
        if (lane == 0) scale[r] = am * (1.0f / 127.0f);
    }
}

constexpr int CW_TEAM = 3200;
__device__ __forceinline__ void team_barrier(unsigned* ctr, unsigned n, int tid) {
    asm volatile("s_waitcnt vmcnt(0)" ::: "memory");
    __syncthreads();
    if (tid == 0) {
        __builtin_amdgcn_fence(__ATOMIC_RELEASE, "agent");
        asm volatile("s_waitcnt vmcnt(0)" ::: "memory");
        (void)__hip_atomic_fetch_add(ctr, 1u, __ATOMIC_RELAXED, __HIP_MEMORY_SCOPE_AGENT);
        unsigned sp = 0;
        while (__hip_atomic_load(ctr, __ATOMIC_RELAXED, __HIP_MEMORY_SCOPE_AGENT) < n) { __builtin_amdgcn_s_sleep(2); if (++sp > (1u << 20)) break; }
        __builtin_amdgcn_fence(__ATOMIC_ACQUIRE, "agent");
        asm volatile("s_waitcnt vmcnt(0)" ::: "memory");
    }
    __syncthreads();
}

struct Args { const float* in[32]; float* out; unsigned char* ws; int ph_lo, ph_hi; };

enum Phase { PH_PRO = 0, PH_NORM1_L0, PH_WIN_L0, PH_MIX_L0, PH_CARRY_L0, PH_CFIN_L0, PH_WOUT_L0, PH_NORM2_L0, PH_FFNUP, PH_FFNDOWN,
             PH_NORM1_L1, PH_WIN_L1, PH_MIX_L1, PH_CARRY_L1, PH_CFIN_L1, PH_WOUT_L1, PH_NORM2_L1, PH_MOE_UP, PH_MOE_DOWN, PH_FINAL, PH_COUNT };

constexpr int I_IN = (D / 64) * (WIN / 32), I_OUT = (D / 64) * (D / 32), I_13 = (D / 64) * (DFF / 32), I_2 = (DFF / 64) * (D / 32), I_E = 2 * I_13 + I_2;
constexpr int CONV_Q0 = I_IN;
constexpr int CONV_DENSE_END = 2 * I_IN + 2 * I_OUT + 2 * I_13 + I_2;
constexpr int CONV_TOTAL = CONV_DENSE_END + NE * I_E;
constexpr int CW_CQ = 3072;
__device__ __forceinline__ void conv_item(const float* const* in, unsigned char* ws, int r, LAS float* scr, int lane) {
    if (r < 2 * I_IN) { const int l = r / I_IN; if (WIN8) transpose_item8(in[8] + (size_t)l * D * WIN, D, WIN, ws + WS_WIN + (size_t)l * WIN * D, 0, scr, r % I_IN, lane); else transpose_item(in[8] + (size_t)l * D * WIN, D, WIN, (bf16_t*)(ws + WS_WIN) + (size_t)l * WIN * D, 3, scr, r % I_IN, lane); return; } r -= 2 * I_IN;
    if (r < 2 * I_OUT) { const int l = r / I_OUT; transpose_item(in[22] + (size_t)l * D * D, D, D, (bf16_t*)(ws + WS_WOUT) + (size_t)l * D * D, 0, scr, r % I_OUT, lane); return; } r -= 2 * I_OUT;
    if (r < I_13) { if (DENSE_UP8) transpose_item8(in[23], D, DFF, ws + WS_W13, 1, scr, r, lane); else transpose_item(in[23], D, DFF, (bf16_t*)(ws + WS_W13), 1, scr, r, lane); return; } r -= I_13;
    if (r < I_13) { if (DENSE_UP8) transpose_item8(in[24], D, DFF, ws + WS_W13, 2, scr, r, lane); else transpose_item(in[24], D, DFF, (bf16_t*)(ws + WS_W13), 2, scr, r, lane); return; } r -= I_13;
    if (r < I_2) { if (DENSE_DOWN8) transpose_item8(in[25], DFF, D, ws + WS_W2, 0, scr, r, lane); else transpose_item(in[25], DFF, D, (bf16_t*)(ws + WS_W2), 0, scr, r, lane); return; } r -= I_2;
    { const int e = r / I_E; int q = r % I_E; unsigned char* eb = ws + WS_WMOE + (size_t)e * EXP_STRIDE;
      if (q < I_13) { transpose_item8(in[28] + (size_t)e * D * DFF, D, DFF, eb, 1, scr, q, lane); return; } q -= I_13;
      if (q < I_13) { transpose_item8(in[29] + (size_t)e * D * DFF, D, DFF, eb, 2, scr, q, lane); return; } q -= I_13;
      transpose_item8(in[30] + (size_t)e * DFF * D, DFF, D, eb + EXP_W2_OFF, 0, scr, q, lane); }
}
__device__ __forceinline__ void conv_static(const float* const* in, unsigned char* ws, int lo, int hi, int first_block, int G, LAS unsigned char* lds, int wave, int lane) {
    if ((int)blockIdx.x < first_block) return;
    LAS float* scr = (LAS float*)(lds + wave * 16384);
    const int rank = ((int)blockIdx.x - first_block) * NWAVES + wave, stride = (G - first_block) * NWAVES;
#pragma unroll 1
    for (int it = lo + rank; it < hi; it += stride) conv_item(in, ws, it, scr, lane);
}

constexpr int CQ_CH = 2 * NWAVES, CQ_NCHUNK = (NE * I_E) / CQ_CH, CW_CQ2 = 7552, CW_DONE = 8064;
static_assert((NE * I_E) % CQ_CH == 0 && CQ_NCHUNK % 8 == 0, "conversion chunks");
__device__ __forceinline__ void conv_pull(const float* const* in, unsigned char* ws, unsigned* ctl, LAS unsigned char* lds, int tid, int wave, int lane, unsigned* done_ctr, unsigned done_target) {
    LAS float* scr = (LAS float*)(lds + wave * 16384);
    volatile LAS int* slot = (volatile LAS int*)(lds + LDS_BYTES - 64);
    const int x = (int)blockIdx.x & 7;
#pragma unroll 1
    for (;;) {
        __syncthreads();
        if (tid == 0) {
            int c = -1;
            const bool stop = done_ctr != nullptr && __hip_atomic_load(done_ctr, __ATOMIC_RELAXED, __HIP_MEMORY_SCOPE_AGENT) >= done_target;
            if (!stop) { const unsigned j = __hip_atomic_fetch_add(ctl + CW_CQ2 + x * 64, 1u, __ATOMIC_RELAXED, __HIP_MEMORY_SCOPE_AGENT); if (j < (unsigned)(CQ_NCHUNK / 8)) c = (int)(j * 8u) + x; }
            *slot = c;
        }
        __syncthreads();
        const int c = *slot;
        if (c < 0) break;
#pragma unroll 1
        for (int k = 0; k < CQ_CH / NWAVES; ++k) conv_item(in, ws, CONV_DENSE_END + c * CQ_CH + k * NWAVES + wave, scr, lane);
    }
}

__global__ void __launch_bounds__(NTHREADS, 2) fwd(Args args) {
    extern __shared__ __attribute__((aligned(16))) unsigned char lds_raw[];
    LAS unsigned char* lds = (LAS unsigned char*)lds_raw;
    const int tid = threadIdx.x, lane = tid & 63, wave = __builtin_amdgcn_readfirstlane(tid >> 6);
    const int G = gridDim.x;
    unsigned char* ws = args.ws;
    const int lo = args.ph_lo, hi = args.ph_hi;
#ifdef ONLY_PHASE
#define IN(k) ((k) == ONLY_PHASE && lo <= (k) && (k) < hi)
#else
#define IN(k) (lo <= (k) && (k) < hi)
#endif
    float* xl = args.out; float* xctx = (float*)(ws + WS_XCTX);
    float* modv = (float*)(ws + WS_MODV);
    unsigned* ctl = (unsigned*)(ws + WS_CTL);
    unsigned char* route = ws + WS_ROUTE;
    bf16_t* hbuf = (bf16_t*)(ws + WS_HBUF);
    bf16_t* proj = (bf16_t*)(ws + WS_BIG);
    unsigned char* H8 = ws + WS_BIG;
    bf16_t* Yb = (bf16_t*)(ws + WS_Y);
    unsigned char* H8m = ws + WS_H8MOE;
    bf16_t* x16 = (bf16_t*)(ws + WS_X16);
    volatile LAS unsigned* xb_st = (volatile LAS unsigned*)(lds + LDS_BYTES - 16);
    if (tid == 0) { xb_st[0] = 0u; xb_st[1] = 0u; xb_st[2] = 0u; xb_st[3] = 0u; }
    __syncthreads();
    XcdBarrier bar = xcd_barrier_post(ctl + CW_BAR, xb_st);
#define SEAM(k) if (IN(k) && IN((k) + 1)) xcd_barrier(bar);
#define REP(k) for (int rep_ = 0, nrep_ = ((DUPMASK >> (k)) & 1u) ? 2 : 1; rep_ < nrep_; ++rep_, (rep_ < nrep_ ? xcd_barrier(bar) : (void)0))

    if (IN(PH_PRO)) REP(PH_PRO) {
        if (blockIdx.x < 192) mod_task(lds, tid, wave, lane, (int)blockIdx.x, args.in[1], args.in[3], args.in[4], args.in[5], modv);
        LAS float* scr = (LAS float*)(lds + wave * 16384);
        const int gw = blockIdx.x * NWAVES + wave, NGW = G * NWAVES;
#pragma unroll 1
        for (int it = gw; it < CONV_DENSE_END; it += NGW) conv_item(args.in, ws, it, scr, lane);
        bf16_t* gwt = (bf16_t*)(ws + WS_LRUW);
        for (int i = blockIdx.x * NTHREADS + tid; i < 2 * 2 * 2 * 8 * 4096; i += G * NTHREADS) {
            const int k = i & 63, n = (i >> 6) & 63, h = (i >> 12) & 7, mat = (i >> 15) & 1, dir = (i >> 16) & 1, l = i >> 17;
            const float* src = (mat == 0 ? args.in[16] : args.in[18]) + ((size_t)((l * 2 + dir) * 8 + h) * 64 + k) * 64 + n;
            gwt[i] = f2bf(-LOG2E * *src);
        }
        float* gconst = (float*)(ws + WS_GCONST);
        for (int i = blockIdx.x * NTHREADS + tid; i < 2 * 2 * 3 * LRU; i += G * NTHREADS) {
            const int c = i & 511, which = (i >> 9) % 3, ld = (i >> 9) / 3;
            float v;
            if (which == 0) v = -LOG2E * args.in[17][ld * LRU + c];
            else if (which == 1) v = -LOG2E * args.in[19][ld * LRU + c];
            else { const float L = args.in[20][ld * LRU + c]; v = 8.0f * LOG2E * (fminf(L, 0.f) - log1pf(__expf(-fabsf(L)))); }
            gconst[i] = v;
        }
    }
#define GEMM_WIN(l) { constexpr int KB = WIN8 ? D : 2 * D; pg8::DenseSched S; S.init(hbuf, ws + WS_WIN + (size_t)(l) * WIN * KB, MA, WIN, KB, G, (int)blockIdx.x); \
        pg8::EpiProjFused E{proj}; pg8::gemm_phase<WIN8>(lds, KB, S, E); }
#define TAILFILL(k) { if (tid == 0) (void)__hip_atomic_fetch_add(ctl + CW_DONE + (k) * 16, 1u, __ATOMIC_RELAXED, __HIP_MEMORY_SCOPE_AGENT); \
        conv_pull(args.in, ws, ctl, lds, tid, wave, lane, ctl + CW_DONE + (k) * 16, (unsigned)G); }
#define GEMM_WIN_I8(l) { pg8::DenseSched S; S.init(hbuf, ws + WS_WINQ + (size_t)(l) * WIN * D, MA, WIN, D, G, (int)blockIdx.x); \
        pg8::EpiProjFusedI8 E{proj, (const float*)(ws + WS_RS1), (const float*)(ws + WS_WINQS) + (l) * WIN}; pg8::gemm_phase<2>(lds + 4096, D, S, E); }
#define MIXARGS(l) MixArgs m; m.proj = proj; m.ybuf = hbuf; m.conf_w = args.in[9] + (l) * CONFK * 256; m.conf_b = args.in[10] + (l) * 256; m.ln_g = args.in[11] + (l) * 256; m.ln_b = args.in[12] + (l) * 256; \
        m.sconv_w = args.in[13] + (l) * 3 * 256; m.g_mix = args.in[21] + (l) * D; m.cw = args.in[14] + (l) * 4 * LRU; m.cb = args.in[15] + (l) * LRU; \
        m.gwt = (const bf16_t*)(ws + WS_LRUW) + (size_t)(l) * 2 * 2 * 8 * 4096; m.gconst = (const float*)(ws + WS_GCONST) + (l) * 2 * 3 * LRU; \
        m.SA = (float*)(ws + WS_SUMM); m.SB = (float*)(ws + WS_SUMM) + 2 * NB * NPOS * LRU; m.CR = (float*)(ws + WS_CR); m.AB = (unsigned*)(ws + WS_BIG + 116 * MiB);
    SEAM(PH_PRO)
    if (IN(PH_NORM1_L0)) REP(PH_NORM1_L0) { norm_phase<false, WINI8_L0 ? 2 : (WIN8 ? 1 : 0)>(lds, tid, wave, lane, G, args.in[0], args.in[2], args.in[6], modv, M_SH1, M_SC1, hbuf, MA, nullptr, nullptr, ctl, route, (float*)(ws + WS_RS1), true);
        if (DENSE_UPI8) quant_rows_i8((const bf16_t*)(ws + WS_W13), ws + WS_W13Q, (float*)(ws + WS_W13QS), 2 * DFF, (int)blockIdx.x * NWAVES + wave, G * NWAVES, lane);
        if (WINI8_L0) quant_rows_i8((const bf16_t*)(ws + WS_WIN), ws + WS_WINQ, (float*)(ws + WS_WINQS), WIN, (int)blockIdx.x * NWAVES + wave, G * NWAVES, lane);
        if (WINI8_L1) quant_rows_i8((const bf16_t*)(ws + WS_WIN) + (size_t)WIN * D, ws + WS_WINQ + (size_t)WIN * D, (float*)(ws + WS_WINQS) + WIN, WIN, (int)blockIdx.x * NWAVES + wave, G * NWAVES, lane); }
    SEAM(PH_NORM1_L0)
    if (IN(PH_WIN_L0)) REP(PH_WIN_L0) { if constexpr (WINI8_L0) GEMM_WIN_I8(0) else GEMM_WIN(0) TAILFILL(0) }
    SEAM(PH_WIN_L0)
    if (IN(PH_MIX_L0)) REP(PH_MIX_L0) { MIXARGS(0) mix_phase(lds, tid, wave, lane, G, m, MA / 32, ctl + CW_WQ); }
    SEAM(PH_MIX_L0)
    if (IN(PH_CARRY_L0)) REP(PH_CARRY_L0) { MIXARGS(0) carry_phase(lds, tid, wave, lane, G, m, 1, MA / 64); }
    SEAM(PH_CARRY_L0)
    if (IN(PH_CFIN_L0)) REP(PH_CFIN_L0) { MIXARGS(0) cfin_phase(lds, tid, wave, lane, G, m); }
    SEAM(PH_CFIN_L0)
    if (IN(PH_WOUT_L0)) REP(PH_WOUT_L0) { pg8::DenseSched S; S.init(hbuf, (const bf16_t*)(ws + WS_WOUT), ML, D, 2 * D, G, (int)blockIdx.x);
        pg8::EpiRes16<true> E{args.in[0], args.in[2], x16, modv + M_GT1, 1.0f, 0}; pg8::gemm_phase<false>(lds, 2 * D, S, E); }
    SEAM(PH_WOUT_L0)
    if (IN(PH_NORM2_L0)) {
        constexpr int OM = DENSE_UPI8 ? 2 : (DENSE_UP8 ? 1 : 0);
        if (blockIdx.x < 16) {
            { pg8::DenseSched S; S.init(hbuf, (const bf16_t*)(ws + WS_WOUT), MC, D, 2 * D, 16, (int)blockIdx.x, ML / 256);
              pg8::EpiRes16<true> E{args.in[0], args.in[2], x16, modv + M_GT1, 1.0f, 0}; pg8::gemm_phase<false>(lds, 2 * D, S, E); }
            team_barrier(ctl + CW_TEAM, 16u, tid);
            norm_phase<false, OM>(lds, tid, wave, lane, G, xl, xctx, args.in[7], modv, M_SH2, M_SC2, hbuf, MC, nullptr, nullptr, ctl, route, (float*)(ws + WS_RS), false, x16, 0, 16, ML);
        } else norm_phase<false, OM>(lds, tid, wave, lane, G, xl, xctx, args.in[7], modv, M_SH2, M_SC2, hbuf, ML, nullptr, nullptr, ctl, route, (float*)(ws + WS_RS), false, x16, 16, G - 16, 0);
        TAILFILL(4)
    }
    SEAM(PH_NORM2_L0)
    if (IN(PH_FFNUP)) REP(PH_FFNUP) {
        if constexpr (DENSE_UPI8) { pg8::DenseSched S; S.init(hbuf, ws + WS_W13Q, MA, 2 * DFF, D, G, (int)blockIdx.x);
            pg8::EpiSwigluI8<DENSE_DOWN8> E{(void*)H8, DFF, (const float*)(ws + WS_RS), (const float*)(ws + WS_W13QS)}; pg8::gemm_phase<2>(lds + 4096, D, S, E); }
        else { constexpr int KB = DENSE_UP8 ? D : 2 * D; pg8::DenseSched S; S.init(hbuf, ws + WS_W13, MA, 2 * DFF, KB, G, (int)blockIdx.x);
        if constexpr (DENSE_DOWN8) { pg8::EpiSwiglu8 E{H8, DFF, DENSE_UP8 ? 1.0f / FP8_SW : 1.0f, FP8_SH}; pg8::gemm_phase<DENSE_UP8>(lds, KB, S, E); }
        else { pg8::EpiSwiglu E{(bf16_t*)H8, DFF, DENSE_UP8 ? 1.0f / FP8_SW : 1.0f}; pg8::gemm_phase<DENSE_UP8>(lds, KB, S, E); } }
        TAILFILL(2) }
    SEAM(PH_FFNUP)
    if (IN(PH_FFNDOWN)) REP(PH_FFNDOWN) { constexpr int KB = DENSE_DOWN8 ? DFF : 2 * DFF; pg8::DenseSched S; S.init(H8, ws + WS_W2, ML, D, KB, G, (int)blockIdx.x);
        pg8::EpiRes16<false> E{nullptr, nullptr, x16, modv + M_GT2, DENSE_DOWN8 ? 1.0f / (FP8_SW * FP8_SH) : 1.0f, 0}; pg8::gemm_phase<DENSE_DOWN8>(lds, KB, S, E); }
    SEAM(PH_FFNDOWN)
    if (IN(PH_NORM1_L1)) {
        if (blockIdx.x < 16) {
            { constexpr int KB = DENSE_DOWN8 ? DFF : 2 * DFF; pg8::DenseSched S; S.init(H8, ws + WS_W2, MC, D, KB, 16, (int)blockIdx.x, ML / 256);
              pg8::EpiRes16<false> E{nullptr, nullptr, x16, modv + M_GT2, DENSE_DOWN8 ? 1.0f / (FP8_SW * FP8_SH) : 1.0f, 0}; pg8::gemm_phase<DENSE_DOWN8>(lds, KB, S, E); }
            team_barrier(ctl + CW_TEAM + 64, 16u, tid);
            norm_phase<false, WINI8_L1 ? 2 : (WIN8 ? 1 : 0)>(lds, tid, wave, lane, G, xl, xctx, args.in[6] + D, modv + 5 * 6144, M_SH1, M_SC1, hbuf, MC, nullptr, nullptr, ctl, route, (float*)(ws + WS_RS1), false, x16, 0, 16, ML);
        } else {
            norm_phase<false, WINI8_L1 ? 2 : (WIN8 ? 1 : 0)>(lds, tid, wave, lane, G, xl, xctx, args.in[6] + D, modv + 5 * 6144, M_SH1, M_SC1, hbuf, ML, nullptr, nullptr, ctl, route, (float*)(ws + WS_RS1), false, x16, 16, G - 16, 0);
        }
        TAILFILL(3)
    }
    SEAM(PH_NORM1_L1)
    if (IN(PH_WIN_L1)) REP(PH_WIN_L1) { if constexpr (WINI8_L1) GEMM_WIN_I8(1) else GEMM_WIN(1) TAILFILL(1) }
    SEAM(PH_WIN_L1)
    if (IN(PH_MIX_L1)) REP(PH_MIX_L1) { MIXARGS(1) mix_phase(lds, tid, wave, lane, G, m, ML / 32, ctl + CW_WQ + 64); }
    SEAM(PH_MIX_L1)
    if (IN(PH_CARRY_L1)) REP(PH_CARRY_L1) { MIXARGS(1) carry_phase(lds, tid, wave, lane, G, m, 0, ML / 64); }
    SEAM(PH_CARRY_L1)
    if (IN(PH_CFIN_L1)) REP(PH_CFIN_L1) { MIXARGS(1) cfin_phase(lds, tid, wave, lane, G, m); }
    SEAM(PH_CFIN_L1)
    if (IN(PH_WOUT_L1)) REP(PH_WOUT_L1) { pg8::DenseSched S; S.init(hbuf, (const bf16_t*)(ws + WS_WOUT) + (size_t)D * D, ML, D, 2 * D, G, (int)blockIdx.x);
        pg8::EpiRes16<false> E{nullptr, nullptr, x16, modv + 5 * 6144 + M_GT1, 1.0f, 0}; pg8::gemm_phase<false>(lds, 2 * D, S, E); }
    SEAM(PH_WOUT_L1)
    if (IN(PH_NORM2_L1)) REP(PH_NORM2_L1) { norm_phase<true, 1>(lds, tid, wave, lane, G, xl, xctx, args.in[7] + D, modv + 5 * 6144, M_SH2, M_SC2, hbuf, ML, args.in[26], args.in[27], ctl, route, nullptr, false, x16);
        conv_pull(args.in, ws, ctl, lds, tid, wave, lane, nullptr, 0u); }
    SEAM(PH_NORM2_L1)
    if (IN(PH_MOE_UP)) REP(PH_MOE_UP) { pg8::MoeUpSched S; S.init(hbuf, ws + WS_WMOE, (const int*)(route + RT_IDX), ctl, G, (int)blockIdx.x);
        pg8::EpiSwiglu8 E{H8m, DFF, 1.0f / FP8_SW, FP8_SH}; pg8::gemm_phase<true>(lds + 2048, D, S, E); }
    SEAM(PH_MOE_UP)
    if (IN(PH_MOE_DOWN)) REP(PH_MOE_DOWN) { pg8::MoeDownSched S; S.init(H8m, ws + WS_WMOE, ctl, G, (int)blockIdx.x);
        pg8::EpiBf16Store E{Yb, D, 1.0f / (FP8_SW * FP8_SH)}; pg8::gemm_phase<true>(lds, DFF, S, E); }
    SEAM(PH_MOE_DOWN)
    if (IN(PH_FINAL)) REP(PH_FINAL) final_phase(wave, lane, G, xl, x16, Yb, modv + 5 * 6144 + M_GT2, args.in[31], ctl, route);
#undef IN
}

static_assert(CW_CQ2 >= CW_BAR + XCD_BAR_WORDS && CW_CQ2 + 8 * 64 <= CW_DONE && (CW_DONE + 8 * 16) * 4 <= 32 * 1024 && (CW_BAR + XCD_BAR_WORDS) * 4 <= 32 * 1024 && (CW_TEAM + 3 * 64) < CW_BAR && CW_CQ < CW_TEAM && (CW_WQ + 128) <= CW_CQ && (CW_CNT + 8 * 64) <= CW_WQ, "control words inside the per-call memset");
extern "C" void kernel_launch(void* const* d_in, const int* in_sizes, int n_in, void* d_out, int out_size, void* d_ws, size_t ws_size, hipStream_t stream) {
    static int grid = 0;
    if (grid == 0) {
        int dev = 0, cus = 0; (void)hipGetDevice(&dev); (void)hipDeviceGetAttribute(&cus, hipDeviceAttributeMultiprocessorCount, dev);
        (void)hipFuncSetAttribute((const void*)fwd, hipFuncAttributeMaxDynamicSharedMemorySize, LDS_BYTES);
        int per_cu = 0;
        (void)hipOccupancyMaxActiveBlocksPerMultiprocessor(&per_cu, (const void*)fwd, NTHREADS, LDS_BYTES);
        grid = cus > 0 ? cus : 256;
        if (per_cu < 1) fprintf(stderr, "kernel_launch: occupancy query reports %d blocks per CU\n", per_cu);
    }
    Args a{};
    for (int i = 0; i < 32; ++i) a.in[i] = (const float*)d_in[i];
    a.out = (float*)d_out; a.ws = (unsigned char*)d_ws;
    (void)hipMemsetAsync((char*)d_ws + WS_CTL, 0, 32 * 1024, stream);
#ifdef MULTI_LAUNCH
    for (int ph = 0; ph < PH_COUNT; ++ph) { a.ph_lo = ph; a.ph_hi = ph + 1; hipLaunchKernelGGL(fwd, dim3(grid), dim3(NTHREADS), LDS_BYTES, stream, a); }
#else
    a.ph_lo = 0; a.ph_hi = PH_COUNT; hipLaunchKernelGGL(fwd, dim3(grid), dim3(NTHREADS), LDS_BYTES, stream, a);
#endif
}
```

```cpp
#include <hip/hip_runtime.h>
#include <stdint.h>
#include <cstdio>

constexpr int D = 1024, NB = 4, SEQ = 8192, CTXL = 256, GW = 64;
constexpr int ML = NB * SEQ;
constexpr int MC = NB * CTXL;
constexpr int MA = ML + MC;
constexpr int WIN = 2304, DFF = 2816, NE = 8, LRU = 512;
constexpr int CONFK = 31;
constexpr float EPS = 1e-6f;
constexpr int C_AVAL = 0, C_AGATE = 256, C_SBG = 512, C_SCG = 768, C_SX = 1024, C_CX = 1280, C_CG = 1792;
constexpr int PW = 1792, P_GLU = 0, P_V = 256, P_SBG = 512, P_CX = 768, P_CG = 1280;
constexpr int M_SH1 = 0, M_SC1 = 1024, M_GT1 = 2048, M_SH2 = 3072, M_SC2 = 4096, M_GT2 = 5120;

typedef unsigned short bf16_t;
typedef short bf16x8 __attribute__((ext_vector_type(8)));
typedef float f32x4 __attribute__((ext_vector_type(4)));
typedef float f32x2 __attribute__((ext_vector_type(2)));

__device__ __forceinline__ bf16_t f2bf(float f) { unsigned u = __builtin_bit_cast(unsigned, f); return (bf16_t)((u + 0x7fffu + ((u >> 16) & 1u)) >> 16); }
__device__ __forceinline__ float bf2f(bf16_t b) { return __builtin_bit_cast(float, ((unsigned)b) << 16); }
__device__ __forceinline__ float sigmoidf_(float x) { return 1.0f / (1.0f + __expf(-x)); }
__device__ __forceinline__ float siluf_(float x) { return x * sigmoidf_(x); }
__device__ __forceinline__ float gelu_tanh(float x) { const float u = 0.7978845608028654f * (x + 0.044715f * x * x * x); return 0.5f * x * (1.0f + tanhf(u)); }
__device__ __forceinline__ float wave_sum(float v) {
#pragma unroll
    for (int o = 1; o < 64; o <<= 1) v += __shfl_xor(v, o);
    return v;
}

__device__ __forceinline__ int row_modidx(int r) { return r < ML ? r / SEQ : 4; }


#define LAS __attribute__((address_space(3)))
typedef unsigned u32x4 __attribute__((ext_vector_type(4)));
typedef unsigned u32x2 __attribute__((ext_vector_type(2)));
typedef int v4i_t __attribute__((ext_vector_type(4)));
typedef int v8i_t __attribute__((ext_vector_type(8)));
constexpr int NWAVES = 8, NTHREADS = 512;
constexpr int LDS_BYTES = 160 * 1024;

__device__ __forceinline__ unsigned cvt_pk_bf16(float lo, float hi) { unsigned r; asm volatile("v_cvt_pk_bf16_f32 %0, %1, %2" : "=v"(r) : "v"(lo), "v"(hi)); return r; }
__device__ __forceinline__ float fast_silu(float x) { return x * __builtin_amdgcn_rcpf(1.0f + __expf(-x)); }

constexpr float FP8_SW = 64.0f, FP8_SH = 8.0f;
namespace pg8 {
constexpr int BM = 256, BK = 64, HALF = 128, HTB = HALF * BK * 2, STAGE_BYTES = 8 * HTB, NXCD = 8, WGM = 4;
__device__ __forceinline__ int lds_byte(int r, int c) { const int st = (r >> 4) * 2 + (c >> 5), rr = r & 15, cc = c & 31, ob = rr * 64 + cc * 2; return st * 1024 + (ob ^ (((ob >> 9) & 1) << 5)); }
__device__ __forceinline__ void stage_rc(int b, int& R, int& C) { const int st = b / 1024, sb = b % 1024, swz = sb ^ (((sb >> 9) & 1) << 5); R = (st >> 1) * 16 + swz / 64; C = (st & 1) * 32 + (swz % 64) / 2; }
__device__ __forceinline__ int perm32(int rho) { const int n = rho >> 4, i = rho & 15; return 8 * (i >> 2) + 4 * n + (i & 3); }

constexpr int SC_OFF = -4096;
constexpr int IDX_OFF = -2048;
struct Unit { int pm, pn; const char* a; const char* b; int e, rb, cnt; };

struct Order {
    int nM, nN, nwg, G, c;
    __device__ __forceinline__ void init(int nM_, int nN_, int G_, int c_) { nM = nM_; nN = nN_; nwg = nM * nN; G = G_; c = c_; }
    __device__ __forceinline__ bool lin(int i, int& pm, int& pn) const {
        const long L = (long)i * G + c; if (L >= nwg) return false;
        int wgid = (int)L; { const int q = nwg / NXCD, r = nwg % NXCD, xcd = wgid % NXCD, off = wgid / NXCD; wgid = (xcd < r ? xcd * (q + 1) : r * (q + 1) + (xcd - r) * q) + off; }
        const int nig = WGM * nN, gid = wgid / nig, fm = gid * WGM, gsz = (nM - fm) < WGM ? (nM - fm) : WGM;
        pm = fm + ((wgid % nig) % gsz); pn = (wgid % nig) / gsz; return true;
    }
};
struct DenseSched {
    static constexpr bool GATHER = false;
    Order o; const char* A; const char* Bt; size_t tstep; int pm_off;
    __device__ __forceinline__ void init(const void* A_, const void* Bt_, int M, int N, int KB, int G, int c, int pm_off_ = 0) { o.init(M / BM, N / BM, G, c); A = (const char*)A_; Bt = (const char*)Bt_; tstep = (size_t)BM * KB; pm_off = pm_off_; }
    __device__ __forceinline__ bool next(int i, Unit& u) const { if (!o.lin(i, u.pm, u.pn)) return false; u.pm += pm_off; u.a = A + (size_t)u.pm * tstep; u.b = Bt + (size_t)u.pn * tstep; u.e = 0; u.rb = 0; u.cnt = 0; return true; }
    __device__ __forceinline__ unsigned arow(const Unit&, int r) const { return (unsigned)r; }
    __device__ __forceinline__ void a_ready(const Unit&) const {}
    __device__ __forceinline__ void done(const Unit&) const {}
};

template <int MODE> struct AccT { typedef f32x4 type; };
template <> struct AccT<2> { typedef v4i_t type; };
template <int MODE, class Epi, class Sched>
__device__ __forceinline__ void gemm_phase(LAS unsigned char* lds, const int KB, const Sched& S, const Epi& E) {
    const int tid = threadIdx.x, wid = __builtin_amdgcn_readfirstlane(tid >> 6), lane = tid & 63, wr = wid >> 2, wc = wid & 3, fr = lane & 15, fq = lane >> 4;
    const int nt = KB / (BK * 2);
    int sR[2], sC[2]; unsigned voffB[2];
#pragma unroll
    for (int i = 0; i < 2; ++i) { stage_rc(tid * 16 + i * 8192, sR[i], sC[i]); const int Rb = Epi::PERM ? ((sR[i] & ~31) + perm32(sR[i] & 31)) : sR[i]; voffB[i] = (unsigned)(Rb * KB) + (unsigned)sC[i] * 2u; }
    const size_t kstep = (size_t)(BK * 2);
    const size_t hstep = (size_t)HALF * KB;
    const unsigned ldsw = (unsigned)wid * 1024u;
    const int aoff = lds_byte(wr * 64 + fr, fq * 8), boff = lds_byte(wc * 32 + fr, fq * 8);
#define PG8_SA(b, h) (((b) * 2 + (h)) * HTB)
#define PG8_SB(b, h) ((4 + (b) * 2 + (h)) * HTB)
#define PG8_STAGE(bufoff, gbase, voff) do { _Pragma("unroll") for (int _i = 0; _i < 2; ++_i) \
        __builtin_amdgcn_global_load_lds((const unsigned*)((const char*)(gbase) + (voff)[_i]), (LAS unsigned*)(lds + (bufoff) + ldsw + _i * 8192), 16, 0, 0); } while (0)
#define PG8_LDA(dst, b, h) do { _Pragma("unroll") for (int m = 0; m < 4; ++m) _Pragma("unroll") for (int k = 0; k < 2; ++k) dst[m][k] = *(const LAS bf16x8*)(lds + PG8_SA(b, h) + aoff + m * 2048 + k * 1024); } while (0)
#define PG8_LDB(dst, b, h) do { _Pragma("unroll") for (int n = 0; n < 2; ++n) _Pragma("unroll") for (int k = 0; k < 2; ++k) dst[n][k] = *(const LAS bf16x8*)(lds + PG8_SB(b, h) + boff + n * 2048 + k * 1024); } while (0)
#define PG8_MMA(ai, bj, At, Bt) do { __builtin_amdgcn_s_setprio(1); _Pragma("unroll") for (int m = 0; m < 4; ++m) _Pragma("unroll") for (int n = 0; n < 2; ++n) { \
        if constexpr (MODE == 1) { const v8i_t b8 = __builtin_shufflevector(__builtin_bit_cast(v4i_t, Bt[n][0]), __builtin_bit_cast(v4i_t, Bt[n][1]), 0, 1, 2, 3, 4, 5, 6, 7), a8 = __builtin_shufflevector(__builtin_bit_cast(v4i_t, At[m][0]), __builtin_bit_cast(v4i_t, At[m][1]), 0, 1, 2, 3, 4, 5, 6, 7); \
            asm volatile("v_mfma_scale_f32_16x16x128_f8f6f4 %0, %1, %2, %0, %3, %3 op_sel_hi:[0,0,0]" : "+v"(acc[ai][bj][m][n]) : "v"(b8), "v"(a8), "v"(fp8_one)); } \
        else if constexpr (MODE == 2) { _Pragma("unroll") for (int k = 0; k < 2; ++k) acc[ai][bj][m][n] = __builtin_amdgcn_mfma_i32_16x16x64_i8(__builtin_bit_cast(v4i_t, Bt[n][k]), __builtin_bit_cast(v4i_t, At[m][k]), acc[ai][bj][m][n], 0, 0, 0); } \
        else { _Pragma("unroll") for (int k = 0; k < 2; ++k) acc[ai][bj][m][n] = __builtin_amdgcn_mfma_f32_16x16x32_bf16(Bt[n][k], At[m][k], acc[ai][bj][m][n], 0, 0, 0); } } \
        __builtin_amdgcn_s_setprio(0); } while (0)
#define PG8_WAIT_V(n) asm volatile("s_waitcnt vmcnt(" #n ")" ::: "memory")
#define PG8_WAIT_L(n) asm volatile("s_waitcnt lgkmcnt(" #n ")" ::: "memory")
#define PG8_BAR __builtin_amdgcn_s_barrier()
#define PG8_SCHED __builtin_amdgcn_sched_barrier(0)
    const int fp8_one = 0x7f7f7f7f;
    Unit cur, nxt; int ui = 0;
    if (!S.next(0, cur)) return;
    typedef typename AccT<MODE>::type acc_t;
    acc_t acc[2][2][4][2];
#pragma unroll
    for (int a = 0; a < 2; ++a)
#pragma unroll
        for (int b = 0; b < 2; ++b)
#pragma unroll
            for (int m = 0; m < 4; ++m)
#pragma unroll
                for (int n = 0; n < 2; ++n) acc[a][b][m][n] = (acc_t){0, 0, 0, 0};
    bf16x8 At[4][2], B0[2][2], B1[2][2];
    unsigned vA0[2], vA1[2], vA0n[2], vA1n[2];
#pragma unroll
    for (int i = 0; i < 2; ++i) {
        vA0[i] = S.arow(cur, sR[i]) * (unsigned)KB + (unsigned)sC[i] * 2u;
        vA1[i] = S.arow(cur, HALF + sR[i]) * (unsigned)KB + (unsigned)sC[i] * 2u;
        vA0n[i] = vA0[i]; vA1n[i] = vA1[i];
    }
    const char* cA = cur.a; const char* cB = cur.b;
    S.a_ready(cur);
    PG8_STAGE(PG8_SB(0, 0), cB, voffB); PG8_STAGE(PG8_SB(0, 1), cB + hstep, voffB); PG8_STAGE(PG8_SA(0, 0), cA, vA0); PG8_STAGE(PG8_SA(0, 1), cA, vA1);
    if (wr == 1) PG8_BAR;
    PG8_WAIT_V(2); PG8_BAR;
    PG8_STAGE(PG8_SB(1, 0), cB + kstep, voffB); PG8_STAGE(PG8_SA(1, 0), cA + kstep, vA0); PG8_STAGE(PG8_SB(1, 1), cB + hstep + kstep, voffB);
    PG8_WAIT_V(6); PG8_BAR;
    for (;;) {
        const bool has_next = S.next(ui + 1, nxt);
        const char* nA = has_next ? nxt.a : cA; const char* nB = has_next ? nxt.b : cB;
        if constexpr (Epi::SCALES) { if (wid < 2) E.dma(cur, lds + SC_OFF + (ui & 1) * 2048, wid, lane); }
        if constexpr (Sched::GATHER) {
            if (has_next && wid == 0) S.idx_dma(nxt, lds + IDX_OFF + ((ui + 1) & 1) * 1024, lane);
        }
#pragma unroll 1
        for (int t = 0; t < nt; t += 2) {
            const bool last = (t == nt - 2);
            const char* a1 = cA + (size_t)(t + 1) * kstep;
            const char* a2 = last ? nA : cA + (size_t)(t + 2) * kstep; const char* b2 = last ? nB : cB + (size_t)(t + 2) * kstep;
            const char* a3 = a2 + kstep; const char* b3 = b2 + kstep;
            if constexpr (Sched::GATHER) {
                if (last && has_next) {
                    const LAS int* ix = (const LAS int*)(lds + IDX_OFF + ((ui + 1) & 1) * 1024);
#pragma unroll
                    for (int i = 0; i < 2; ++i) {
                        vA0n[i] = S.arow_lds(nxt, sR[i], ix) * (unsigned)KB + (unsigned)sC[i] * 2u;
                        vA1n[i] = S.arow_lds(nxt, HALF + sR[i], ix) * (unsigned)KB + (unsigned)sC[i] * 2u;
                    }
                }
            }
            unsigned w0[2], w1[2];
#pragma unroll
            for (int i = 0; i < 2; ++i) { w0[i] = (Sched::GATHER && last) ? vA0n[i] : vA0[i]; w1[i] = (Sched::GATHER && last) ? vA1n[i] : vA1[i]; }
            if (last && has_next) S.a_ready(nxt);
            PG8_LDB(B0, 0, 0); PG8_LDB(B1, 0, 1); PG8_SCHED; PG8_LDA(At, 0, 0); PG8_STAGE(PG8_SA(1, 1), a1, vA1);
            PG8_WAIT_V(8); PG8_WAIT_L(0); PG8_BAR; PG8_MMA(0, 0, At, B0); PG8_MMA(0, 1, At, B1); PG8_BAR; PG8_SCHED;
            PG8_LDA(At, 0, 1); PG8_STAGE(PG8_SB(0, 0), b2, voffB); PG8_STAGE(PG8_SB(0, 1), b2 + hstep, voffB); PG8_STAGE(PG8_SA(0, 0), a2, w0);
            PG8_WAIT_V(8); PG8_WAIT_L(0); PG8_BAR; PG8_MMA(1, 0, At, B0); PG8_MMA(1, 1, At, B1); PG8_BAR; PG8_SCHED;
            PG8_LDB(B0, 1, 0); PG8_LDB(B1, 1, 1); PG8_SCHED; PG8_LDA(At, 1, 0); PG8_STAGE(PG8_SA(0, 1), a2, w1);
            PG8_WAIT_V(8); PG8_WAIT_L(0); PG8_BAR; PG8_MMA(0, 0, At, B0); PG8_MMA(0, 1, At, B1); PG8_BAR; PG8_SCHED;
            PG8_LDA(At, 1, 1); PG8_STAGE(PG8_SB(1, 0), b3, voffB); PG8_STAGE(PG8_SB(1, 1), b3 + hstep, voffB); PG8_STAGE(PG8_SA(1, 0), a3, w0);
            PG8_WAIT_V(8); PG8_WAIT_L(0); PG8_BAR; PG8_MMA(1, 0, At, B0); PG8_MMA(1, 1, At, B1); PG8_BAR; PG8_SCHED;
        }
        if constexpr (MODE == 1) asm volatile("s_nop 15\n\ts_nop 15" ::: "memory");
        if (wr == 0) PG8_BAR;
        if constexpr (Epi::SCALES) E(acc, cur, wr, wc, fr, fq, (const LAS float*)(lds + SC_OFF + (ui & 1) * 2048)); else E(acc, cur, wr, wc, fr, fq);
        S.done(cur);
        if (!has_next) break;
#pragma unroll
        for (int a = 0; a < 2; ++a)
#pragma unroll
            for (int b = 0; b < 2; ++b)
#pragma unroll
                for (int m = 0; m < 4; ++m)
#pragma unroll
                    for (int n = 0; n < 2; ++n) acc[a][b][m][n] = (acc_t){0, 0, 0, 0};
        cur = nxt; cA = nA; cB = nB; ++ui;
#pragma unroll
        for (int i = 0; i < 2; ++i) { vA0[i] = vA0n[i]; vA1[i] = vA1n[i]; }
        if (wr == 1) PG8_BAR;
    }
    PG8_WAIT_V(0);
    PG8_BAR;
#undef PG8_SA
#undef PG8_SB
#undef PG8_STAGE
#undef PG8_LDA
#undef PG8_LDB
#undef PG8_MMA
#undef PG8_WAIT_V
#undef PG8_WAIT_L
#undef PG8_BAR
#undef PG8_SCHED
}

struct EpiBf16Store {
    static constexpr bool PERM = true; static constexpr bool SCALES = false;
    bf16_t* O; int ldo; float sc;
    __device__ __forceinline__ void operator()(const f32x4 (&acc)[2][2][4][2], const Unit& u, int wr, int wc, int fr, int fq) const {
        const int row0 = u.pm * BM + wr * 64 + fr, col0 = u.pn * BM + wc * 32 + 8 * fq;
#pragma unroll
        for (int ai = 0; ai < 2; ++ai)
#pragma unroll
            for (int m = 0; m < 4; ++m) { bf16_t* rowp = O + (size_t)(row0 + ai * HALF + m * 16) * ldo + col0;
#pragma unroll
                for (int bj = 0; bj < 2; ++bj) { const f32x4 v0 = acc[ai][bj][m][0] * sc, v1 = acc[ai][bj][m][1] * sc;
                    u32x4 w; w.x = cvt_pk_bf16(v0[0], v0[1]); w.y = cvt_pk_bf16(v0[2], v0[3]); w.z = cvt_pk_bf16(v1[0], v1[1]); w.w = cvt_pk_bf16(v1[2], v1[3]);
                    *(u32x4*)(rowp + bj * HALF) = w; } }
    }
};
struct EpiRes {
    static constexpr bool PERM = false; static constexpr bool SCALES = false;
    const float* xin_l; const float* xin_c; float* xout_l; float* xout_c; const float* gate; float sc; int nt_in;
    __device__ __forceinline__ void operator()(const f32x4 (&acc)[2][2][4][2], const Unit& u, int wr, int wc, int fr, int fq) const {
        const int trow = u.pm * BM; const bool isc = trow >= ML;
        const int modrow = isc ? 4 : trow / SEQ;
        const float* xi = isc ? xin_c : xin_l; float* xo = isc ? xout_c : xout_l;
        const int row0 = (isc ? trow - ML : trow) + wr * 64 + fr, col0 = u.pn * BM + wc * 32 + 4 * fq;
        const float* gp = gate + (size_t)modrow * 6144 + col0;
        f32x4 gv[2][2];
#pragma unroll
        for (int bj = 0; bj < 2; ++bj)
#pragma unroll
            for (int n = 0; n < 2; ++n) gv[bj][n] = *(const f32x4*)(gp + bj * HALF + n * 16) * sc;
#pragma unroll
        for (int ai = 0; ai < 2; ++ai) {
            f32x4 xv[4][2][2];
#pragma unroll
            for (int m = 0; m < 4; ++m) { const size_t off = (size_t)(row0 + ai * HALF + m * 16) * D + col0;
#pragma unroll
                for (int bj = 0; bj < 2; ++bj)
#pragma unroll
                    for (int n = 0; n < 2; ++n) xv[m][bj][n] = nt_in ? __builtin_nontemporal_load((const f32x4*)(xi + off + bj * HALF + n * 16)) : *(const f32x4*)(xi + off + bj * HALF + n * 16); }
            asm volatile("s_waitcnt vmcnt(0)" ::: "memory");
#pragma unroll
            for (int m = 0; m < 4; ++m) { const size_t off = (size_t)(row0 + ai * HALF + m * 16) * D + col0;
#pragma unroll
                for (int bj = 0; bj < 2; ++bj)
#pragma unroll
                    for (int n = 0; n < 2; ++n) *(f32x4*)(xo + off + bj * HALF + n * 16) = xv[m][bj][n] + gv[bj][n] * acc[ai][bj][m][n]; }
        }
    }
};
template <bool IN_F32>
struct EpiRes16 {
    static constexpr bool PERM = true; static constexpr bool SCALES = false;
    const float* xin_l; const float* xin_c; bf16_t* x16; const float* gate; float sc; int pad;
    __device__ __forceinline__ void operator()(const f32x4 (&acc)[2][2][4][2], const Unit& u, int wr, int wc, int fr, int fq) const {
        const int trow = u.pm * BM; const bool isc = trow >= ML;
        const int modrow = isc ? 4 : trow / SEQ;
        const int row0 = trow + wr * 64 + fr, col0 = u.pn * BM + wc * 32 + 8 * fq;
        const float* gp = gate + (size_t)modrow * 6144 + col0;
        f32x4 gv[2][2];
#pragma unroll
        for (int bj = 0; bj < 2; ++bj)
#pragma unroll
            for (int n = 0; n < 2; ++n) gv[bj][n] = *(const f32x4*)(gp + bj * HALF + n * 4) * sc;
        if constexpr (IN_F32) {
            const float* xi = isc ? xin_c : xin_l; const int rb = isc ? row0 - ML : row0;
#pragma unroll
            for (int ai = 0; ai < 2; ++ai) {
                f32x4 xv[4][2][2];
#pragma unroll
                for (int m = 0; m < 4; ++m) { const size_t off = (size_t)(rb + ai * HALF + m * 16) * D + col0;
#pragma unroll
                    for (int bj = 0; bj < 2; ++bj)
#pragma unroll
                        for (int n = 0; n < 2; ++n) xv[m][bj][n] = __builtin_nontemporal_load((const f32x4*)(xi + off + bj * HALF + n * 4)); }
                asm volatile("s_waitcnt vmcnt(0)" ::: "memory");
#pragma unroll
                for (int m = 0; m < 4; ++m) { const size_t off = (size_t)(row0 + ai * HALF + m * 16) * D + col0;
#pragma unroll
                    for (int bj = 0; bj < 2; ++bj) { const f32x4 o0 = xv[m][bj][0] + gv[bj][0] * acc[ai][bj][m][0], o1 = xv[m][bj][1] + gv[bj][1] * acc[ai][bj][m][1];
                        u32x4 w; w.x = cvt_pk_bf16(o0[0], o0[1]); w.y = cvt_pk_bf16(o0[2], o0[3]); w.z = cvt_pk_bf16(o1[0], o1[1]); w.w = cvt_pk_bf16(o1[2], o1[3]);
                        *(u32x4*)(x16 + off + bj * HALF) = w; } }
            }
        } else {
#pragma unroll
            for (int ai = 0; ai < 2; ++ai) {
                u32x4 xr[4][2];
#pragma unroll
                for (int m = 0; m < 4; ++m) { const size_t off = (size_t)(row0 + ai * HALF + m * 16) * D + col0;
#pragma unroll
                    for (int bj = 0; bj < 2; ++bj) xr[m][bj] = *(const u32x4*)(x16 + off + bj * HALF); }
                asm volatile("s_waitcnt vmcnt(0)" ::: "memory");
#pragma unroll
                for (int m = 0; m < 4; ++m) { const size_t off = (size_t)(row0 + ai * HALF + m * 16) * D + col0;
#pragma unroll
                    for (int bj = 0; bj < 2; ++bj) { const u32x4 r = xr[m][bj]; f32x4 x0, x1;
                        x0[0] = __builtin_bit_cast(float, r.x << 16); x0[1] = __builtin_bit_cast(float, r.x & 0xffff0000u); x0[2] = __builtin_bit_cast(float, r.y << 16); x0[3] = __builtin_bit_cast(float, r.y & 0xffff0000u);
                        x1[0] = __builtin_bit_cast(float, r.z << 16); x1[1] = __builtin_bit_cast(float, r.z & 0xffff0000u); x1[2] = __builtin_bit_cast(float, r.w << 16); x1[3] = __builtin_bit_cast(float, r.w & 0xffff0000u);
                        const f32x4 o0 = x0 + gv[bj][0] * acc[ai][bj][m][0], o1 = x1 + gv[bj][1] * acc[ai][bj][m][1];
                        u32x4 w; w.x = cvt_pk_bf16(o0[0], o0[1]); w.y = cvt_pk_bf16(o0[2], o0[3]); w.z = cvt_pk_bf16(o1[0], o1[1]); w.w = cvt_pk_bf16(o1[2], o1[3]);
                        *(u32x4*)(x16 + off + bj * HALF) = w; } }
            }
        }
    }
};
struct EpiSwiglu {
    static constexpr bool PERM = true; static constexpr bool SCALES = false;
    bf16_t* H; int ldo; float sin;
    __device__ __forceinline__ void operator()(const f32x4 (&acc)[2][2][4][2], const Unit& u, int wr, int wc, int fr, int fq) const {
        const int row0 = u.pm * BM + wr * 64 + fr, col0 = u.pn * HALF + wc * 32 + 8 * fq;
#pragma unroll
        for (int ai = 0; ai < 2; ++ai)
#pragma unroll
            for (int m = 0; m < 4; ++m) { bf16_t* rowp = H + (size_t)(row0 + ai * HALF + m * 16) * ldo + col0;
                float o[8];
#pragma unroll
                for (int n = 0; n < 2; ++n)
#pragma unroll
                    for (int j = 0; j < 4; j += 2) {
                        const f32x2 G = {acc[ai][0][m][n][j], acc[ai][0][m][n][j + 1]}, U = {acc[ai][1][m][n][j], acc[ai][1][m][n][j + 1]};
                        const f32x2 Ee = G * (-1.4426950408889634f * sin); f32x2 T = {__builtin_amdgcn_exp2f(Ee.x), __builtin_amdgcn_exp2f(Ee.y)}; T = T + 1.0f;
                        const f32x2 R = {__builtin_amdgcn_rcpf(T.x), __builtin_amdgcn_rcpf(T.y)};
                        const f32x2 Q = (G * U) * (R * (sin * sin));
                        o[n * 4 + j] = Q.x; o[n * 4 + j + 1] = Q.y; }
                u32x4 w; w.x = cvt_pk_bf16(o[0], o[1]); w.y = cvt_pk_bf16(o[2], o[3]); w.z = cvt_pk_bf16(o[4], o[5]); w.w = cvt_pk_bf16(o[6], o[7]);
                *(u32x4*)rowp = w; }
    }
};
__device__ __forceinline__ unsigned pack4_fp8(float a, float b, float c, float d) {
    int p = 0; p = __builtin_amdgcn_cvt_pk_fp8_f32(a, b, p, false); p = __builtin_amdgcn_cvt_pk_fp8_f32(c, d, p, true); return (unsigned)p; }
struct EpiSwiglu8 {
    static constexpr bool PERM = true; static constexpr bool SCALES = false;
    unsigned char* H; int ldo; float sin, sout;
    __device__ __forceinline__ void operator()(const f32x4 (&acc)[2][2][4][2], const Unit& u, int wr, int wc, int fr, int fq) const {
        const int row0 = u.pm * BM + wr * 64 + fr, col0 = u.pn * HALF + wc * 32 + 8 * fq;
        const float c1 = -1.4426950408889634f * sin, c2 = sin * sin * sout;
#pragma unroll
        for (int ai = 0; ai < 2; ++ai)
#pragma unroll
            for (int m = 0; m < 4; ++m) { unsigned char* rowp = H + (size_t)(row0 + ai * HALF + m * 16) * ldo + col0;
                float o[8];
#pragma unroll
                for (int n = 0; n < 2; ++n)
#pragma unroll
                    for (int j = 0; j < 4; j += 2) {
                        const f32x2 G = {acc[ai][0][m][n][j], acc[ai][0][m][n][j + 1]}, U = {acc[ai][1][m][n][j], acc[ai][1][m][n][j + 1]};
                        const f32x2 Ee = G * c1; f32x2 T = {__builtin_amdgcn_exp2f(Ee.x), __builtin_amdgcn_exp2f(Ee.y)}; T = T + 1.0f;
                        const f32x2 R = {__builtin_amdgcn_rcpf(T.x), __builtin_amdgcn_rcpf(T.y)};
                        const f32x2 Q = (G * U) * (R * c2);
                        o[n * 4 + j] = __builtin_amdgcn_fmed3f(Q.x, -448.f, 448.f); o[n * 4 + j + 1] = __builtin_amdgcn_fmed3f(Q.y, -448.f, 448.f); }
                u32x2 w; w.x = pack4_fp8(o[0], o[1], o[2], o[3]); w.y = pack4_fp8(o[4], o[5], o[6], o[7]);
                *(u32x2*)rowp = w; }
    }
};
template <bool F8>
struct EpiSwigluI8 {
    static constexpr bool PERM = true; static constexpr bool SCALES = true;
    void* H; int ldo; const float* rs; const float* cs;
    __device__ __forceinline__ void dma(const Unit& u, LAS unsigned char* slot, int wid, int lane) const {
        const float* src = wid == 0 ? rs + (size_t)u.pm * BM + 4 * lane : cs + (size_t)u.pn * BM + 4 * lane;
        __builtin_amdgcn_global_load_lds((const unsigned*)src, (LAS unsigned*)(slot + wid * 1024), 16, 0, 0); }
    __device__ __forceinline__ void operator()(const v4i_t (&acc)[2][2][4][2], const Unit& u, int wr, int wc, int fr, int fq, const LAS float* sl) const {
        const int row0 = u.pm * BM + wr * 64 + fr, col0 = u.pn * HALF + wc * 32 + 8 * fq, cc0 = u.pn * BM + wc * 32 + 8 * fq;
        const LAS float* cl = sl + 256 + wc * 32 + 8 * fq; const f32x4 cg0 = *(const LAS f32x4*)cl, cg1 = *(const LAS f32x4*)(cl + 4), cu0 = *(const LAS f32x4*)(cl + HALF), cu1 = *(const LAS f32x4*)(cl + HALF + 4);
        f32x2 ce[2][2], cq[2][2];
#pragma unroll
        for (int n = 0; n < 2; ++n)
#pragma unroll
            for (int jp = 0; jp < 2; ++jp) { const f32x2 g2 = {n ? cg1[2 * jp] : cg0[2 * jp], n ? cg1[2 * jp + 1] : cg0[2 * jp + 1]}, u2 = {n ? cu1[2 * jp] : cu0[2 * jp], n ? cu1[2 * jp + 1] : cu0[2 * jp + 1]};
                ce[n][jp] = g2 * -1.4426950408889634f; cq[n][jp] = g2 * u2; }
#pragma unroll
        for (int ai = 0; ai < 2; ++ai)
#pragma unroll
            for (int m = 0; m < 4; ++m) { const int row = row0 + ai * HALF + m * 16; const float r = sl[wr * 64 + fr + ai * HALF + m * 16], r2 = F8 ? r * r * FP8_SH : r * r;
                float o[8];
#pragma unroll
                for (int n = 0; n < 2; ++n)
#pragma unroll
                    for (int jp = 0; jp < 2; ++jp) {
                        const f32x2 G = {(float)acc[ai][0][m][n][2 * jp], (float)acc[ai][0][m][n][2 * jp + 1]}, U = {(float)acc[ai][1][m][n][2 * jp], (float)acc[ai][1][m][n][2 * jp + 1]};
                        const f32x2 Ee = G * (ce[n][jp] * r); f32x2 T = {__builtin_amdgcn_exp2f(Ee.x), __builtin_amdgcn_exp2f(Ee.y)}; T = T + 1.0f;
                        const f32x2 R = {__builtin_amdgcn_rcpf(T.x), __builtin_amdgcn_rcpf(T.y)};
                        const f32x2 Q = (G * U) * (R * (cq[n][jp] * r2));
                        o[n * 4 + 2 * jp] = Q.x; o[n * 4 + 2 * jp + 1] = Q.y; }
                if constexpr (F8) {
#pragma unroll
                    for (int j = 0; j < 8; ++j) o[j] = __builtin_amdgcn_fmed3f(o[j], -448.f, 448.f);
                    u32x2 w; w.x = pack4_fp8(o[0], o[1], o[2], o[3]); w.y = pack4_fp8(o[4], o[5], o[6], o[7]);
                    *(u32x2*)((unsigned char*)H + (size_t)row * ldo + col0) = w;
                } else {
                    u32x4 w; w.x = cvt_pk_bf16(o[0], o[1]); w.y = cvt_pk_bf16(o[2], o[3]); w.z = cvt_pk_bf16(o[4], o[5]); w.w = cvt_pk_bf16(o[6], o[7]);
                    *(u32x4*)((bf16_t*)H + (size_t)row * ldo + col0) = w; } }
    }
};
struct EpiProjFused {
    static constexpr bool PERM = true; static constexpr bool SCALES = false;
    bf16_t* O;
    __device__ __forceinline__ void operator()(const f32x4 (&acc)[2][2][4][2], const Unit& u, int wr, int wc, int fr, int fq) const {
        const int row0 = u.pm * BM + wr * 64 + fr;
        if (u.pn < 4) {
            const int col0 = (u.pn < 2 ? P_GLU : P_V) + (u.pn & 1) * HALF + wc * 32 + 8 * fq;
#pragma unroll
            for (int ai = 0; ai < 2; ++ai)
#pragma unroll
                for (int m = 0; m < 4; ++m) { bf16_t* rowp = O + (size_t)(row0 + ai * HALF + m * 16) * PW + col0;
                    float o[8];
#pragma unroll
                    for (int n = 0; n < 2; ++n)
#pragma unroll
                        for (int j = 0; j < 4; j += 2) { const f32x2 a = {acc[ai][0][m][n][j], acc[ai][0][m][n][j + 1]}, b = {acc[ai][1][m][n][j], acc[ai][1][m][n][j + 1]};
                            f32x2 q;
                            if (u.pn < 2) { const f32x2 e = b * -1.4426950408889634f; f32x2 t = {__builtin_amdgcn_exp2f(e.x), __builtin_amdgcn_exp2f(e.y)}; t = t + 1.0f;
                                const f32x2 r = {__builtin_amdgcn_rcpf(t.x), __builtin_amdgcn_rcpf(t.y)}; q = a * r; }
                            else q = a * b;
                            o[n * 4 + j] = q.x; o[n * 4 + j + 1] = q.y; }
                    u32x4 w; w.x = cvt_pk_bf16(o[0], o[1]); w.y = cvt_pk_bf16(o[2], o[3]); w.z = cvt_pk_bf16(o[4], o[5]); w.w = cvt_pk_bf16(o[6], o[7]);
                    *(u32x4*)rowp = w; }
        } else {
            const int col0 = P_SBG + (u.pn - 4) * BM + wc * 32 + 8 * fq; const bool gl = u.pn >= 7;
#pragma unroll
            for (int ai = 0; ai < 2; ++ai)
#pragma unroll
                for (int m = 0; m < 4; ++m) { bf16_t* rowp = O + (size_t)(row0 + ai * HALF + m * 16) * PW + col0;
#pragma unroll
                    for (int bj = 0; bj < 2; ++bj) { f32x4 v0 = acc[ai][bj][m][0], v1 = acc[ai][bj][m][1];
                        if (gl) {
#pragma unroll
                            for (int j = 0; j < 4; ++j) { const f32x2 x = {v0[j], v1[j]};
                                const f32x2 e = x * ((x * x) * (-2.302208198f * 0.044715f) + -2.302208198f); f32x2 t = {__builtin_amdgcn_exp2f(e.x), __builtin_amdgcn_exp2f(e.y)}; t = t + 1.0f;
                                const f32x2 r = {__builtin_amdgcn_rcpf(t.x), __builtin_amdgcn_rcpf(t.y)}, q = x * r; v0[j] = q.x; v1[j] = q.y; } }
                        u32x4 w; w.x = cvt_pk_bf16(v0[0], v0[1]); w.y = cvt_pk_bf16(v0[2], v0[3]); w.z = cvt_pk_bf16(v1[0], v1[1]); w.w = cvt_pk_bf16(v1[2], v1[3]);
                        *(u32x4*)(rowp + bj * HALF) = w; } }
        }
    }
};
struct EpiProjFusedI8 {
    static constexpr bool PERM = true; static constexpr bool SCALES = true;
    bf16_t* O; const float* rs; const float* cs;
    __device__ __forceinline__ void dma(const Unit& u, LAS unsigned char* slot, int wid, int lane) const {
        const float* src = wid == 0 ? rs + (size_t)u.pm * BM + 4 * lane : cs + (size_t)u.pn * BM + 4 * lane;
        __builtin_amdgcn_global_load_lds((const unsigned*)src, (LAS unsigned*)(slot + wid * 1024), 16, 0, 0); }
    __device__ __forceinline__ void operator()(const v4i_t (&acc)[2][2][4][2], const Unit& u, int wr, int wc, int fr, int fq, const LAS float* sl) const {
        const int row0 = u.pm * BM + wr * 64 + fr, cc0 = u.pn * BM + wc * 32 + 8 * fq;
        const LAS float* cl = sl + 256 + wc * 32 + 8 * fq; const f32x4 ca0 = *(const LAS f32x4*)cl, ca1 = *(const LAS f32x4*)(cl + 4), cb0 = *(const LAS f32x4*)(cl + HALF), cb1 = *(const LAS f32x4*)(cl + HALF + 4);
        f32x2 ca[2][2], cb[2][2];
#pragma unroll
        for (int jp = 0; jp < 2; ++jp) { ca[0][jp] = (f32x2){ca0[2 * jp], ca0[2 * jp + 1]}; ca[1][jp] = (f32x2){ca1[2 * jp], ca1[2 * jp + 1]}; cb[0][jp] = (f32x2){cb0[2 * jp], cb0[2 * jp + 1]}; cb[1][jp] = (f32x2){cb1[2 * jp], cb1[2 * jp + 1]}; }
        if (u.pn < 4) {
            const int col0 = (u.pn < 2 ? P_GLU : P_V) + (u.pn & 1) * HALF + wc * 32 + 8 * fq;
#pragma unroll
            for (int ai = 0; ai < 2; ++ai)
#pragma unroll
                for (int m = 0; m < 4; ++m) { const int row = row0 + ai * HALF + m * 16; bf16_t* rowp = O + (size_t)row * PW + col0; const float r = sl[wr * 64 + fr + ai * HALF + m * 16];
                    float o[8];
#pragma unroll
                    for (int n = 0; n < 2; ++n)
#pragma unroll
                        for (int jp = 0; jp < 2; ++jp) {
                            const f32x2 a = (f32x2){(float)acc[ai][0][m][n][2 * jp], (float)acc[ai][0][m][n][2 * jp + 1]} * (ca[n][jp] * r);
                            const f32x2 b = (f32x2){(float)acc[ai][1][m][n][2 * jp], (float)acc[ai][1][m][n][2 * jp + 1]} * (cb[n][jp] * r);
                            f32x2 q;
                            if (u.pn < 2) { const f32x2 e = b * -1.4426950408889634f; f32x2 t = {__builtin_amdgcn_exp2f(e.x), __builtin_amdgcn_exp2f(e.y)}; t = t + 1.0f;
                                const f32x2 rr = {__builtin_amdgcn_rcpf(t.x), __builtin_amdgcn_rcpf(t.y)}; q = a * rr; }
                            else q = a * b;
                            o[n * 4 + 2 * jp] = q.x; o[n * 4 + 2 * jp + 1] = q.y; }
                    u32x4 w; w.x = cvt_pk_bf16(o[0], o[1]); w.y = cvt_pk_bf16(o[2], o[3]); w.z = cvt_pk_bf16(o[4], o[5]); w.w = cvt_pk_bf16(o[6], o[7]);
                    *(u32x4*)rowp = w; }
        } else {
            const int col0 = P_SBG + (u.pn - 4) * BM + wc * 32 + 8 * fq; const bool gl = u.pn >= 7;
#pragma unroll
            for (int ai = 0; ai < 2; ++ai)
#pragma unroll
                for (int m = 0; m < 4; ++m) { const int row = row0 + ai * HALF + m * 16; bf16_t* rowp = O + (size_t)row * PW + col0; const float r = sl[wr * 64 + fr + ai * HALF + m * 16];
#pragma unroll
                    for (int bj = 0; bj < 2; ++bj) { float o[8];
#pragma unroll
                        for (int n = 0; n < 2; ++n)
#pragma unroll
                            for (int jp = 0; jp < 2; ++jp) {
                                f32x2 x = (f32x2){(float)acc[ai][bj][m][n][2 * jp], (float)acc[ai][bj][m][n][2 * jp + 1]} * ((bj ? cb[n][jp] : ca[n][jp]) * r);
                                if (gl) { const f32x2 e = x * ((x * x) * (-2.302208198f * 0.044715f) + -2.302208198f); f32x2 t = {__builtin_amdgcn_exp2f(e.x), __builtin_amdgcn_exp2f(e.y)}; t = t + 1.0f;
                                    const f32x2 rr = {__builtin_amdgcn_rcpf(t.x), __builtin_amdgcn_rcpf(t.y)}; x = x * rr; }
                                o[n * 4 + 2 * jp] = x.x; o[n * 4 + 2 * jp + 1] = x.y; }
                        u32x4 w; w.x = cvt_pk_bf16(o[0], o[1]); w.y = cvt_pk_bf16(o[2], o[3]); w.z = cvt_pk_bf16(o[4], o[5]); w.w = cvt_pk_bf16(o[6], o[7]);
                        *(u32x4*)(rowp + bj * HALF) = w; } }
        }
    }
};
}

constexpr size_t MiB = 1u << 20;
constexpr size_t WS_CTL = 0;
constexpr size_t WS_MODV = 1 * MiB;
constexpr size_t WS_LRUW = 2 * MiB;
constexpr size_t WS_GCONST = 2 * MiB + 512 * 1024;
constexpr size_t WS_XCTX = 4 * MiB;
constexpr size_t WS_SUMM = 8 * MiB;
constexpr size_t WS_CR = 13 * MiB;
constexpr size_t WS_WIN = 16 * MiB;
constexpr size_t WS_WOUT = 25 * MiB;
constexpr bool WIN8 = false;
constexpr bool WINI8_L0 = true, WINI8_L1 = true;
constexpr bool DENSE_UPI8 = true;
constexpr bool DENSE_UP8 = false, DENSE_DOWN8 = true;
constexpr size_t WS_W13 = 29 * MiB;
constexpr size_t WS_W2 = 40 * MiB;
constexpr size_t WS_ROUTE = 45 * MiB + 512 * 1024;
constexpr size_t WS_WMOE = 48 * MiB;
constexpr size_t WS_HBUF = 114 * MiB;
constexpr size_t WS_BIG = 180 * MiB;
constexpr size_t WS_X16 = WS_BIG + 250 * MiB;
constexpr size_t WS_W13Q = WS_BIG + 317 * MiB;
constexpr size_t WS_W13QS = WS_W13Q + (size_t)2 * DFF * D;
constexpr size_t WS_RS = WS_W13QS + 64 * 1024;
constexpr size_t WS_WINQ = WS_BIG + 324 * MiB;
constexpr size_t WS_WINQS = WS_BIG + 329 * MiB;
constexpr size_t WS_RS1 = WS_WINQS + 64 * 1024;

__device__ __forceinline__ unsigned pk2(float lo, float hi) { return (unsigned)f2bf(lo) | ((unsigned)f2bf(hi) << 16); }
__device__ __forceinline__ int win_row(int n0) {
    if (n0 < 256) return 256 * (n0 >> 7) + (n0 & 127);
    if (n0 < 512) { const int q = n0 - 256; return 256 * (q >> 7) + 128 + (q & 127); }
    if (n0 < 768) return 1024 + (n0 - 512);
    if (n0 < 1024) { const int q = n0 - 768; return 512 + 256 * (q >> 7) + (q & 127); }
    if (n0 < 1280) { const int q = n0 - 1024; return 512 + 256 * (q >> 7) + 128 + (q & 127); }
    return n0;
}
__device__ __forceinline__ void transpose_item(const float* W, int K, int N, bf16_t* WT, int mode, LAS float* scr, int item, int lane) {
    const int nblk = N / 32, kb = item / nblk, nb = item % nblk, k0 = 64 * kb, n0 = 32 * nb;
    const int drow0 = (mode == 0) ? n0 : (mode == 3 ? win_row(n0) : (256 * (n0 >> 7) + (n0 & 127) + (mode == 2 ? 128 : 0)));
#pragma unroll 8
    for (int i = 0; i < 32; ++i) { const int kk = 2 * i + (lane >> 5); scr[kk * 33 + (lane & 31)] = __builtin_nontemporal_load(W + (size_t)(k0 + kk) * N + n0 + (lane & 31)); }
    asm volatile("s_waitcnt lgkmcnt(0)" ::: "memory");
    const int c = lane & 7;
#pragma unroll
    for (int j = 0; j < 4; ++j) { const int n = (lane >> 3) + 8 * j; const LAS float* s = scr + (8 * c) * 33 + n;
        u32x4 o; o.x = pk2(s[0 * 33], s[1 * 33]); o.y = pk2(s[2 * 33], s[3 * 33]); o.z = pk2(s[4 * 33], s[5 * 33]); o.w = pk2(s[6 * 33], s[7 * 33]);
        *(u32x4*)(WT + (size_t)(drow0 + n) * K + k0 + 8 * c) = o; }
    asm volatile("s_waitcnt lgkmcnt(0)" ::: "memory");
}


constexpr int XS = 68;
constexpr int NPOS = 132;
constexpr int CW_BYTES = 16896;
constexpr int CWL_OFF = NWAVES * CW_BYTES;
constexpr float LOG2E = 1.4426950408889634f;
struct MixArgs {
    const bf16_t* proj; bf16_t* ybuf;
    const float* conf_w; const float* conf_b; const float* ln_g; const float* ln_b;
    const float* sconv_w; const float* g_mix;
    const float* cw; const float* cb; const bf16_t* gwt; const float* gconst;
    float* SA; float* SB; float* CR;
    unsigned* AB;
};
__device__ __forceinline__ void unpack8(const u32x4 r, float (&v)[8]) {
    v[0] = __builtin_bit_cast(float, r.x << 16); v[1] = __builtin_bit_cast(float, r.x & 0xffff0000u);
    v[2] = __builtin_bit_cast(float, r.y << 16); v[3] = __builtin_bit_cast(float, r.y & 0xffff0000u);
    v[4] = __builtin_bit_cast(float, r.z << 16); v[5] = __builtin_bit_cast(float, r.z & 0xffff0000u);
    v[6] = __builtin_bit_cast(float, r.w << 16); v[7] = __builtin_bit_cast(float, r.w & 0xffff0000u);
}
__device__ __forceinline__ float fast_exp2(float x) { return __builtin_amdgcn_exp2f(x); }
__device__ __forceinline__ float fast_rcp(float x) { return __builtin_amdgcn_rcpf(x); }
__device__ __forceinline__ float fast_sigmoid(float x) { return fast_rcp(1.0f + fast_exp2(-LOG2E * x)); }
__device__ __forceinline__ float fast_gelu_tanh(float x) { return x * fast_sigmoid(1.5957691216057308f * (x + 0.044715f * x * x * x)); }

__device__ __forceinline__ void a_unit(LAS unsigned char* lds, int tid, int ua, const MixArgs& m) {
    LAS float* g = (LAS float*)lds;
    const int r0 = ua * 32;
    int lo, hi; if (r0 < ML) { lo = (r0 / GW) * GW; hi = lo + GW; } else { lo = ML + ((r0 - ML) / CTXL) * CTXL; hi = lo + CTXL; }
    {
        u32x4 rv[4];
#pragma unroll
        for (int i = 0; i < 4; ++i) {
            const int it = tid + NTHREADS * i, sr = it >> 5, cg = it & 31; int s = r0 - 15 + sr; s = s < lo ? lo : (s >= hi ? hi - 1 : s);
            rv[i] = *(const u32x4*)(m.proj + (size_t)s * PW + P_GLU + 8 * cg);
        }
#pragma unroll
        for (int i = 0; i < 4; ++i) {
            const int it = tid + NTHREADS * i, sr = it >> 5, cg = it & 31, s = r0 - 15 + sr;
            if (it < 62 * 32) {
                float av[8], o[8]; unpack8(rv[i], av);
                const bool ok = (s >= lo && s < hi);
#pragma unroll
                for (int j = 0; j < 8; ++j) o[j] = ok ? av[j] : 0.f;
                *(LAS f32x4*)(g + sr * 256 + 8 * cg) = (f32x4){o[0], o[1], o[2], o[3]};
                *(LAS f32x4*)(g + sr * 256 + 8 * cg + 4) = (f32x4){o[4], o[5], o[6], o[7]};
            }
        }
    }
    const int c = tid & 255, half = tid >> 8;
    float acc[16];
    {
        float w[CONFK];
#pragma unroll
        for (int k = 0; k < CONFK; ++k) w[k] = m.conf_w[k * 256 + c];
        const float cb = m.conf_b[c];
        f32x2 wp[CONFK + 1];
#pragma unroll
        for (int k = 0; k <= CONFK; ++k) wp[k] = (f32x2){k < CONFK ? w[k] : 0.f, k > 0 ? w[k - 1] : 0.f};
        __syncthreads();
        f32x2 ac2[8];
#pragma unroll
        for (int t = 0; t < 8; ++t) ac2[t] = (f32x2){cb, cb};
#pragma unroll
        for (int j = 0; j < 46; ++j) {
            const float gv = g[(half * 16 + j) * 256 + c];
#pragma unroll
            for (int tp = 0; tp < 8; ++tp) { const int k = j - 2 * tp; if (k >= 0 && k <= CONFK) ac2[tp] = wp[k] * gv + ac2[tp]; }
        }
#pragma unroll
        for (int t = 0; t < 8; ++t) { acc[2 * t] = ac2[t].x; acc[2 * t + 1] = ac2[t].y; }
    }
    __syncthreads();
#pragma unroll
    for (int t = 0; t < 16; ++t) g[(half * 16 + t) * 256 + c] = acc[t];
    __syncthreads();
    {
        const int wave = tid >> 6, lane = tid & 63;
        const f32x4 lg = *(const f32x4*)(m.ln_g + 4 * lane), lb = *(const f32x4*)(m.ln_b + 4 * lane), gm = *(const f32x4*)(m.g_mix + 4 * lane);
#pragma unroll
        for (int q = 0; q < 4; ++q) {
            const int t = wave * 4 + q;
            const f32x4 u4 = *(const LAS f32x4*)(g + t * 256 + 4 * lane);
            const float mean = wave_sum((u4[0] + u4[1]) + (u4[2] + u4[3])) * (1.0f / 256.0f);
            const f32x4 d = u4 - mean;
            const float var = wave_sum((d[0] * d[0] + d[1] * d[1]) + (d[2] * d[2] + d[3] * d[3])) * (1.0f / 256.0f);
            const float rstd = rsqrtf(var + EPS);
            f32x4 ya;
#pragma unroll
            for (int j = 0; j < 4; ++j) { const float ln = d[j] * rstd * lg[j] + lb[j]; ya[j] = ln * fast_sigmoid(ln); }
            float hs = (ya[0] * ya[0] + ya[1] * ya[1]) + (ya[2] * ya[2] + ya[3] * ya[3]);
            hs += __shfl_xor(hs, 1); hs += __shfl_xor(hs, 2); hs += __shfl_xor(hs, 4); hs += __shfl_xor(hs, 8);
            const float hr = rsqrtf(hs * (1.0f / 64.0f) + EPS);
            u32x2 o; o.x = cvt_pk_bf16(ya[0] * hr * gm[0], ya[1] * hr * gm[1]); o.y = cvt_pk_bf16(ya[2] * hr * gm[2], ya[3] * hr * gm[3]);
            *(u32x2*)(m.ybuf + (size_t)(r0 + t) * D + 4 * lane) = o;
        }
    }
    __syncthreads();
}
__device__ __forceinline__ void b_unit(int tid, int ub, const MixArgs& m) {
    const int r0 = ub * 64;
#pragma unroll
    for (int i = 0; i < 4; ++i) {
        const int it = tid + NTHREADS * i, r = r0 + (it >> 5), cg = it & 31;
        int lo, hi, step; if (r < ML) { lo = (r / SEQ) * SEQ; hi = lo + SEQ; step = GW; } else { lo = ML + ((r - ML) / CTXL) * CTXL; hi = lo + CTXL; step = 1; }
        u32x4 rc[3];
#pragma unroll
        for (int k = 0; k < 3; ++k) { int s = r + (k - 1) * step; s = (s >= lo && s < hi) ? s : r; rc[k] = *(const u32x4*)(m.proj + (size_t)s * PW + P_V + 8 * cg); }
        const u32x4 rb = *(const u32x4*)(m.proj + (size_t)r * PW + P_SBG + 8 * cg);
        float acc[8];
#pragma unroll
        for (int j = 0; j < 8; ++j) acc[j] = 0.f;
#pragma unroll
        for (int k = 0; k < 3; ++k) {
            const int s = r + (k - 1) * step; const float ok = (s >= lo && s < hi) ? 1.f : 0.f;
            float cv[8]; unpack8(rc[k], cv);
            const f32x4 w0 = *(const f32x4*)(m.sconv_w + k * 256 + 8 * cg) * ok, w1 = *(const f32x4*)(m.sconv_w + k * 256 + 8 * cg + 4) * ok;
#pragma unroll
            for (int j = 0; j < 4; ++j) { acc[j] += w0[j] * cv[j]; acc[4 + j] += w1[j] * cv[4 + j]; }
        }
        float bg[8]; unpack8(rb, bg);
        float ss = 0.f;
#pragma unroll
        for (int j = 0; j < 8; ++j) { acc[j] *= bg[j]; ss += acc[j] * acc[j]; }
        ss += __shfl_xor(ss, 1); ss += __shfl_xor(ss, 2); ss += __shfl_xor(ss, 4);
        const float hr = rsqrtf(ss * (1.0f / 64.0f) + EPS);
        const f32x4 g0 = *(const f32x4*)(m.g_mix + 256 + 8 * cg), g1 = *(const f32x4*)(m.g_mix + 256 + 8 * cg + 4);
        u32x4 o; o.x = cvt_pk_bf16(acc[0] * hr * g0[0], acc[1] * hr * g0[1]); o.y = cvt_pk_bf16(acc[2] * hr * g0[2], acc[3] * hr * g0[3]);
        o.z = cvt_pk_bf16(acc[4] * hr * g1[0], acc[5] * hr * g1[1]); o.w = cvt_pk_bf16(acc[6] * hr * g1[2], acc[7] * hr * g1[3]);
        *(u32x4*)(m.ybuf + (size_t)r * D + 256 + 8 * cg) = o;
    }
}
__device__ __forceinline__ void c_prep(LAS unsigned char* lds, int tid, const MixArgs& m) {
    LAS float* cwl = (LAS float*)(lds + CWL_OFF);
    for (int i = tid; i < 5 * LRU; i += NTHREADS) cwl[i] = i < 4 * LRU ? m.cw[i] : m.cb[i - 4 * LRU];
    __syncthreads();
}
__device__ __forceinline__ void c_summary_unit(LAS unsigned char* lds, int wave, int lane, int b, int p, const MixArgs& m) {
    const int ch0 = 64 * wave, fr = lane & 15, fq = lane >> 4, ch = ch0 + lane;
    LAS float* As = (LAS float*)(lds + wave * CW_BYTES);
    LAS float* Bs = As + 16 * XS;
    const LAS float* cwl = (const LAS float*)(lds + CWL_OFF);
    const int r0 = p < 4 ? ML + b * CTXL + 64 * p : b * SEQ + 64 * (p - 4);
    const int seq_lo = p < 4 ? ML + b * CTXL : b * SEQ, seq_hi = seq_lo + (p < 4 ? CTXL : SEQ);
    const int cl = ch0 + 8 * (lane & 7);
    const bf16_t* pcx = m.proj + P_CX + cl;
#pragma unroll 1
    for (int dir = 0; dir < 2; ++dir) {
        bf16x8 fa[4][2], fx[4][2]; float bav[4], bxv[4], c1v[4];
        {
            const bf16_t* wA = m.gwt + ((size_t)((dir * 2 + 0) * 8 + wave) * 64 + fr) * 64 + 8 * fq;
            const bf16_t* wX = m.gwt + ((size_t)((dir * 2 + 1) * 8 + wave) * 64 + fr) * 64 + 8 * fq;
#pragma unroll
            for (int nt = 0; nt < 4; ++nt) {
#pragma unroll
                for (int ks = 0; ks < 2; ++ks) { fa[nt][ks] = *(const bf16x8*)(wA + (size_t)nt * 16 * 64 + 32 * ks); fx[nt][ks] = *(const bf16x8*)(wX + (size_t)nt * 16 * 64 + 32 * ks); }
                const int cc = ch0 + 16 * nt + fr;
                bav[nt] = m.gconst[(dir * 3 + 0) * LRU + cc]; bxv[nt] = m.gconst[(dir * 3 + 1) * LRU + cc]; c1v[nt] = m.gconst[(dir * 3 + 2) * LRU + cc];
            }
        }
        float Hn[4] = {0.f, 0.f, 0.f, 0.f}, Pn[4] = {1.f, 1.f, 1.f, 1.f};
        unsigned* abp = m.AB + ((size_t)dir * MA + r0) * LRU + ch0;
        u32x4 raw[2][4];
        auto issue = [&](int blk) __attribute__((always_inline)) {
#pragma unroll
            for (int ps = 0; ps < 2; ++ps) { const int r = r0 + 16 * blk + ps * 8 + (lane >> 3);
#pragma unroll
                for (int k = 0; k < 4; ++k) { int s = r + k - 2; s = s < seq_lo ? seq_lo : (s >= seq_hi ? seq_hi - 1 : s); raw[ps][k] = *(const u32x4*)(pcx + (size_t)s * PW); } }
        };
        issue(dir == 0 ? 0 : 3);
#pragma unroll 1
        for (int ib = 0; ib < 4; ++ib) {
            const int blk = dir == 0 ? ib : 3 - ib;
#pragma unroll
            for (int ps = 0; ps < 2; ++ps) {
                const int tt = ps * 8 + (lane >> 3), r = r0 + 16 * blk + tt;
                const f32x4 b0 = *(const LAS f32x4*)(cwl + 4 * LRU + cl), b1 = *(const LAS f32x4*)(cwl + 4 * LRU + cl + 4);
                f32x2 a2[4] = {{b0[0], b0[1]}, {b0[2], b0[3]}, {b1[0], b1[1]}, {b1[2], b1[3]}};
#pragma unroll
                for (int k = 0; k < 4; ++k) { const int s = r + k - 2; const bool ok = (s >= seq_lo && s < seq_hi);
                    u32x4 rv = raw[ps][k]; if (!ok) rv = (u32x4){0u, 0u, 0u, 0u};
                    const f32x4 w0 = *(const LAS f32x4*)(cwl + k * LRU + cl), w1 = *(const LAS f32x4*)(cwl + k * LRU + cl + 4);
                    const f32x2 v0 = {__uint_as_float(rv.x << 16), __uint_as_float(rv.x & 0xffff0000u)}, v1 = {__uint_as_float(rv.y << 16), __uint_as_float(rv.y & 0xffff0000u)};
                    const f32x2 v2 = {__uint_as_float(rv.z << 16), __uint_as_float(rv.z & 0xffff0000u)}, v3 = {__uint_as_float(rv.w << 16), __uint_as_float(rv.w & 0xffff0000u)};
                    a2[0] = (f32x2){w0[0], w0[1]} * v0 + a2[0]; a2[1] = (f32x2){w0[2], w0[3]} * v1 + a2[1]; a2[2] = (f32x2){w1[0], w1[1]} * v2 + a2[2]; a2[3] = (f32x2){w1[2], w1[3]} * v3 + a2[3]; }
                *(LAS f32x4*)(Bs + tt * XS + 8 * (lane & 7)) = (f32x4){a2[0].x, a2[0].y, a2[1].x, a2[1].y};
                *(LAS f32x4*)(Bs + tt * XS + 8 * (lane & 7) + 4) = (f32x4){a2[2].x, a2[2].y, a2[3].x, a2[3].y};
            }
            if (ib < 3) issue(dir == 0 ? ib + 1 : 2 - ib);
            bf16x8 xa[2]; float xcv[4][4];
#pragma unroll
            for (int ks = 0; ks < 2; ++ks) {
                const f32x4 lo4 = *(const LAS f32x4*)(Bs + fr * XS + 32 * ks + 8 * fq), hi4 = *(const LAS f32x4*)(Bs + fr * XS + 32 * ks + 8 * fq + 4);
                const unsigned p0 = cvt_pk_bf16(lo4[0], lo4[1]), p1 = cvt_pk_bf16(lo4[2], lo4[3]), p2 = cvt_pk_bf16(hi4[0], hi4[1]), p3 = cvt_pk_bf16(hi4[2], hi4[3]);
                xa[ks] = __builtin_bit_cast(bf16x8, (u32x4){p0, p1, p2, p3});
            }
#pragma unroll
            for (int nt = 0; nt < 4; ++nt)
#pragma unroll
                for (int j = 0; j < 4; ++j) xcv[nt][j] = Bs[(4 * fq + j) * XS + 16 * nt + fr];
#pragma unroll
            for (int nt = 0; nt < 4; ++nt) {
                f32x4 ga = (f32x4){0.f, 0.f, 0.f, 0.f}, gx = (f32x4){0.f, 0.f, 0.f, 0.f};
#pragma unroll
                for (int ks = 0; ks < 2; ++ks) { ga = __builtin_amdgcn_mfma_f32_16x16x32_bf16(xa[ks], fa[nt][ks], ga, 0, 0, 0); gx = __builtin_amdgcn_mfma_f32_16x16x32_bf16(xa[ks], fx[nt][ks], gx, 0, 0, 0); }
                float av[4], bv[4];
#pragma unroll
                for (int j = 0; j < 4; j += 2) {
                    const f32x2 ea = (f32x2){ga[j], ga[j + 1]} + bav[nt], ex = (f32x2){gx[j], gx[j + 1]} + bxv[nt];
                    f32x2 ta = {fast_exp2(ea.x), fast_exp2(ea.y)}, tx = {fast_exp2(ex.x), fast_exp2(ex.y)}; ta = ta + 1.0f; tx = tx + 1.0f;
                    const f32x2 rr = {fast_rcp(ta.x), fast_rcp(ta.y)}, ii = {fast_rcp(tx.x), fast_rcp(tx.y)};
                    const f32x2 la = rr * c1v[nt]; const f32x2 a = {fast_exp2(la.x), fast_exp2(la.y)};
                    const f32x2 om = 1.0f - a * a;
                    const f32x2 mult = {__builtin_amdgcn_sqrtf(fmaxf(om.x, 0.f)), __builtin_amdgcn_sqrtf(fmaxf(om.y, 0.f))};
                    const f32x2 bb = mult * (ii * (f32x2){xcv[nt][j], xcv[nt][j + 1]});
                    av[j] = a.x; av[j + 1] = a.y; bv[j] = bb.x; bv[j + 1] = bb.y;
                }
                unsigned* abq = abp + (size_t)(16 * blk + 4 * fq) * LRU + 16 * nt + fr;
#pragma unroll
                for (int j = 0; j < 4; ++j) abq[(size_t)j * LRU] = cvt_pk_bf16(bv[j], 1.0f - av[j]);
                float Ac, Bc;
                if (dir == 0) { Ac = av[0]; Bc = bv[0];
#pragma unroll
                    for (int j = 1; j < 4; ++j) { Bc = av[j] * Bc + bv[j]; Ac *= av[j]; } }
                else { Ac = av[3]; Bc = bv[3];
#pragma unroll
                    for (int j = 2; j >= 0; --j) { Bc = av[j] * Bc + bv[j]; Ac *= av[j]; } }
#pragma unroll
                for (int st = 0; st < 2; ++st) {
                    const float Ap = __shfl_xor(Ac, 16 << st), Bp = __shfl_xor(Bc, 16 << st);
                    const bool mine_later = (((fq >> st) & 1) != 0) == (dir == 0);
                    const float Al = mine_later ? Ac : Ap, Bl = mine_later ? Bc : Bp, Ae = mine_later ? Ap : Ac, Be = mine_later ? Bp : Bc;
                    Ac = Al * Ae; Bc = Al * Be + Bl;
                }
                Hn[nt] = Ac * Hn[nt] + Bc; Pn[nt] *= Ac;
            }
        }
        if (fq == 0) {
#pragma unroll
            for (int nt = 0; nt < 4; ++nt) { const size_t o = ((size_t)(dir * NB + b) * NPOS + p) * LRU + ch0 + 16 * nt + fr; m.SA[o] = Pn[nt]; m.SB[o] = Hn[nt]; }
        }
    }
}
__device__ __forceinline__ void c_final_unit(LAS unsigned char* lds, int wave, int lane, int b, int p, const MixArgs& m, bool self_fold) {
    const int ch0 = 64 * wave, ch = ch0 + lane;
    LAS float* As = (LAS float*)(lds + wave * CW_BYTES);
    LAS bf16_t* hfb = (LAS bf16_t*)(lds + wave * CW_BYTES + 2 * 16 * XS * 4);
    const int r0 = p < 4 ? ML + b * CTXL + 64 * p : b * SEQ + 64 * (p - 4);
    float hf = 0.f, hb = 0.f;
    if (self_fold) {
        const float* sa0 = m.SA + (size_t)(0 * NB + b) * NPOS * LRU + ch; const float* sb0 = m.SB + (size_t)(0 * NB + b) * NPOS * LRU + ch;
        const float* sa1 = m.SA + (size_t)(1 * NB + b) * NPOS * LRU + ch; const float* sb1 = m.SB + (size_t)(1 * NB + b) * NPOS * LRU + ch;
        for (int j = 0; j < p; ++j) hf = sa0[(size_t)j * LRU] * hf + sb0[(size_t)j * LRU];
        for (int j = 3; j > p; --j) hb = sa1[(size_t)j * LRU] * hb + sb1[(size_t)j * LRU];
    } else {
        hf = m.CR[((size_t)(0 * NB + b) * NPOS + p) * LRU + ch]; hb = m.CR[((size_t)(1 * NB + b) * NPOS + p) * LRU + ch];
    }
    const unsigned* ab0 = m.AB + ((size_t)0 * MA + r0) * LRU + ch; const unsigned* ab1 = m.AB + ((size_t)1 * MA + r0) * LRU + ch;
    unsigned wf[64], wb[64];
#pragma unroll
    for (int t = 0; t < 64; ++t) wf[t] = ab0[(size_t)t * LRU];
#pragma unroll
    for (int t = 0; t < 64; ++t) wb[t] = ab1[(size_t)t * LRU];
#pragma unroll
    for (int t = 0; t < 64; ++t) { const float bb = __builtin_bit_cast(float, wf[t] << 16), om = __builtin_bit_cast(float, wf[t] & 0xffff0000u); hf = (1.0f - om) * hf + bb; hfb[t * 64 + lane] = f2bf(hf); }
    const f32x4 gm0 = *(const f32x4*)(m.g_mix + 512 + ch0 + 16 * (lane & 3)), gm1 = *(const f32x4*)(m.g_mix + 512 + ch0 + 16 * (lane & 3) + 4),
                gm2 = *(const f32x4*)(m.g_mix + 512 + ch0 + 16 * (lane & 3) + 8), gm3 = *(const f32x4*)(m.g_mix + 512 + ch0 + 16 * (lane & 3) + 12);
    const float gm[16] = {gm0[0], gm0[1], gm0[2], gm0[3], gm1[0], gm1[1], gm1[2], gm1[3], gm2[0], gm2[1], gm2[2], gm2[3], gm3[0], gm3[1], gm3[2], gm3[3]};
    u32x4 cgr[4][2];
#pragma unroll
    for (int blk = 0; blk < 4; ++blk) { const bf16_t* pg = m.proj + (size_t)(r0 + 16 * blk + (lane >> 2)) * PW + P_CG + ch0 + 16 * (lane & 3); cgr[blk][0] = *(const u32x4*)pg; cgr[blk][1] = *(const u32x4*)(pg + 8); }
#pragma unroll
    for (int blk = 3; blk >= 0; --blk) {
#pragma unroll
        for (int tt = 15; tt >= 0; --tt) { const unsigned w = wb[16 * blk + tt]; const float bb = __builtin_bit_cast(float, w << 16), om = __builtin_bit_cast(float, w & 0xffff0000u); hb = (1.0f - om) * hb + bb;
            As[tt * XS + lane] = hb + bf2f(hfb[(16 * blk + tt) * 64 + lane]); }
        {
            const int tt = lane >> 2, q = lane & 3, r = r0 + 16 * blk + tt;
            float ys[16], cg[16];
#pragma unroll
            for (int v4 = 0; v4 < 4; ++v4) { const f32x4 t4 = *(const LAS f32x4*)(As + tt * XS + 16 * q + 4 * v4); ys[4 * v4] = t4[0]; ys[4 * v4 + 1] = t4[1]; ys[4 * v4 + 2] = t4[2]; ys[4 * v4 + 3] = t4[3]; }
            { float t8[8]; unpack8(cgr[blk][0], t8);
#pragma unroll
              for (int j = 0; j < 8; ++j) cg[j] = t8[j];
              unpack8(cgr[blk][1], t8);
#pragma unroll
              for (int j = 0; j < 8; ++j) cg[8 + j] = t8[j]; }
            float ss = 0.f;
#pragma unroll
            for (int j = 0; j < 16; ++j) { ys[j] *= cg[j]; ss += ys[j] * ys[j]; }
            ss += __shfl_xor(ss, 1); ss += __shfl_xor(ss, 2);
            const float hr = rsqrtf(ss * (1.0f / 64.0f) + EPS);
            u32x4 o0, o1;
            o0.x = cvt_pk_bf16(ys[0] * hr * gm[0], ys[1] * hr * gm[1]); o0.y = cvt_pk_bf16(ys[2] * hr * gm[2], ys[3] * hr * gm[3]);
            o0.z = cvt_pk_bf16(ys[4] * hr * gm[4], ys[5] * hr * gm[5]); o0.w = cvt_pk_bf16(ys[6] * hr * gm[6], ys[7] * hr * gm[7]);
            o1.x = cvt_pk_bf16(ys[8] * hr * gm[8], ys[9] * hr * gm[9]); o1.y = cvt_pk_bf16(ys[10] * hr * gm[10], ys[11] * hr * gm[11]);
            o1.z = cvt_pk_bf16(ys[12] * hr * gm[12], ys[13] * hr * gm[13]); o1.w = cvt_pk_bf16(ys[14] * hr * gm[14], ys[15] * hr * gm[15]);
            bf16_t* yo = m.ybuf + (size_t)r * D + 512 + ch0 + 16 * q;
            *(u32x4*)yo = o0; *(u32x4*)(yo + 8) = o1;
        }
    }
}
__device__ __forceinline__ void carry_task(int gid, const MixArgs& m) {
    const int ch = gid & 511, dir = (gid >> 9) & 1, b = gid >> 10;
    const float* sa = m.SA + (size_t)(dir * NB + b) * NPOS * LRU + ch; const float* sb = m.SB + (size_t)(dir * NB + b) * NPOS * LRU + ch;
    float* cr = m.CR + (size_t)(dir * NB + b) * NPOS * LRU + ch;
    float h = 0.f;
    if (dir == 0) {
#pragma unroll 33
        for (int p = 0; p < NPOS; ++p) { const float a = sa[(size_t)p * LRU], bb = sb[(size_t)p * LRU]; cr[(size_t)p * LRU] = h; h = a * h + bb; }
    } else {
#pragma unroll
        for (int p = 3; p >= 0; --p) { const float a = sa[(size_t)p * LRU], bb = sb[(size_t)p * LRU]; cr[(size_t)p * LRU] = h; h = a * h + bb; }
#pragma unroll 32
        for (int p = NPOS - 1; p >= 4; --p) { const float a = sa[(size_t)p * LRU], bb = sb[(size_t)p * LRU]; cr[(size_t)p * LRU] = h; h = a * h + bb; }
    }
}
constexpr int REP_CS = 1, REP_B = 1, REP_CF = 1;
__device__ __forceinline__ void mix_phase(LAS unsigned char* lds, int tid, int wave, int lane, int G, const MixArgs& m, int n_a_units, unsigned* ctr) {
    const int nC = NB * NPOS, total = nC + n_a_units;
    volatile LAS int* nxt = (volatile LAS int*)(lds + LDS_BYTES - 32);
    c_prep(lds, tid, m);
    int u = blockIdx.x;
#pragma unroll 1
    for (int rep = 0; rep < REP_CS; ++rep) {
#pragma unroll 1
        while (u < nC) {
            if (tid == 0) *nxt = G + (int)__hip_atomic_fetch_add(ctr, 1u, __ATOMIC_RELAXED, __HIP_MEMORY_SCOPE_AGENT);
            c_summary_unit(lds, wave, lane, u / NPOS, u % NPOS, m);
            __syncthreads();
            u = *nxt;
            __syncthreads();
        }
        if (rep + 1 < REP_CS) u = blockIdx.x;
    }
#pragma unroll 1
    while (u < total) {
        if (tid == 0) *nxt = G + (int)__hip_atomic_fetch_add(ctr, 1u, __ATOMIC_RELAXED, __HIP_MEMORY_SCOPE_AGENT);
        a_unit(lds, tid, u - nC, m);
        u = *nxt;
        __syncthreads();
    }
}
__device__ __forceinline__ void carry_phase(LAS unsigned char* lds, int tid, int wave, int lane, int G, const MixArgs& m, int ctx_too, int n_b_units) {
    if (blockIdx.x < 8) carry_task((int)blockIdx.x * NTHREADS + tid, m);
    else if (ctx_too && blockIdx.x < 24) { const int u = (int)blockIdx.x - 8; c_final_unit(lds, wave, lane, u >> 2, u & 3, m, true); }
#pragma unroll 1
    for (int rep = 0; rep < REP_B; ++rep)
#pragma unroll 1
    for (int u = (int)((blockIdx.x + G - 24) % G); u < n_b_units; u += G) b_unit(tid, u, m);
}
__device__ __forceinline__ void cfin_phase(LAS unsigned char* lds, int tid, int wave, int lane, int G, const MixArgs& m) {
    const int nC = NB * (NPOS - 4);
#pragma unroll 1
    for (int rep = 0; rep < REP_CF; ++rep)
#pragma unroll 1
    for (int u = blockIdx.x; u < nC; u += G) c_final_unit(lds, wave, lane, u / (NPOS - 4), 4 + u % (NPOS - 4), m, false);
}

constexpr int CW_WQ = 2048;
constexpr int CW_CNT = 1024;
constexpr size_t EXP_STRIDE = (size_t)(2 * DFF * D + D * DFF);
constexpr size_t EXP_W2_OFF = (size_t)2 * DFF * D;
constexpr size_t RT_E = 0;
constexpr size_t RT_P = 256 * 1024;
constexpr size_t RT_POS = 512 * 1024;
constexpr size_t RT_IDX = 1024 * 1024;
constexpr int MAXT = 264;
constexpr size_t WS_Y = WS_HBUF;
constexpr size_t WS_H8MOE = WS_BIG + 66 * MiB;

typedef int i32x2 __attribute__((ext_vector_type(2)));

template <bool ROUTE, int OUTM  >
__device__ __forceinline__ void norm_phase(LAS unsigned char* lds, int tid, int wave, int lane, int G, const float* xl, const float* xc, const float* g, const float* modv_l, int sh_off, int sc_off,
                                           bf16_t* out, int rows, const float* wr, const float* br, unsigned* ctl, unsigned char* route, float* rsc = nullptr, bool nt_x = false, const bf16_t* xs16 = nullptr,
                                           int first_block = 0, int nblocks = 0, int row_lo = 0) {
    LAS float* wrT = (LAS float*)lds;
    LAS unsigned* lcnt = (LAS unsigned*)(lds + 32768);
    if (ROUTE) {
        for (int i = tid; i < D * NE; i += NTHREADS) wrT[(i & 7) * D + (i >> 3)] = wr[i];
        if (tid < 32) lcnt[tid] = 0u;
        __syncthreads();
    }
    const int gw = ((int)blockIdx.x - first_block) * NWAVES + wave, NGW = (nblocks ? nblocks : G) * NWAVES;
    const int rpw = (rows + NGW - 1) / NGW;
    const int rbeg0 = gw * rpw, rbeg = row_lo + (rbeg0 < rows ? rbeg0 : rows), rend = row_lo + ((rbeg0 + rpw < rows) ? rbeg0 + rpw : rows);
    int cur_mod = -1; f32x4 Gv[4], Sv[4];
    int my_e0 = 0, my_e1 = 0, my_l0 = 0, my_l1 = 0; float my_p0 = 0.f, my_p1 = 0.f;
#pragma unroll 1
    for (int row = rbeg; row < rend; ++row) {
        const int mr = row_modidx(row);
        if (mr != cur_mod) { cur_mod = mr; const float* mv = modv_l + (size_t)mr * 6144;
#pragma unroll
            for (int j = 0; j < 4; ++j) { const int c = 4 * lane + 256 * j; const f32x4 gg = *(const f32x4*)(g + c), sc = *(const f32x4*)(mv + sc_off + c); Gv[j] = gg * (sc + 1.0f); Sv[j] = *(const f32x4*)(mv + sh_off + c); } }
        const float* xr = row < ML ? xl + (size_t)row * D : xc + (size_t)(row - ML) * D;
        f32x4 v[4]; float ss = 0.f;
#pragma unroll
        for (int j = 0; j < 4; ++j) {
            if (xs16) { const u32x2 r = *(const u32x2*)(xs16 + (size_t)row * D + 4 * lane + 256 * j); v[j][0] = __builtin_bit_cast(float, r.x << 16); v[j][1] = __builtin_bit_cast(float, r.x & 0xffff0000u); v[j][2] = __builtin_bit_cast(float, r.y << 16); v[j][3] = __builtin_bit_cast(float, r.y & 0xffff0000u); }
            else v[j] = nt_x ? __builtin_nontemporal_load((const f32x4*)(xr + 4 * lane + 256 * j)) : *(const f32x4*)(xr + 4 * lane + 256 * j);
            ss += (v[j][0] * v[j][0] + v[j][1] * v[j][1]) + (v[j][2] * v[j][2] + v[j][3] * v[j][3]); }
        ss = wave_sum(ss);
        const float rstd = rsqrtf(ss * (1.0f / D) + EPS);
#pragma unroll
        for (int j = 0; j < 4; ++j) { v[j] = (v[j] * rstd) * Gv[j] + Sv[j];
            if (OUTM == 1) *(unsigned*)((unsigned char*)out + (size_t)row * D + 4 * lane + 256 * j) = pg8::pack4_fp8(v[j][0], v[j][1], v[j][2], v[j][3]);
            else if (OUTM == 0) { u32x2 o; o.x = cvt_pk_bf16(v[j][0], v[j][1]); o.y = cvt_pk_bf16(v[j][2], v[j][3]); *(u32x2*)(out + (size_t)row * D + 4 * lane + 256 * j) = o; } }
        if (OUTM == 2) {
            float am = 0.f;
#pragma unroll
            for (int j = 0; j < 4; ++j) am = fmaxf(am, fmaxf(fmaxf(fabsf(v[j][0]), fabsf(v[j][1])), fmaxf(fabsf(v[j][2]), fabsf(v[j][3]))));
#pragma unroll
            for (int o = 1; o < 64; o <<= 1) am = fmaxf(am, __shfl_xor(am, o));
            am = fmaxf(am, 1e-20f);
            const float qs = 127.0f / am;
#pragma unroll
            for (int j = 0; j < 4; ++j) { const int q0 = (int)__builtin_rintf(v[j][0] * qs), q1 = (int)__builtin_rintf(v[j][1] * qs), q2 = (int)__builtin_rintf(v[j][2] * qs), q3 = (int)__builtin_rintf(v[j][3] * qs);
                *(unsigned*)((unsigned char*)out + (size_t)row * D + 4 * lane + 256 * j) = (unsigned)(q0 & 0xff) | ((unsigned)(q1 & 0xff) << 8) | ((unsigned)(q2 & 0xff) << 16) | ((unsigned)(q3 & 0xff) << 24); }
            if (lane == 0) rsc[row] = am * (1.0f / 127.0f);
        }
        if (ROUTE) {
            float lg[NE];
#pragma unroll
            for (int e = 0; e < NE; ++e) { float a = 0.f;
#pragma unroll
                for (int j = 0; j < 4; ++j) { const f32x4 w4 = *(const LAS f32x4*)(wrT + e * D + 4 * lane + 256 * j); a += (v[j][0] * w4[0] + v[j][1] * w4[1]) + (v[j][2] * w4[2] + v[j][3] * w4[3]); }
                lg[e] = wave_sum(a) + br[e]; }
            int i0 = 0; float v0 = lg[0];
#pragma unroll
            for (int e = 1; e < NE; ++e) if (lg[e] > v0) { v0 = lg[e]; i0 = e; }
            int i1 = 0; float v1 = -3.0e38f;
#pragma unroll
            for (int e = 0; e < NE; ++e) if (e != i0 && lg[e] > v1) { v1 = lg[e]; i1 = e; }
            const float e1 = __expf(v1 - v0), p0 = 1.0f / (1.0f + e1), p1 = e1 / (1.0f + e1);
            if (lane == row - rbeg) {
                my_e0 = i0; my_e1 = i1; my_p0 = p0; my_p1 = p1;
                my_l0 = (int)__hip_atomic_fetch_add(lcnt + i0, 1u, __ATOMIC_RELAXED, __HIP_MEMORY_SCOPE_WORKGROUP);
                my_l1 = (int)__hip_atomic_fetch_add(lcnt + i1, 1u, __ATOMIC_RELAXED, __HIP_MEMORY_SCOPE_WORKGROUP);
            }
        }
    }
    if (ROUTE) {
        __syncthreads();
        if (tid < 8) { const unsigned n = lcnt[tid]; lcnt[16 + tid] = n ? __hip_atomic_fetch_add(ctl + CW_CNT + tid * 64, n, __ATOMIC_RELAXED, __HIP_MEMORY_SCOPE_AGENT) : 0u; }
        __syncthreads();
        const int row = rbeg + lane;
        if (row < rend) {
            const int pos0 = (int)lcnt[16 + my_e0] + my_l0, pos1 = (int)lcnt[16 + my_e1] + my_l1;
            ((i32x2*)(route + RT_E))[row] = (i32x2){my_e0, my_e1};
            ((f32x2*)(route + RT_P))[row] = (f32x2){my_p0, my_p1};
            ((i32x2*)(route + RT_POS))[row] = (i32x2){pos0, pos1};
            int* ridx = (int*)(route + RT_IDX);
            ridx[(size_t)my_e0 * ML + pos0] = row;
            ridx[(size_t)my_e1 * ML + pos1] = row;
        }
    }
}

struct MoeTiles { int toff[9]; };
__device__ __forceinline__ void moe_tiles(const unsigned* ctl, MoeTiles& t) {
    int acc = 0;
#pragma unroll
    for (int e = 0; e < 8; ++e) { const int c = (int)__builtin_amdgcn_readfirstlane(__hip_atomic_load(ctl + CW_CNT + e * 64, __ATOMIC_RELAXED, __HIP_MEMORY_SCOPE_AGENT)); t.toff[e] = acc; acc += (c + 255) >> 8; }
    t.toff[8] = acc;
}
namespace pg8 {
struct MoeUpSched {
    static constexpr bool GATHER = true;
    Order o; MoeTiles t; const char* hb; const char* wmoe; const int* ridx; const unsigned* cntp; size_t tstepB;
    __device__ __forceinline__ void init(const void* hbuf8, const unsigned char* wmoe_, const int* ridx_, const unsigned* ctl, int G, int c) {
        moe_tiles(ctl, t); o.init(t.toff[8], (2 * DFF) / BM, G, c); cntp = ctl + CW_CNT; hb = (const char*)hbuf8; wmoe = (const char*)wmoe_; ridx = ridx_; tstepB = (size_t)BM * D; }
    __device__ __forceinline__ bool next(int i, Unit& u) const {
        if (!o.lin(i, u.pm, u.pn)) return false;
        int e = 0, ts = 0;
#pragma unroll
        for (int k = 1; k < 8; ++k) if (u.pm >= t.toff[k]) { e = k; ts = t.toff[k]; }
        u.e = e; u.rb = (u.pm - ts) * BM; u.cnt = (int)cntp[e * 64];
        u.a = hb; u.b = wmoe + (size_t)e * EXP_STRIDE + (size_t)u.pn * tstepB; return true;
    }
    __device__ __forceinline__ unsigned arow(const Unit& u, int r) const { const int idx = u.rb + r; return (unsigned)ridx[(size_t)u.e * ML + (idx < u.cnt ? idx : 0)]; }
    __device__ __forceinline__ void idx_dma(const Unit& u, LAS unsigned char* slot, int lane) const {
        __builtin_amdgcn_global_load_lds((const unsigned*)(ridx + (size_t)u.e * ML + u.rb + lane * 4), (LAS unsigned*)slot, 16, 0, 0); }
    __device__ __forceinline__ unsigned arow_lds(const Unit& u, int r, const LAS int* ix) const { return (unsigned)ix[(u.rb + r < u.cnt) ? r : 0]; }
    __device__ __forceinline__ void a_ready(const Unit&) const {}
    __device__ __forceinline__ void done(const Unit&) const {}
};
struct MoeDownSched {
    static constexpr bool GATHER = false;
    Order o; MoeTiles t; const char* H; const char* wmoe; size_t tstep;
    __device__ __forceinline__ void init(const void* Hc, const unsigned char* wmoe_, const unsigned* ctl, int G, int c) {
        moe_tiles(ctl, t); o.init(t.toff[8], D / BM, G, c); H = (const char*)Hc; wmoe = (const char*)wmoe_; tstep = (size_t)BM * DFF; }
    __device__ __forceinline__ bool next(int i, Unit& u) const {
        if (!o.lin(i, u.pm, u.pn)) return false;
        u.pm = t.toff[8] - 1 - u.pm;
        int e = 0;
#pragma unroll
        for (int k = 1; k < 8; ++k) if (u.pm >= t.toff[k]) e = k;
        u.e = e; u.rb = 0; u.cnt = 0;
        u.a = H + (size_t)u.pm * tstep; u.b = wmoe + (size_t)e * EXP_STRIDE + EXP_W2_OFF + (size_t)u.pn * tstep; return true;
    }
    __device__ __forceinline__ unsigned arow(const Unit&, int r) const { return (unsigned)r; }
    __device__ __forceinline__ void a_ready(const Unit&) const {}
    __device__ __forceinline__ void done(const Unit&) const {}
};
}

__device__ __forceinline__ void final_phase(int wave, int lane, int G, float* x, const bf16_t* x16, const bf16_t* Y, const float* gt2  , const float* g_final, const unsigned* ctl, const unsigned char* route) {
    MoeTiles t; moe_tiles(ctl, t);
    const int gw = blockIdx.x * NWAVES + wave, NGW = G * NWAVES;
    const int rpw = (ML + NGW - 1) / NGW;
    const int rbeg = gw * rpw, rend = (rbeg + rpw < ML) ? rbeg + rpw : ML;
    f32x4 gf[4];
#pragma unroll
    for (int j = 0; j < 4; ++j) gf[j] = *(const f32x4*)(g_final + 4 * lane + 256 * j);
#pragma unroll 1
    for (int row = rbeg; row < rend; ++row) {
        const i32x2 ee = ((const i32x2*)(route + RT_E))[row]; const f32x2 pp = ((const f32x2*)(route + RT_P))[row]; const i32x2 ps = ((const i32x2*)(route + RT_POS))[row];
        int t0 = 0, t1 = 0;
#pragma unroll
        for (int k = 1; k < 8; ++k) { if (ee[0] >= k) t0 = t.toff[k]; if (ee[1] >= k) t1 = t.toff[k]; }
        const bf16_t* y0 = Y + ((size_t)t0 * 256 + ps[0]) * D; const bf16_t* y1 = Y + ((size_t)t1 * 256 + ps[1]) * D;
        const float* gt = gt2 + (size_t)(row / SEQ) * 6144;
        f32x4 v[4]; float ss = 0.f;
#pragma unroll
        for (int j = 0; j < 4; ++j) {
            const int c = 4 * lane + 256 * j;
            const u32x2 xr_ = *(const u32x2*)(x16 + (size_t)row * D + c); f32x4 xv; xv[0] = __builtin_bit_cast(float, xr_.x << 16); xv[1] = __builtin_bit_cast(float, xr_.x & 0xffff0000u); xv[2] = __builtin_bit_cast(float, xr_.y << 16); xv[3] = __builtin_bit_cast(float, xr_.y & 0xffff0000u);
            const f32x4 gv = *(const f32x4*)(gt + c);
            const u32x2 a = *(const u32x2*)(y0 + c), b2 = *(const u32x2*)(y1 + c);
            f32x4 ya, yb;
            ya[0] = __builtin_bit_cast(float, a.x << 16); ya[1] = __builtin_bit_cast(float, a.x & 0xffff0000u); ya[2] = __builtin_bit_cast(float, a.y << 16); ya[3] = __builtin_bit_cast(float, a.y & 0xffff0000u);
            yb[0] = __builtin_bit_cast(float, b2.x << 16); yb[1] = __builtin_bit_cast(float, b2.x & 0xffff0000u); yb[2] = __builtin_bit_cast(float, b2.y << 16); yb[3] = __builtin_bit_cast(float, b2.y & 0xffff0000u);
            v[j] = xv + gv * (ya * pp[0] + yb * pp[1]);
            ss += (v[j][0] * v[j][0] + v[j][1] * v[j][1]) + (v[j][2] * v[j][2] + v[j][3] * v[j][3]);
        }
        ss = wave_sum(ss);
        const float rstd = rsqrtf(ss * (1.0f / D) + EPS);
#pragma unroll
        for (int j = 0; j < 4; ++j) *(f32x4*)(x + (size_t)row * D + 4 * lane + 256 * j) = (v[j] * rstd) * gf[j];
    }
}

__device__ __forceinline__ void mod_task(LAS unsigned char* lds, int tid, int wave, int lane, int task, const float* c, const float* c_ctx, const float* w_mod, const float* b_mod, float* modv) {
    LAS float* sl = (LAS float*)lds;
    LAS float* red = (LAS float*)(lds + 20480);
    for (int i = tid; i < 5 * D; i += NTHREADS) { const float v = i < 4 * D ? c[i] : c_ctx[i - 4 * D]; sl[i] = v / (1.0f + __expf(-v)); }
    __syncthreads();
    const int l = task / 96, n = (task % 96) * 64 + lane;
    const float* w = w_mod + (size_t)l * D * 6144 + n;
    float acc[5] = {0.f, 0.f, 0.f, 0.f, 0.f};
#pragma unroll 16
    for (int kk = 0; kk < 128; ++kk) { const int k = wave * 128 + kk; const float wv = w[(size_t)k * 6144];
#pragma unroll
        for (int r = 0; r < 5; ++r) acc[r] += sl[r * D + k] * wv; }
#pragma unroll
    for (int r = 0; r < 5; ++r) red[(wave * 5 + r) * 64 + lane] = acc[r];
    __syncthreads();
    if (tid < 320) { const int r = tid >> 6, ln = tid & 63; float s = 0.f;
#pragma unroll
        for (int w8 = 0; w8 < 8; ++w8) s += red[(w8 * 5 + r) * 64 + ln];
        const int nn = (task % 96) * 64 + ln; modv[((size_t)l * 5 + r) * 6144 + nn] = s + b_mod[l * 6144 + nn]; }
    __syncthreads();
}

constexpr unsigned DUPMASK = 0u;
constexpr int CW_BAR = 4096;
#define XB_TMO      128
#define XB_XCNT(j)  (256  + 64 * (j))
#define XB_XSUB(j)  (1280 + 64 * (j))
#define XB_XGEN(j)  (2304 + 64 * (j))
#define XB_TOP      3328
#define XB_TOPGEN   3392
#define XCD_BAR_WORDS 3456
#define XB_SPIN_CAP (1u << 18)

__device__ __forceinline__ unsigned xb_ld(unsigned* p)              { return __hip_atomic_load(p, __ATOMIC_RELAXED, __HIP_MEMORY_SCOPE_AGENT); }
__device__ __forceinline__ unsigned xb_add(unsigned* p, unsigned v) { return __hip_atomic_fetch_add(p, v, __ATOMIC_RELAXED, __HIP_MEMORY_SCOPE_AGENT); }
__device__ __forceinline__ unsigned xb_xcc_id() { return (unsigned)__builtin_amdgcn_s_getreg((3 << 11) | 20) & 0xFu; }
#define XB_SPIN(cond, bar) do { unsigned _sp = 0; while (cond) { __builtin_amdgcn_s_sleep(1); \
    if ((++_sp & 255u) == 0u) { if (xb_ld(&(bar)[XB_TMO])) break; if (_sp > XB_SPIN_CAP) { atomicAdd(&(bar)[XB_TMO], 1u); break; } } } } while (0)

struct XcdBarrier {
    unsigned* bar; unsigned x;
    volatile LAS unsigned* st;
};

__device__ __forceinline__ XcdBarrier xcd_barrier_post(unsigned* bar, volatile LAS unsigned* st) {
    XcdBarrier b; b.bar = bar; b.x = xb_xcc_id(); b.st = st;
    if (threadIdx.x == 0) (void)xb_add(&bar[XB_XCNT(b.x)], 1u);
    return b;
}
__device__ __forceinline__ void xcd_barrier_complete(unsigned* bar, unsigned x, unsigned& nloc, unsigned& nx) {
    const unsigned G = gridDim.x * gridDim.y * gridDim.z;
    unsigned sum, cnt, mine, sp = 0u;
    for (;;) {
        sum = 0u; cnt = 0u; mine = 0u;
#pragma unroll
        for (unsigned j = 0; j < 16; ++j) { const unsigned c = xb_ld(&bar[XB_XCNT(j)]); sum += c; cnt += (c > 0u) ? 1u : 0u; mine = (j == x) ? c : mine; }
        if (sum == G) break;
        __builtin_amdgcn_s_sleep(1);
        if ((++sp & 255u) == 0u) { if (xb_ld(&bar[XB_TMO])) break; if (sp > XB_SPIN_CAP) { atomicAdd(&bar[XB_TMO], 1u); break; } }
    }
    nloc = mine > 0u ? mine : 1u; nx = cnt > 0u ? cnt : 1u;
}

__device__ __forceinline__ void xcd_barrier(const XcdBarrier& b) {
    asm volatile("s_waitcnt vmcnt(0)" ::: "memory");
    __syncthreads();
    if (threadIdx.x == 0) {
        unsigned* bar = b.bar;
        __builtin_amdgcn_s_waitcnt(0);
        unsigned nloc = b.st[0], nx = b.st[1];
        if (nloc == 0u) { xcd_barrier_complete(bar, b.x, nloc, nx); b.st[0] = nloc; b.st[1] = nx; }
        const unsigned old = xb_add(&bar[XB_XSUB(b.x)], 1u);
        const unsigned gen = old / nloc;
        if (old + 1u == (gen + 1u) * nloc) {
            __builtin_amdgcn_fence(__ATOMIC_RELEASE, "agent");
            asm volatile("s_waitcnt vmcnt(0)" ::: "memory");
            const unsigned og = xb_add(&bar[XB_TOP], 1u);
            const unsigned tg = og / nx;
            if (og + 1u == (tg + 1u) * nx) xb_add(&bar[XB_TOPGEN], 1u);
            else XB_SPIN(xb_ld(&bar[XB_TOPGEN]) == tg, bar);
            __builtin_amdgcn_fence(__ATOMIC_ACQUIRE, "agent");
            xb_add(&bar[XB_XGEN(b.x)], 1u);
            asm volatile("s_waitcnt vmcnt(0)" ::: "memory");
        } else {
            XB_SPIN(xb_ld(&bar[XB_XGEN(b.x)]) == gen, bar);
            __builtin_amdgcn_fence(__ATOMIC_ACQUIRE, "agent");
            asm volatile("s_waitcnt vmcnt(0)" ::: "memory");
        }
    }
    __syncthreads();
}


__device__ __forceinline__ void transpose_item8(const float* W, int K, int N, unsigned char* WT, int mode, LAS float* scr, int item, int lane) {
    const int nblk = N / 32, kb = item / nblk, nb = item % nblk, k0 = 64 * kb, n0 = 32 * nb;
    const int drow0 = (mode == 0) ? n0 : (mode == 3 ? win_row(n0) : (256 * (n0 >> 7) + (n0 & 127) + (mode == 2 ? 128 : 0)));
    {
        f32x4 v[8];
#pragma unroll
        for (int i = 0; i < 8; ++i) v[i] = __builtin_nontemporal_load((const f32x4*)(W + (size_t)(k0 + 8 * i + (lane >> 3)) * N + n0 + 4 * (lane & 7)));
#pragma unroll
        for (int i = 0; i < 8; ++i) { LAS float* d = scr + (8 * i + (lane >> 3)) * 33 + 4 * (lane & 7);
#pragma unroll
            for (int j = 0; j < 4; ++j) d[j] = v[i][j] * FP8_SW; }
    }
    asm volatile("s_waitcnt lgkmcnt(0)" ::: "memory");
    const int c = lane & 7;
#pragma unroll
    for (int j = 0; j < 4; ++j) { const int n = (lane >> 3) + 8 * j; const LAS float* q = scr + (8 * c) * 33 + n;
        u32x2 o; o.x = pg8::pack4_fp8(q[0 * 33], q[1 * 33], q[2 * 33], q[3 * 33]); o.y = pg8::pack4_fp8(q[4 * 33], q[5 * 33], q[6 * 33], q[7 * 33]);
        *(u32x2*)(WT + (size_t)(drow0 + n) * K + k0 + 8 * c) = o; }
    asm volatile("s_waitcnt lgkmcnt(0)" ::: "memory");
}

__device__ __forceinline__ void quant_rows_i8(const bf16_t* W, unsigned char* Q, float* scale, int nrows, int gw, int NGW, int lane) {
#pragma unroll 1
    for (int r = gw; r < nrows; r += NGW) {
        const u32x4 a = *(const u32x4*)(W + (size_t)r * D + 16 * lane), b = *(const u32x4*)(W + (size_t)r * D + 16 * lane + 8);
        float v[16]; { float t[8]; unpack8(a, t);
#pragma unroll
            for (int j = 0; j < 8; ++j) v[j] = t[j];
            unpack8(b, t);
#pragma unroll
            for (int j = 0; j < 8; ++j) v[8 + j] = t[j]; }
        float am = 0.f;
#pragma unroll
        for (int j = 0; j < 16; ++j) am = fmaxf(am, fabsf(v[j]));
#pragma unroll
        for (int o = 1; o < 64; o <<= 1) am = fmaxf(am, __shfl_xor(am, o));
        am = fmaxf(am, 1e-30f);
        const float qs = 127.0f / am;
        unsigned w[4];
#pragma unroll
        for (int g4 = 0; g4 < 4; ++g4) { const int q0 = (int)__builtin_rintf(v[4 * g4] * qs), q1 = (int)__builtin_rintf(v[4 * g4 + 1] * qs), q2 = (int)__builtin_rintf(v[4 * g4 + 2] * qs), q3 = (int)__builtin_rintf(v[4 * g4 + 3] * qs);
            w[g4] = (unsigned)(q0 & 0xff) | ((unsigned)(q1 & 0xff) << 8) | ((unsigned)(q2 & 0xff) << 16) | ((unsigned)(q3 & 0xff) << 24); }
        *(u32x4*)(Q + (size_t)r * D + 16 * lane) = (u32x4){w[0], w[1], w[2], w[3]};
        if (lane == 0) scale[r] = am * (1.0f / 127.0f);
    }
}

constexpr int CW_TEAM = 3200;
__device__ __forceinline__ void team_barrier(unsigned* ctr, unsigned n, int tid) {
    asm volatile("s_waitcnt vmcnt(0)" ::: "memory");
    __syncthreads();
    if (tid == 0) {
        __builtin_amdgcn_fence(__ATOMIC_RELEASE, "agent");
        asm volatile("s_waitcnt vmcnt(0)" ::: "memory");
        (void)__hip_atomic_fetch_add(ctr, 1u, __ATOMIC_RELAXED, __HIP_MEMORY_SCOPE_AGENT);
        unsigned sp = 0;
        while (__hip_atomic_load(ctr, __ATOMIC_RELAXED, __HIP_MEMORY_SCOPE_AGENT) < n) { __builtin_amdgcn_s_sleep(2); if (++sp > (1u << 20)) break; }
        __builtin_amdgcn_fence(__ATOMIC_ACQUIRE, "agent");
        asm volatile("s_waitcnt vmcnt(0)" ::: "memory");
    }
    __syncthreads();
}

struct Args { const float* in[32]; float* out; unsigned char* ws; int ph_lo, ph_hi; };

enum Phase { PH_PRO = 0, PH_NORM1_L0, PH_WIN_L0, PH_MIX_L0, PH_CARRY_L0, PH_CFIN_L0, PH_WOUT_L0, PH_NORM2_L0, PH_FFNUP, PH_FFNDOWN,
             PH_NORM1_L1, PH_WIN_L1, PH_MIX_L1, PH_CARRY_L1, PH_CFIN_L1, PH_WOUT_L1, PH_NORM2_L1, PH_MOE_UP, PH_MOE_DOWN, PH_FINAL, PH_COUNT };

constexpr int I_IN = (D / 64) * (WIN / 32), I_OUT = (D / 64) * (D / 32), I_13 = (D / 64) * (DFF / 32), I_2 = (DFF / 64) * (D / 32), I_E = 2 * I_13 + I_2;
constexpr int CONV_Q0 = I_IN;
constexpr int CONV_DENSE_END = 2 * I_IN + 2 * I_OUT + 2 * I_13 + I_2;
constexpr int CONV_TOTAL = CONV_DENSE_END + NE * I_E;
constexpr int CW_CQ = 3072;
__device__ __forceinline__ void conv_item(const float* const* in, unsigned char* ws, int r, LAS float* scr, int lane) {
    if (r < 2 * I_IN) { const int l = r / I_IN; if (WIN8) transpose_item8(in[8] + (size_t)l * D * WIN, D, WIN, ws + WS_WIN + (size_t)l * WIN * D, 0, scr, r % I_IN, lane); else transpose_item(in[8] + (size_t)l * D * WIN, D, WIN, (bf16_t*)(ws + WS_WIN) + (size_t)l * WIN * D, 3, scr, r % I_IN, lane); return; } r -= 2 * I_IN;
    if (r < 2 * I_OUT) { const int l = r / I_OUT; transpose_item(in[22] + (size_t)l * D * D, D, D, (bf16_t*)(ws + WS_WOUT) + (size_t)l * D * D, 0, scr, r % I_OUT, lane); return; } r -= 2 * I_OUT;
    if (r < I_13) { if (DENSE_UP8) transpose_item8(in[23], D, DFF, ws + WS_W13, 1, scr, r, lane); else transpose_item(in[23], D, DFF, (bf16_t*)(ws + WS_W13), 1, scr, r, lane); return; } r -= I_13;
    if (r < I_13) { if (DENSE_UP8) transpose_item8(in[24], D, DFF, ws + WS_W13, 2, scr, r, lane); else transpose_item(in[24], D, DFF, (bf16_t*)(ws + WS_W13), 2, scr, r, lane); return; } r -= I_13;
    if (r < I_2) { if (DENSE_DOWN8) transpose_item8(in[25], DFF, D, ws + WS_W2, 0, scr, r, lane); else transpose_item(in[25], DFF, D, (bf16_t*)(ws + WS_W2), 0, scr, r, lane); return; } r -= I_2;
    { const int e = r / I_E; int q = r % I_E; unsigned char* eb = ws + WS_WMOE + (size_t)e * EXP_STRIDE;
      if (q < I_13) { transpose_item8(in[28] + (size_t)e * D * DFF, D, DFF, eb, 1, scr, q, lane); return; } q -= I_13;
      if (q < I_13) { transpose_item8(in[29] + (size_t)e * D * DFF, D, DFF, eb, 2, scr, q, lane); return; } q -= I_13;
      transpose_item8(in[30] + (size_t)e * DFF * D, DFF, D, eb + EXP_W2_OFF, 0, scr, q, lane); }
}
__device__ __forceinline__ void conv_static(const float* const* in, unsigned char* ws, int lo, int hi, int first_block, int G, LAS unsigned char* lds, int wave, int lane) {
    if ((int)blockIdx.x < first_block) return;
    LAS float* scr = (LAS float*)(lds + wave * 16384);
    const int rank = ((int)blockIdx.x - first_block) * NWAVES + wave, stride = (G - first_block) * NWAVES;
#pragma unroll 1
    for (int it = lo + rank; it < hi; it += stride) conv_item(in, ws, it, scr, lane);
}

constexpr int CQ_CH = 2 * NWAVES, CQ_NCHUNK = (NE * I_E) / CQ_CH, CW_CQ2 = 7552, CW_DONE = 8064;
static_assert((NE * I_E) % CQ_CH == 0 && CQ_NCHUNK % 8 == 0, "conversion chunks");
__device__ __forceinline__ void conv_pull(const float* const* in, unsigned char* ws, unsigned* ctl, LAS unsigned char* lds, int tid, int wave, int lane, unsigned* done_ctr, unsigned done_target) {
    LAS float* scr = (LAS float*)(lds + wave * 16384);
    volatile LAS int* slot = (volatile LAS int*)(lds + LDS_BYTES - 64);
    const int x = (int)blockIdx.x & 7;
#pragma unroll 1
    for (;;) {
        __syncthreads();
        if (tid == 0) {
            int c = -1;
            const bool stop = done_ctr != nullptr && __hip_atomic_load(done_ctr, __ATOMIC_RELAXED, __HIP_MEMORY_SCOPE_AGENT) >= done_target;
            if (!stop) { const unsigned j = __hip_atomic_fetch_add(ctl + CW_CQ2 + x * 64, 1u, __ATOMIC_RELAXED, __HIP_MEMORY_SCOPE_AGENT); if (j < (unsigned)(CQ_NCHUNK / 8)) c = (int)(j * 8u) + x; }
            *slot = c;
        }
        __syncthreads();
        const int c = *slot;
        if (c < 0) break;
#pragma unroll 1
        for (int k = 0; k < CQ_CH / NWAVES; ++k) conv_item(in, ws, CONV_DENSE_END + c * CQ_CH + k * NWAVES + wave, scr, lane);
    }
}

__global__ void __launch_bounds__(NTHREADS, 2) fwd(Args args) {
    extern __shared__ __attribute__((aligned(16))) unsigned char lds_raw[];
    LAS unsigned char* lds = (LAS unsigned char*)lds_raw;
    const int tid = threadIdx.x, lane = tid & 63, wave = __builtin_amdgcn_readfirstlane(tid >> 6);
    const int G = gridDim.x;
    unsigned char* ws = args.ws;
    const int lo = args.ph_lo, hi = args.ph_hi;
#ifdef ONLY_PHASE
#define IN(k) ((k) == ONLY_PHASE && lo <= (k) && (k) < hi)
#else
#define IN(k) (lo <= (k) && (k) < hi)
#endif
    float* xl = args.out; float* xctx = (float*)(ws + WS_XCTX);
    float* modv = (float*)(ws + WS_MODV);
    unsigned* ctl = (unsigned*)(ws + WS_CTL);
    unsigned char* route = ws + WS_ROUTE;
    bf16_t* hbuf = (bf16_t*)(ws + WS_HBUF);
    bf16_t* proj = (bf16_t*)(ws + WS_BIG);
    unsigned char* H8 = ws + WS_BIG;
    bf16_t* Yb = (bf16_t*)(ws + WS_Y);
    unsigned char* H8m = ws + WS_H8MOE;
    bf16_t* x16 = (bf16_t*)(ws + WS_X16);
    volatile LAS unsigned* xb_st = (volatile LAS unsigned*)(lds + LDS_BYTES - 16);
    if (tid == 0) { xb_st[0] = 0u; xb_st[1] = 0u; xb_st[2] = 0u; xb_st[3] = 0u; }
    __syncthreads();
    XcdBarrier bar = xcd_barrier_post(ctl + CW_BAR, xb_st);
#define SEAM(k) if (IN(k) && IN((k) + 1)) xcd_barrier(bar);
#define REP(k) for (int rep_ = 0, nrep_ = ((DUPMASK >> (k)) & 1u) ? 2 : 1; rep_ < nrep_; ++rep_, (rep_ < nrep_ ? xcd_barrier(bar) : (void)0))

    if (IN(PH_PRO)) REP(PH_PRO) {
        if (blockIdx.x < 192) mod_task(lds, tid, wave, lane, (int)blockIdx.x, args.in[1], args.in[3], args.in[4], args.in[5], modv);
        LAS float* scr = (LAS float*)(lds + wave * 16384);
        const int gw = blockIdx.x * NWAVES + wave, NGW = G * NWAVES;
#pragma unroll 1
        for (int it = gw; it < CONV_DENSE_END; it += NGW) conv_item(args.in, ws, it, scr, lane);
        bf16_t* gwt = (bf16_t*)(ws + WS_LRUW);
        for (int i = blockIdx.x * NTHREADS + tid; i < 2 * 2 * 2 * 8 * 4096; i += G * NTHREADS) {
            const int k = i & 63, n = (i >> 6) & 63, h = (i >> 12) & 7, mat = (i >> 15) & 1, dir = (i >> 16) & 1, l = i >> 17;
            const float* src = (mat == 0 ? args.in[16] : args.in[18]) + ((size_t)((l * 2 + dir) * 8 + h) * 64 + k) * 64 + n;
            gwt[i] = f2bf(-LOG2E * *src);
        }
        float* gconst = (float*)(ws + WS_GCONST);
        for (int i = blockIdx.x * NTHREADS + tid; i < 2 * 2 * 3 * LRU; i += G * NTHREADS) {
            const int c = i & 511, which = (i >> 9) % 3, ld = (i >> 9) / 3;
            float v;
            if (which == 0) v = -LOG2E * args.in[17][ld * LRU + c];
            else if (which == 1) v = -LOG2E * args.in[19][ld * LRU + c];
            else { const float L = args.in[20][ld * LRU + c]; v = 8.0f * LOG2E * (fminf(L, 0.f) - log1pf(__expf(-fabsf(L)))); }
            gconst[i] = v;
        }
    }
#define GEMM_WIN(l) { constexpr int KB = WIN8 ? D : 2 * D; pg8::DenseSched S; S.init(hbuf, ws + WS_WIN + (size_t)(l) * WIN * KB, MA, WIN, KB, G, (int)blockIdx.x); \
        pg8::EpiProjFused E{proj}; pg8::gemm_phase<WIN8>(lds, KB, S, E); }
#define TAILFILL(k) { if (tid == 0) (void)__hip_atomic_fetch_add(ctl + CW_DONE + (k) * 16, 1u, __ATOMIC_RELAXED, __HIP_MEMORY_SCOPE_AGENT); \
        conv_pull(args.in, ws, ctl, lds, tid, wave, lane, ctl + CW_DONE + (k) * 16, (unsigned)G); }
#define GEMM_WIN_I8(l) { pg8::DenseSched S; S.init(hbuf, ws + WS_WINQ + (size_t)(l) * WIN * D, MA, WIN, D, G, (int)blockIdx.x); \
        pg8::EpiProjFusedI8 E{proj, (const float*)(ws + WS_RS1), (const float*)(ws + WS_WINQS) + (l) * WIN}; pg8::gemm_phase<2>(lds + 4096, D, S, E); }
#define MIXARGS(l) MixArgs m; m.proj = proj; m.ybuf = hbuf; m.conf_w = args.in[9] + (l) * CONFK * 256; m.conf_b = args.in[10] + (l) * 256; m.ln_g = args.in[11] + (l) * 256; m.ln_b = args.in[12] + (l) * 256; \
        m.sconv_w = args.in[13] + (l) * 3 * 256; m.g_mix = args.in[21] + (l) * D; m.cw = args.in[14] + (l) * 4 * LRU; m.cb = args.in[15] + (l) * LRU; \
        m.gwt = (const bf16_t*)(ws + WS_LRUW) + (size_t)(l) * 2 * 2 * 8 * 4096; m.gconst = (const float*)(ws + WS_GCONST) + (l) * 2 * 3 * LRU; \
        m.SA = (float*)(ws + WS_SUMM); m.SB = (float*)(ws + WS_SUMM) + 2 * NB * NPOS * LRU; m.CR = (float*)(ws + WS_CR); m.AB = (unsigned*)(ws + WS_BIG + 116 * MiB);
    SEAM(PH_PRO)
    if (IN(PH_NORM1_L0)) REP(PH_NORM1_L0) { norm_phase<false, WINI8_L0 ? 2 : (WIN8 ? 1 : 0)>(lds, tid, wave, lane, G, args.in[0], args.in[2], args.in[6], modv, M_SH1, M_SC1, hbuf, MA, nullptr, nullptr, ctl, route, (float*)(ws + WS_RS1), true);
        if (DENSE_UPI8) quant_rows_i8((const bf16_t*)(ws + WS_W13), ws + WS_W13Q, (float*)(ws + WS_W13QS), 2 * DFF, (int)blockIdx.x * NWAVES + wave, G * NWAVES, lane);
        if (WINI8_L0) quant_rows_i8((const bf16_t*)(ws + WS_WIN), ws + WS_WINQ, (float*)(ws + WS_WINQS), WIN, (int)blockIdx.x * NWAVES + wave, G * NWAVES, lane);
        if (WINI8_L1) quant_rows_i8((const bf16_t*)(ws + WS_WIN) + (size_t)WIN * D, ws + WS_WINQ + (size_t)WIN * D, (float*)(ws + WS_WINQS) + WIN, WIN, (int)blockIdx.x * NWAVES + wave, G * NWAVES, lane); }
    SEAM(PH_NORM1_L0)
    if (IN(PH_WIN_L0)) REP(PH_WIN_L0) { if constexpr (WINI8_L0) GEMM_WIN_I8(0) else GEMM_WIN(0) TAILFILL(0) }
    SEAM(PH_WIN_L0)
    if (IN(PH_MIX_L0)) REP(PH_MIX_L0) { MIXARGS(0) mix_phase(lds, tid, wave, lane, G, m, MA / 32, ctl + CW_WQ); }
    SEAM(PH_MIX_L0)
    if (IN(PH_CARRY_L0)) REP(PH_CARRY_L0) { MIXARGS(0) carry_phase(lds, tid, wave, lane, G, m, 1, MA / 64); }
    SEAM(PH_CARRY_L0)
    if (IN(PH_CFIN_L0)) REP(PH_CFIN_L0) { MIXARGS(0) cfin_phase(lds, tid, wave, lane, G, m); }
    SEAM(PH_CFIN_L0)
    if (IN(PH_WOUT_L0)) REP(PH_WOUT_L0) { pg8::DenseSched S; S.init(hbuf, (const bf16_t*)(ws + WS_WOUT), ML, D, 2 * D, G, (int)blockIdx.x);
        pg8::EpiRes16<true> E{args.in[0], args.in[2], x16, modv + M_GT1, 1.0f, 0}; pg8::gemm_phase<false>(lds, 2 * D, S, E); }
    SEAM(PH_WOUT_L0)
    if (IN(PH_NORM2_L0)) {
        constexpr int OM = DENSE_UPI8 ? 2 : (DENSE_UP8 ? 1 : 0);
        if (blockIdx.x < 16) {
            { pg8::DenseSched S; S.init(hbuf, (const bf16_t*)(ws + WS_WOUT), MC, D, 2 * D, 16, (int)blockIdx.x, ML / 256);
              pg8::EpiRes16<true> E{args.in[0], args.in[2], x16, modv + M_GT1, 1.0f, 0}; pg8::gemm_phase<false>(lds, 2 * D, S, E); }
            team_barrier(ctl + CW_TEAM, 16u, tid);
            norm_phase<false, OM>(lds, tid, wave, lane, G, xl, xctx, args.in[7], modv, M_SH2, M_SC2, hbuf, MC, nullptr, nullptr, ctl, route, (float*)(ws + WS_RS), false, x16, 0, 16, ML);
        } else norm_phase<false, OM>(lds, tid, wave, lane, G, xl, xctx, args.in[7], modv, M_SH2, M_SC2, hbuf, ML, nullptr, nullptr, ctl, route, (float*)(ws + WS_RS), false, x16, 16, G - 16, 0);
        TAILFILL(4)
    }
    SEAM(PH_NORM2_L0)
    if (IN(PH_FFNUP)) REP(PH_FFNUP) {
        if constexpr (DENSE_UPI8) { pg8::DenseSched S; S.init(hbuf, ws + WS_W13Q, MA, 2 * DFF, D, G, (int)blockIdx.x);
            pg8::EpiSwigluI8<DENSE_DOWN8> E{(void*)H8, DFF, (const float*)(ws + WS_RS), (const float*)(ws + WS_W13QS)}; pg8::gemm_phase<2>(lds + 4096, D, S, E); }
        else { constexpr int KB = DENSE_UP8 ? D : 2 * D; pg8::DenseSched S; S.init(hbuf, ws + WS_W13, MA, 2 * DFF, KB, G, (int)blockIdx.x);
        if constexpr (DENSE_DOWN8) { pg8::EpiSwiglu8 E{H8, DFF, DENSE_UP8 ? 1.0f / FP8_SW : 1.0f, FP8_SH}; pg8::gemm_phase<DENSE_UP8>(lds, KB, S, E); }
        else { pg8::EpiSwiglu E{(bf16_t*)H8, DFF, DENSE_UP8 ? 1.0f / FP8_SW : 1.0f}; pg8::gemm_phase<DENSE_UP8>(lds, KB, S, E); } }
        TAILFILL(2) }
    SEAM(PH_FFNUP)
    if (IN(PH_FFNDOWN)) REP(PH_FFNDOWN) { constexpr int KB = DENSE_DOWN8 ? DFF : 2 * DFF; pg8::DenseSched S; S.init(H8, ws + WS_W2, ML, D, KB, G, (int)blockIdx.x);
        pg8::EpiRes16<false> E{nullptr, nullptr, x16, modv + M_GT2, DENSE_DOWN8 ? 1.0f / (FP8_SW * FP8_SH) : 1.0f, 0}; pg8::gemm_phase<DENSE_DOWN8>(lds, KB, S, E); }
    SEAM(PH_FFNDOWN)
    if (IN(PH_NORM1_L1)) {
        if (blockIdx.x < 16) {
            { constexpr int KB = DENSE_DOWN8 ? DFF : 2 * DFF; pg8::DenseSched S; S.init(H8, ws + WS_W2, MC, D, KB, 16, (int)blockIdx.x, ML / 256);
              pg8::EpiRes16<false> E{nullptr, nullptr, x16, modv + M_GT2, DENSE_DOWN8 ? 1.0f / (FP8_SW * FP8_SH) : 1.0f, 0}; pg8::gemm_phase<DENSE_DOWN8>(lds, KB, S, E); }
            team_barrier(ctl + CW_TEAM + 64, 16u, tid);
            norm_phase<false, WINI8_L1 ? 2 : (WIN8 ? 1 : 0)>(lds, tid, wave, lane, G, xl, xctx, args.in[6] + D, modv + 5 * 6144, M_SH1, M_SC1, hbuf, MC, nullptr, nullptr, ctl, route, (float*)(ws + WS_RS1), false, x16, 0, 16, ML);
        } else {
            norm_phase<false, WINI8_L1 ? 2 : (WIN8 ? 1 : 0)>(lds, tid, wave, lane, G, xl, xctx, args.in[6] + D, modv + 5 * 6144, M_SH1, M_SC1, hbuf, ML, nullptr, nullptr, ctl, route, (float*)(ws + WS_RS1), false, x16, 16, G - 16, 0);
        }
        TAILFILL(3)
    }
    SEAM(PH_NORM1_L1)
    if (IN(PH_WIN_L1)) REP(PH_WIN_L1) { if constexpr (WINI8_L1) GEMM_WIN_I8(1) else GEMM_WIN(1) TAILFILL(1) }
    SEAM(PH_WIN_L1)
    if (IN(PH_MIX_L1)) REP(PH_MIX_L1) { MIXARGS(1) mix_phase(lds, tid, wave, lane, G, m, ML / 32, ctl + CW_WQ + 64); }
    SEAM(PH_MIX_L1)
    if (IN(PH_CARRY_L1)) REP(PH_CARRY_L1) { MIXARGS(1) carry_phase(lds, tid, wave, lane, G, m, 0, ML / 64); }
    SEAM(PH_CARRY_L1)
    if (IN(PH_CFIN_L1)) REP(PH_CFIN_L1) { MIXARGS(1) cfin_phase(lds, tid, wave, lane, G, m); }
    SEAM(PH_CFIN_L1)
    if (IN(PH_WOUT_L1)) REP(PH_WOUT_L1) { pg8::DenseSched S; S.init(hbuf, (const bf16_t*)(ws + WS_WOUT) + (size_t)D * D, ML, D, 2 * D, G, (int)blockIdx.x);
        pg8::EpiRes16<false> E{nullptr, nullptr, x16, modv + 5 * 6144 + M_GT1, 1.0f, 0}; pg8::gemm_phase<false>(lds, 2 * D, S, E); }
    SEAM(PH_WOUT_L1)
    if (IN(PH_NORM2_L1)) REP(PH_NORM2_L1) { norm_phase<true, 1>(lds, tid, wave, lane, G, xl, xctx, args.in[7] + D, modv + 5 * 6144, M_SH2, M_SC2, hbuf, ML, args.in[26], args.in[27], ctl, route, nullptr, false, x16);
        conv_pull(args.in, ws, ctl, lds, tid, wave, lane, nullptr, 0u); }
    SEAM(PH_NORM2_L1)
    if (IN(PH_MOE_UP)) REP(PH_MOE_UP) { pg8::MoeUpSched S; S.init(hbuf, ws + WS_WMOE, (const int*)(route + RT_IDX), ctl, G, (int)blockIdx.x);
        pg8::EpiSwiglu8 E{H8m, DFF, 1.0f / FP8_SW, FP8_SH}; pg8::gemm_phase<true>(lds + 2048, D, S, E); }
    SEAM(PH_MOE_UP)
    if (IN(PH_MOE_DOWN)) REP(PH_MOE_DOWN) { pg8::MoeDownSched S; S.init(H8m, ws + WS_WMOE, ctl, G, (int)blockIdx.x);
        pg8::EpiBf16Store E{Yb, D, 1.0f / (FP8_SW * FP8_SH)}; pg8::gemm_phase<true>(lds, DFF, S, E); }
    SEAM(PH_MOE_DOWN)
    if (IN(PH_FINAL)) REP(PH_FINAL) final_phase(wave, lane, G, xl, x16, Yb, modv + 5 * 6144 + M_GT2, args.in[31], ctl, route);
#undef IN
}

static_assert(CW_CQ2 >= CW_BAR + XCD_BAR_WORDS && CW_CQ2 + 8 * 64 <= CW_DONE && (CW_DONE + 8 * 16) * 4 <= 32 * 1024 && (CW_BAR + XCD_BAR_WORDS) * 4 <= 32 * 1024 && (CW_TEAM + 3 * 64) < CW_BAR && CW_CQ < CW_TEAM && (CW_WQ + 128) <= CW_CQ && (CW_CNT + 8 * 64) <= CW_WQ, "control words inside the per-call memset");
extern "C" void kernel_launch(void* const* d_in, const int* in_sizes, int n_in, void* d_out, int out_size, void* d_ws, size_t ws_size, hipStream_t stream) {
    static int grid = 0;
    if (grid == 0) {
        int dev = 0, cus = 0; (void)hipGetDevice(&dev); (void)hipDeviceGetAttribute(&cus, hipDeviceAttributeMultiprocessorCount, dev);
        (void)hipFuncSetAttribute((const void*)fwd, hipFuncAttributeMaxDynamicSharedMemorySize, LDS_BYTES);
        int per_cu = 0;
        (void)hipOccupancyMaxActiveBlocksPerMultiprocessor(&per_cu, (const void*)fwd, NTHREADS, LDS_BYTES);
        grid = cus > 0 ? cus : 256;
        if (per_cu < 1) fprintf(stderr, "kernel_launch: occupancy query reports %d blocks per CU\n", per_cu);
    }
    Args a{};
    for (int i = 0; i < 32; ++i) a.in[i] = (const float*)d_in[i];
    a.out = (float*)d_out; a.ws = (unsigned char*)d_ws;
    (void)hipMemsetAsync((char*)d_ws + WS_CTL, 0, 32 * 1024, stream);
#ifdef MULTI_LAUNCH
    for (int ph = 0; ph < PH_COUNT; ++ph) { a.ph_lo = ph; a.ph_hi = ph + 1; hipLaunchKernelGGL(fwd, dim3(grid), dim3(NTHREADS), LDS_BYTES, stream, a); }
#else
    a.ph_lo = 0; a.ph_hi = PH_COUNT; hipLaunchKernelGGL(fwd, dim3(grid), dim3(NTHREADS), LDS_BYTES, stream, a);
#endif
}
```

```cpp
#include <hip/hip_runtime.h>
#include <stdint.h>
#include <cstdio>

constexpr int D = 1024, NB = 4, SEQ = 8192, CTXL = 256, GW = 64;
constexpr int ML = NB * SEQ;
constexpr int MC = NB * CTXL;
constexpr int MA = ML + MC;
constexpr int WIN = 2304, DFF = 2816, NE = 8, LRU = 512;
constexpr int CONFK = 31;
constexpr float EPS = 1e-6f;
constexpr int C_AVAL = 0, C_AGATE = 256, C_SBG = 512, C_SCG = 768, C_SX = 1024, C_CX = 1280, C_CG = 1792;
constexpr int PW = 1792, P_GLU = 0, P_V = 256, P_SBG = 512, P_CX = 768, P_CG = 1280;
constexpr int M_SH1 = 0, M_SC1 = 1024, M_GT1 = 2048, M_SH2 = 3072, M_SC2 = 4096, M_GT2 = 5120;

typedef unsigned short bf16_t;
typedef short bf16x8 __attribute__((ext_vector_type(8)));
typedef float f32x4 __attribute__((ext_vector_type(4)));
typedef float f32x2 __attribute__((ext_vector_type(2)));

__device__ __forceinline__ bf16_t f2bf(float f) { unsigned u = __builtin_bit_cast(unsigned, f); return (bf16_t)((u + 0x7fffu + ((u >> 16) & 1u)) >> 16); }
__device__ __forceinline__ float bf2f(bf16_t b) { return __builtin_bit_cast(float, ((unsigned)b) << 16); }
__device__ __forceinline__ float sigmoidf_(float x) { return 1.0f / (1.0f + __expf(-x)); }
__device__ __forceinline__ float siluf_(float x) { return x * sigmoidf_(x); }
__device__ __forceinline__ float gelu_tanh(float x) { const float u = 0.7978845608028654f * (x + 0.044715f * x * x * x); return 0.5f * x * (1.0f + tanhf(u)); }
__device__ __forceinline__ float wave_sum(float v) {
#pragma unroll
    for (int o = 1; o < 64; o <<= 1) v += __shfl_xor(v, o);
    return v;
}

__device__ __forceinline__ int row_modidx(int r) { return r < ML ? r / SEQ : 4; }


#define LAS __attribute__((address_space(3)))
typedef unsigned u32x4 __attribute__((ext_vector_type(4)));
typedef unsigned u32x2 __attribute__((ext_vector_type(2)));
typedef int v4i_t __attribute__((ext_vector_type(4)));
typedef int v8i_t __attribute__((ext_vector_type(8)));
constexpr int NWAVES = 8, NTHREADS = 512;
constexpr int LDS_BYTES = 160 * 1024;

__device__ __forceinline__ unsigned cvt_pk_bf16(float lo, float hi) { unsigned r; asm volatile("v_cvt_pk_bf16_f32 %0, %1, %2" : "=v"(r) : "v"(lo), "v"(hi)); return r; }
__device__ __forceinline__ float fast_silu(float x) { return x * __builtin_amdgcn_rcpf(1.0f + __expf(-x)); }

constexpr float FP8_SW = 64.0f, FP8_SH = 8.0f;
namespace pg8 {
constexpr int BM = 256, BK = 64, HALF = 128, HTB = HALF * BK * 2, STAGE_BYTES = 8 * HTB, NXCD = 8, WGM = 4;
__device__ __forceinline__ int lds_byte(int r, int c) { const int st = (r >> 4) * 2 + (c >> 5), rr = r & 15, cc = c & 31, ob = rr * 64 + cc * 2; return st * 1024 + (ob ^ (((ob >> 9) & 1) << 5)); }
__device__ __forceinline__ void stage_rc(int b, int& R, int& C) { const int st = b / 1024, sb = b % 1024, swz = sb ^ (((sb >> 9) & 1) << 5); R = (st >> 1) * 16 + swz / 64; C = (st & 1) * 32 + (swz % 64) / 2; }
__device__ __forceinline__ int perm32(int rho) { const int n = rho >> 4, i = rho & 15; return 8 * (i >> 2) + 4 * n + (i & 3); }

constexpr int SC_OFF = -4096;
constexpr int IDX_OFF = -2048;
struct Unit { int pm, pn; const char* a; const char* b; int e, rb, cnt; };

struct Order {
    int nM, nN, nwg, G, c;
    __device__ __forceinline__ void init(int nM_, int nN_, int G_, int c_) { nM = nM_; nN = nN_; nwg = nM * nN; G = G_; c = c_; }
    __device__ __forceinline__ bool lin(int i, int& pm, int& pn) const {
        const long L = (long)i * G + c; if (L >= nwg) return false;
        int wgid = (int)L; { const int q = nwg / NXCD, r = nwg % NXCD, xcd = wgid % NXCD, off = wgid / NXCD; wgid = (xcd < r ? xcd * (q + 1) : r * (q + 1) + (xcd - r) * q) + off; }
        const int nig = WGM * nN, gid = wgid / nig, fm = gid * WGM, gsz = (nM - fm) < WGM ? (nM - fm) : WGM;
        pm = fm + ((wgid % nig) % gsz); pn = (wgid % nig) / gsz; return true;
    }
};
struct DenseSched {
    static constexpr bool GATHER = false;
    Order o; const char* A; const char* Bt; size_t tstep; int pm_off;
    __device__ __forceinline__ void init(const void* A_, const void* Bt_, int M, int N, int KB, int G, int c, int pm_off_ = 0) { o.init(M / BM, N / BM, G, c); A = (const char*)A_; Bt = (const char*)Bt_; tstep = (size_t)BM * KB; pm_off = pm_off_; }
    __device__ __forceinline__ bool next(int i, Unit& u) const { if (!o.lin(i, u.pm, u.pn)) return false; u.pm += pm_off; u.a = A + (size_t)u.pm * tstep; u.b = Bt + (size_t)u.pn * tstep; u.e = 0; u.rb = 0; u.cnt = 0; return true; }
    __device__ __forceinline__ unsigned arow(const Unit&, int r) const { return (unsigned)r; }
    __device__ __forceinline__ void a_ready(const Unit&) const {}
    __device__ __forceinline__ void done(const Unit&) const {}
};

template <int MODE> struct AccT { typedef f32x4 type; };
template <> struct AccT<2> { typedef v4i_t type; };
template <int MODE, class Epi, class Sched>
__device__ __forceinline__ void gemm_phase(LAS unsigned char* lds, const int KB, const Sched& S, const Epi& E) {
    const int tid = threadIdx.x, wid = __builtin_amdgcn_readfirstlane(tid >> 6), lane = tid & 63, wr = wid >> 2, wc = wid & 3, fr = lane & 15, fq = lane >> 4;
    const int nt = KB / (BK * 2);
    int sR[2], sC[2]; unsigned voffB[2];
#pragma unroll
    for (int i = 0; i < 2; ++i) { stage_rc(tid * 16 + i * 8192, sR[i], sC[i]); const int Rb = Epi::PERM ? ((sR[i] & ~31) + perm32(sR[i] & 31)) : sR[i]; voffB[i] = (unsigned)(Rb * KB) + (unsigned)sC[i] * 2u; }
    const size_t kstep = (size_t)(BK * 2);
    const size_t hstep = (size_t)HALF * KB;
    const unsigned ldsw = (unsigned)wid * 1024u;
    const int aoff = lds_byte(wr * 64 + fr, fq * 8), boff = lds_byte(wc * 32 + fr, fq * 8);
#define PG8_SA(b, h) (((b) * 2 + (h)) * HTB)
#define PG8_SB(b, h) ((4 + (b) * 2 + (h)) * HTB)
#define PG8_STAGE(bufoff, gbase, voff) do { _Pragma("unroll") for (int _i = 0; _i < 2; ++_i) \
        __builtin_amdgcn_global_load_lds((const unsigned*)((const char*)(gbase) + (voff)[_i]), (LAS unsigned*)(lds + (bufoff) + ldsw + _i * 8192), 16, 0, 0); } while (0)
#define PG8_LDA(dst, b, h) do { _Pragma("unroll") for (int m = 0; m < 4; ++m) _Pragma("unroll") for (int k = 0; k < 2; ++k) dst[m][k] = *(const LAS bf16x8*)(lds + PG8_SA(b, h) + aoff + m * 2048 + k * 1024); } while (0)
#define PG8_LDB(dst, b, h) do { _Pragma("unroll") for (int n = 0; n < 2; ++n) _Pragma("unroll") for (int k = 0; k < 2; ++k) dst[n][k] = *(const LAS bf16x8*)(lds + PG8_SB(b, h) + boff + n * 2048 + k * 1024); } while (0)
#define PG8_MMA(ai, bj, At, Bt) do { __builtin_amdgcn_s_setprio(1); _Pragma("unroll") for (int m = 0; m < 4; ++m) _Pragma("unroll") for (int n = 0; n < 2; ++n) { \
        if constexpr (MODE == 1) { const v8i_t b8 = __builtin_shufflevector(__builtin_bit_cast(v4i_t, Bt[n][0]), __builtin_bit_cast(v4i_t, Bt[n][1]), 0, 1, 2, 3, 4, 5, 6, 7), a8 = __builtin_shufflevector(__builtin_bit_cast(v4i_t, At[m][0]), __builtin_bit_cast(v4i_t, At[m][1]), 0, 1, 2, 3, 4, 5, 6, 7); \
            asm volatile("v_mfma_scale_f32_16x16x128_f8f6f4 %0, %1, %2, %0, %3, %3 op_sel_hi:[0,0,0]" : "+v"(acc[ai][bj][m][n]) : "v"(b8), "v"(a8), "v"(fp8_one)); } \
        else if constexpr (MODE == 2) { _Pragma("unroll") for (int k = 0; k < 2; ++k) acc[ai][bj][m][n] = __builtin_amdgcn_mfma_i32_16x16x64_i8(__builtin_bit_cast(v4i_t, Bt[n][k]), __builtin_bit_cast(v4i_t, At[m][k]), acc[ai][bj][m][n], 0, 0, 0); } \
        else { _Pragma("unroll") for (int k = 0; k < 2; ++k) acc[ai][bj][m][n] = __builtin_amdgcn_mfma_f32_16x16x32_bf16(Bt[n][k], At[m][k], acc[ai][bj][m][n], 0, 0, 0); } } \
        __builtin_amdgcn_s_setprio(0); } while (0)
#define PG8_WAIT_V(n) asm volatile("s_waitcnt vmcnt(" #n ")" ::: "memory")
#define PG8_WAIT_L(n) asm volatile("s_waitcnt lgkmcnt(" #n ")" ::: "memory")
#define PG8_BAR __builtin_amdgcn_s_barrier()
#define PG8_SCHED __builtin_amdgcn_sched_barrier(0)
    const int fp8_one = 0x7f7f7f7f;
    Unit cur, nxt; int ui = 0;
    if (!S.next(0, cur)) return;
    typedef typename AccT<MODE>::type acc_t;
    acc_t acc[2][2][4][2];
#pragma unroll
    for (int a = 0; a < 2; ++a)
#pragma unroll
        for (int b = 0; b < 2; ++b)
#pragma unroll
            for (int m = 0; m < 4; ++m)
#pragma unroll
                for (int n = 0; n < 2; ++n) acc[a][b][m][n] = (acc_t){0, 0, 0, 0};
    bf16x8 At[4][2], B0[2][2], B1[2][2];
    unsigned vA0[2], vA1[2], vA0n[2], vA1n[2];
#pragma unroll
    for (int i = 0; i < 2; ++i) {
        vA0[i] = S.arow(cur, sR[i]) * (unsigned)KB + (unsigned)sC[i] * 2u;
        vA1[i] = S.arow(cur, HALF + sR[i]) * (unsigned)KB + (unsigned)sC[i] * 2u;
        vA0n[i] = vA0[i]; vA1n[i] = vA1[i];
    }
    const char* cA = cur.a; const char* cB = cur.b;
    S.a_ready(cur);
    PG8_STAGE(PG8_SB(0, 0), cB, voffB); PG8_STAGE(PG8_SB(0, 1), cB + hstep, voffB); PG8_STAGE(PG8_SA(0, 0), cA, vA0); PG8_STAGE(PG8_SA(0, 1), cA, vA1);
    if (wr == 1) PG8_BAR;
    PG8_WAIT_V(2); PG8_BAR;
    PG8_STAGE(PG8_SB(1, 0), cB + kstep, voffB); PG8_STAGE(PG8_SA(1, 0), cA + kstep, vA0); PG8_STAGE(PG8_SB(1, 1), cB + hstep + kstep, voffB);
    PG8_WAIT_V(6); PG8_BAR;
    for (;;) {
        const bool has_next = S.next(ui + 1, nxt);
        const char* nA = has_next ? nxt.a : cA; const char* nB = has_next ? nxt.b : cB;
        if constexpr (Epi::SCALES) { if (wid < 2) E.dma(cur, lds + SC_OFF + (ui & 1) * 2048, wid, lane); }
        if constexpr (Sched::GATHER) {
            if (has_next && wid == 0) S.idx_dma(nxt, lds + IDX_OFF + ((ui + 1) & 1) * 1024, lane);
        }
#pragma unroll 1
        for (int t = 0; t < nt; t += 2) {
            const bool last = (t == nt - 2);
            const char* a1 = cA + (size_t)(t + 1) * kstep;
            const char* a2 = last ? nA : cA + (size_t)(t + 2) * kstep; const char* b2 = last ? nB : cB + (size_t)(t + 2) * kstep;
            const char* a3 = a2 + kstep; const char* b3 = b2 + kstep;
            if constexpr (Sched::GATHER) {
                if (last && has_next) {
                    const LAS int* ix = (const LAS int*)(lds + IDX_OFF + ((ui + 1) & 1) * 1024);
#pragma unroll
                    for (int i = 0; i < 2; ++i) {
                        vA0n[i] = S.arow_lds(nxt, sR[i], ix) * (unsigned)KB + (unsigned)sC[i] * 2u;
                        vA1n[i] = S.arow_lds(nxt, HALF + sR[i], ix) * (unsigned)KB + (unsigned)sC[i] * 2u;
                    }
                }
            }
            unsigned w0[2], w1[2];
#pragma unroll
            for (int i = 0; i < 2; ++i) { w0[i] = (Sched::GATHER && last) ? vA0n[i] : vA0[i]; w1[i] = (Sched::GATHER && last) ? vA1n[i] : vA1[i]; }
            if (last && has_next) S.a_ready(nxt);
            PG8_LDB(B0, 0, 0); PG8_LDB(B1, 0, 1); PG8_SCHED; PG8_LDA(At, 0, 0); PG8_STAGE(PG8_SA(1, 1), a1, vA1);
            PG8_WAIT_V(8); PG8_WAIT_L(0); PG8_BAR; PG8_MMA(0, 0, At, B0); PG8_MMA(0, 1, At, B1); PG8_BAR; PG8_SCHED;
            PG8_LDA(At, 0, 1); PG8_STAGE(PG8_SB(0, 0), b2, voffB); PG8_STAGE(PG8_SB(0, 1), b2 + hstep, voffB); PG8_STAGE(PG8_SA(0, 0), a2, w0);
            PG8_WAIT_V(8); PG8_WAIT_L(0); PG8_BAR; PG8_MMA(1, 0, At, B0); PG8_MMA(1, 1, At, B1); PG8_BAR; PG8_SCHED;
            PG8_LDB(B0, 1, 0); PG8_LDB(B1, 1, 1); PG8_SCHED; PG8_LDA(At, 1, 0); PG8_STAGE(PG8_SA(0, 1), a2, w1);
            PG8_WAIT_V(8); PG8_WAIT_L(0); PG8_BAR; PG8_MMA(0, 0, At, B0); PG8_MMA(0, 1, At, B1); PG8_BAR; PG8_SCHED;
            PG8_LDA(At, 1, 1); PG8_STAGE(PG8_SB(1, 0), b3, voffB); PG8_STAGE(PG8_SB(1, 1), b3 + hstep, voffB); PG8_STAGE(PG8_SA(1, 0), a3, w0);
            PG8_WAIT_V(8); PG8_WAIT_L(0); PG8_BAR; PG8_MMA(1, 0, At, B0); PG8_MMA(1, 1, At, B1); PG8_BAR; PG8_SCHED;
        }
        if constexpr (MODE == 1) asm volatile("s_nop 15\n\ts_nop 15" ::: "memory");
        if (wr == 0) PG8_BAR;
        if constexpr (Epi::SCALES) E(acc, cur, wr, wc, fr, fq, (const LAS float*)(lds + SC_OFF + (ui & 1) * 2048)); else E(acc, cur, wr, wc, fr, fq);
        S.done(cur);
        if (!has_next) break;
#pragma unroll
        for (int a = 0; a < 2; ++a)
#pragma unroll
            for (int b = 0; b < 2; ++b)
#pragma unroll
                for (int m = 0; m < 4; ++m)
#pragma unroll
                    for (int n = 0; n < 2; ++n) acc[a][b][m][n] = (acc_t){0, 0, 0, 0};
        cur = nxt; cA = nA; cB = nB; ++ui;
#pragma unroll
        for (int i = 0; i < 2; ++i) { vA0[i] = vA0n[i]; vA1[i] = vA1n[i]; }
        if (wr == 1) PG8_BAR;
    }
    PG8_WAIT_V(0);
    PG8_BAR;
#undef PG8_SA
#undef PG8_SB
#undef PG8_STAGE
#undef PG8_LDA
#undef PG8_LDB
#undef PG8_MMA
#undef PG8_WAIT_V
#undef PG8_WAIT_L
#undef PG8_BAR
#undef PG8_SCHED
}

struct EpiBf16Store {
    static constexpr bool PERM = true; static constexpr bool SCALES = false;
    bf16_t* O; int ldo; float sc;
    __device__ __forceinline__ void operator()(const f32x4 (&acc)[2][2][4][2], const Unit& u, int wr, int wc, int fr, int fq) const {
        const int row0 = u.pm * BM + wr * 64 + fr, col0 = u.pn * BM + wc * 32 + 8 * fq;
#pragma unroll
        for (int ai = 0; ai < 2; ++ai)
#pragma unroll
            for (int m = 0; m < 4; ++m) { bf16_t* rowp = O + (size_t)(row0 + ai * HALF + m * 16) * ldo + col0;
#pragma unroll
                for (int bj = 0; bj < 2; ++bj) { const f32x4 v0 = acc[ai][bj][m][0] * sc, v1 = acc[ai][bj][m][1] * sc;
                    u32x4 w; w.x = cvt_pk_bf16(v0[0], v0[1]); w.y = cvt_pk_bf16(v0[2], v0[3]); w.z = cvt_pk_bf16(v1[0], v1[1]); w.w = cvt_pk_bf16(v1[2], v1[3]);
                    *(u32x4*)(rowp + bj * HALF) = w; } }
    }
};
struct EpiRes {
    static constexpr bool PERM = false; static constexpr bool SCALES = false;
    const float* xin_l; const float* xin_c; float* xout_l; float* xout_c; const float* gate; float sc; int nt_in;
    __device__ __forceinline__ void operator()(const f32x4 (&acc)[2][2][4][2], const Unit& u, int wr, int wc, int fr, int fq) const {
        const int trow = u.pm * BM; const bool isc = trow >= ML;
        const int modrow = isc ? 4 : trow / SEQ;
        const float* xi = isc ? xin_c : xin_l; float* xo = isc ? xout_c : xout_l;
        const int row0 = (isc ? trow - ML : trow) + wr * 64 + fr, col0 = u.pn * BM + wc * 32 + 4 * fq;
        const float* gp = gate + (size_t)modrow * 6144 + col0;
        f32x4 gv[2][2];
#pragma unroll
        for (int bj = 0; bj < 2; ++bj)
#pragma unroll
            for (int n = 0; n < 2; ++n) gv[bj][n] = *(const f32x4*)(gp + bj * HALF + n * 16) * sc;
#pragma unroll
        for (int ai = 0; ai < 2; ++ai) {
            f32x4 xv[4][2][2];
#pragma unroll
            for (int m = 0; m < 4; ++m) { const size_t off = (size_t)(row0 + ai * HALF + m * 16) * D + col0;
#pragma unroll
                for (int bj = 0; bj < 2; ++bj)
#pragma unroll
                    for (int n = 0; n < 2; ++n) xv[m][bj][n] = nt_in ? __builtin_nontemporal_load((const f32x4*)(xi + off + bj * HALF + n * 16)) : *(const f32x4*)(xi + off + bj * HALF + n * 16); }
            asm volatile("s_waitcnt vmcnt(0)" ::: "memory");
#pragma unroll
            for (int m = 0; m < 4; ++m) { const size_t off = (size_t)(row0 + ai * HALF + m * 16) * D + col0;
#pragma unroll
                for (int bj = 0; bj < 2; ++bj)
#pragma unroll
                    for (int n = 0; n < 2; ++n) *(f32x4*)(xo + off + bj * HALF + n * 16) = xv[m][bj][n] + gv[bj][n] * acc[ai][bj][m][n]; }
        }
    }
};
template <bool IN_F32>
struct EpiRes16 {
    static constexpr bool PERM = true; static constexpr bool SCALES = false;
    const float* xin_l; const float* xin_c; bf16_t* x16; const float* gate; float sc; int pad;
    __device__ __forceinline__ void operator()(const f32x4 (&acc)[2][2][4][2], const Unit& u, int wr, int wc, int fr, int fq) const {
        const int trow = u.pm * BM; const bool isc = trow >= ML;
        const int modrow = isc ? 4 : trow / SEQ;
        const int row0 = trow + wr * 64 + fr, col0 = u.pn * BM + wc * 32 + 8 * fq;
        const float* gp = gate + (size_t)modrow * 6144 + col0;
        f32x4 gv[2][2];
#pragma unroll
        for (int bj = 0; bj < 2; ++bj)
#pragma unroll
            for (int n = 0; n < 2; ++n) gv[bj][n] = *(const f32x4*)(gp + bj * HALF + n * 4) * sc;
        if constexpr (IN_F32) {
            const float* xi = isc ? xin_c : xin_l; const int rb = isc ? row0 - ML : row0;
#pragma unroll
            for (int ai = 0; ai < 2; ++ai) {
                f32x4 xv[4][2][2];
#pragma unroll
                for (int m = 0; m < 4; ++m) { const size_t off = (size_t)(rb + ai * HALF + m * 16) * D + col0;
#pragma unroll
                    for (int bj = 0; bj < 2; ++bj)
#pragma unroll
                        for (int n = 0; n < 2; ++n) xv[m][bj][n] = __builtin_nontemporal_load((const f32x4*)(xi + off + bj * HALF + n * 4)); }
                asm volatile("s_waitcnt vmcnt(0)" ::: "memory");
#pragma unroll
                for (int m = 0; m < 4; ++m) { const size_t off = (size_t)(row0 + ai * HALF + m * 16) * D + col0;
#pragma unroll
                    for (int bj = 0; bj < 2; ++bj) { const f32x4 o0 = xv[m][bj][0] + gv[bj][0] * acc[ai][bj][m][0], o1 = xv[m][bj][1] + gv[bj][1] * acc[ai][bj][m][1];
                        u32x4 w; w.x = cvt_pk_bf16(o0[0], o0[1]); w.y = cvt_pk_bf16(o0[2], o0[3]); w.z = cvt_pk_bf16(o1[0], o1[1]); w.w = cvt_pk_bf16(o1[2], o1[3]);
                        *(u32x4*)(x16 + off + bj * HALF) = w; } }
            }
        } else {
#pragma unroll
            for (int ai = 0; ai < 2; ++ai) {
                u32x4 xr[4][2];
#pragma unroll
                for (int m = 0; m < 4; ++m) { const size_t off = (size_t)(row0 + ai * HALF + m * 16) * D + col0;
#pragma unroll
                    for (int bj = 0; bj < 2; ++bj) xr[m][bj] = *(const u32x4*)(x16 + off + bj * HALF); }
                asm volatile("s_waitcnt vmcnt(0)" ::: "memory");
#pragma unroll
                for (int m = 0; m < 4; ++m) { const size_t off = (size_t)(row0 + ai * HALF + m * 16) * D + col0;
#pragma unroll
                    for (int bj = 0; bj < 2; ++bj) { const u32x4 r = xr[m][bj]; f32x4 x0, x1;
                        x0[0] = __builtin_bit_cast(float, r.x << 16); x0[1] = __builtin_bit_cast(float, r.x & 0xffff0000u); x0[2] = __builtin_bit_cast(float, r.y << 16); x0[3] = __builtin_bit_cast(float, r.y & 0xffff0000u);
                        x1[0] = __builtin_bit_cast(float, r.z << 16); x1[1] = __builtin_bit_cast(float, r.z & 0xffff0000u); x1[2] = __builtin_bit_cast(float, r.w << 16); x1[3] = __builtin_bit_cast(float, r.w & 0xffff0000u);
                        const f32x4 o0 = x0 + gv[bj][0] * acc[ai][bj][m][0], o1 = x1 + gv[bj][1] * acc[ai][bj][m][1];
                        u32x4 w; w.x = cvt_pk_bf16(o0[0], o0[1]); w.y = cvt_pk_bf16(o0[2], o0[3]); w.z = cvt_pk_bf16(o1[0], o1[1]); w.w = cvt_pk_bf16(o1[2], o1[3]);
                        *(u32x4*)(x16 + off + bj * HALF) = w; } }
            }
        }
    }
};
struct EpiSwiglu {
    static constexpr bool PERM = true; static constexpr bool SCALES = false;
    bf16_t* H; int ldo; float sin;
    __device__ __forceinline__ void operator()(const f32x4 (&acc)[2][2][4][2], const Unit& u, int wr, int wc, int fr, int fq) const {
        const int row0 = u.pm * BM + wr * 64 + fr, col0 = u.pn * HALF + wc * 32 + 8 * fq;
#pragma unroll
        for (int ai = 0; ai < 2; ++ai)
#pragma unroll
            for (int m = 0; m < 4; ++m) { bf16_t* rowp = H + (size_t)(row0 + ai * HALF + m * 16) * ldo + col0;
                float o[8];
#pragma unroll
                for (int n = 0; n < 2; ++n)
#pragma unroll
                    for (int j = 0; j < 4; j += 2) {
                        const f32x2 G = {acc[ai][0][m][n][j], acc[ai][0][m][n][j + 1]}, U = {acc[ai][1][m][n][j], acc[ai][1][m][n][j + 1]};
                        const f32x2 Ee = G * (-1.4426950408889634f * sin); f32x2 T = {__builtin_amdgcn_exp2f(Ee.x), __builtin_amdgcn_exp2f(Ee.y)}; T = T + 1.0f;
                        const f32x2 R = {__builtin_amdgcn_rcpf(T.x), __builtin_amdgcn_rcpf(T.y)};
                        const f32x2 Q = (G * U) * (R * (sin * sin));
                        o[n * 4 + j] = Q.x; o[n * 4 + j + 1] = Q.y; }
                u32x4 w; w.x = cvt_pk_bf16(o[0], o[1]); w.y = cvt_pk_bf16(o[2], o[3]); w.z = cvt_pk_bf16(o[4], o[5]); w.w = cvt_pk_bf16(o[6], o[7]);
                *(u32x4*)rowp = w; }
    }
};
__device__ __forceinline__ unsigned pack4_fp8(float a, float b, float c, float d) {
    int p = 0; p = __builtin_amdgcn_cvt_pk_fp8_f32(a, b, p, false); p = __builtin_amdgcn_cvt_pk_fp8_f32(c, d, p, true); return (unsigned)p; }
struct EpiSwiglu8 {
    static constexpr bool PERM = true; static constexpr bool SCALES = false;
    unsigned char* H; int ldo; float sin, sout;
    __device__ __forceinline__ void operator()(const f32x4 (&acc)[2][2][4][2], const Unit& u, int wr, int wc, int fr, int fq) const {
        const int row0 = u.pm * BM + wr * 64 + fr, col0 = u.pn * HALF + wc * 32 + 8 * fq;
        const float c1 = -1.4426950408889634f * sin, c2 = sin * sin * sout;
#pragma unroll
        for (int ai = 0; ai < 2; ++ai)
#pragma unroll
            for (int m = 0; m < 4; ++m) { unsigned char* rowp = H + (size_t)(row0 + ai * HALF + m * 16) * ldo + col0;
                float o[8];
#pragma unroll
                for (int n = 0; n < 2; ++n)
#pragma unroll
                    for (int j = 0; j < 4; j += 2) {
                        const f32x2 G = {acc[ai][0][m][n][j], acc[ai][0][m][n][j + 1]}, U = {acc[ai][1][m][n][j], acc[ai][1][m][n][j + 1]};
                        const f32x2 Ee = G * c1; f32x2 T = {__builtin_amdgcn_exp2f(Ee.x), __builtin_amdgcn_exp2f(Ee.y)}; T = T + 1.0f;
                        const f32x2 R = {__builtin_amdgcn_rcpf(T.x), __builtin_amdgcn_rcpf(T.y)};
                        const f32x2 Q = (G * U) * (R * c2);
                        o[n * 4 + j] = __builtin_amdgcn_fmed3f(Q.x, -448.f, 448.f); o[n * 4 + j + 1] = __builtin_amdgcn_fmed3f(Q.y, -448.f, 448.f); }
                u32x2 w; w.x = pack4_fp8(o[0], o[1], o[2], o[3]); w.y = pack4_fp8(o[4], o[5], o[6], o[7]);
                *(u32x2*)rowp = w; }
    }
};
template <bool F8>
struct EpiSwigluI8 {
    static constexpr bool PERM = true; static constexpr bool SCALES = true;
    void* H; int ldo; const float* rs; const float* cs;
    __device__ __forceinline__ void dma(const Unit& u, LAS unsigned char* slot, int wid, int lane) const {
        const float* src = wid == 0 ? rs + (size_t)u.pm * BM + 4 * lane : cs + (size_t)u.pn * BM + 4 * lane;
        __builtin_amdgcn_global_load_lds((const unsigned*)src, (LAS unsigned*)(slot + wid * 1024), 16, 0, 0); }
    __device__ __forceinline__ void operator()(const v4i_t (&acc)[2][2][4][2], const Unit& u, int wr, int wc, int fr, int fq, const LAS float* sl) const {
        const int row0 = u.pm * BM + wr * 64 + fr, col0 = u.pn * HALF + wc * 32 + 8 * fq, cc0 = u.pn * BM + wc * 32 + 8 * fq;
        const LAS float* cl = sl + 256 + wc * 32 + 8 * fq; const f32x4 cg0 = *(const LAS f32x4*)cl, cg1 = *(const LAS f32x4*)(cl + 4), cu0 = *(const LAS f32x4*)(cl + HALF), cu1 = *(const LAS f32x4*)(cl + HALF + 4);
        f32x2 ce[2][2], cq[2][2];
#pragma unroll
        for (int n = 0; n < 2; ++n)
#pragma unroll
            for (int jp = 0; jp < 2; ++jp) { const f32x2 g2 = {n ? cg1[2 * jp] : cg0[2 * jp], n ? cg1[2 * jp + 1] : cg0[2 * jp + 1]}, u2 = {n ? cu1[2 * jp] : cu0[2 * jp], n ? cu1[2 * jp + 1] : cu0[2 * jp + 1]};
                ce[n][jp] = g2 * -1.4426950408889634f; cq[n][jp] = g2 * u2; }
#pragma unroll
        for (int ai = 0; ai < 2; ++ai)
#pragma unroll
            for (int m = 0; m < 4; ++m) { const int row = row0 + ai * HALF + m * 16; const float r = sl[wr * 64 + fr + ai * HALF + m * 16], r2 = F8 ? r * r * FP8_SH : r * r;
                float o[8];
#pragma unroll
                for (int n = 0; n < 2; ++n)
#pragma unroll
                    for (int jp = 0; jp < 2; ++jp) {
                        const f32x2 G = {(float)acc[ai][0][m][n][2 * jp], (float)acc[ai][0][m][n][2 * jp + 1]}, U = {(float)acc[ai][1][m][n][2 * jp], (float)acc[ai][1][m][n][2 * jp + 1]};
                        const f32x2 Ee = G * (ce[n][jp] * r); f32x2 T = {__builtin_amdgcn_exp2f(Ee.x), __builtin_amdgcn_exp2f(Ee.y)}; T = T + 1.0f;
                        const f32x2 R = {__builtin_amdgcn_rcpf(T.x), __builtin_amdgcn_rcpf(T.y)};
                        const f32x2 Q = (G * U) * (R * (cq[n][jp] * r2));
                        o[n * 4 + 2 * jp] = Q.x; o[n * 4 + 2 * jp + 1] = Q.y; }
                if constexpr (F8) {
#pragma unroll
                    for (int j = 0; j < 8; ++j) o[j] = __builtin_amdgcn_fmed3f(o[j], -448.f, 448.f);
                    u32x2 w; w.x = pack4_fp8(o[0], o[1], o[2], o[3]); w.y = pack4_fp8(o[4], o[5], o[6], o[7]);
                    *(u32x2*)((unsigned char*)H + (size_t)row * ldo + col0) = w;
                } else {
                    u32x4 w; w.x = cvt_pk_bf16(o[0], o[1]); w.y = cvt_pk_bf16(o[2], o[3]); w.z = cvt_pk_bf16(o[4], o[5]); w.w = cvt_pk_bf16(o[6], o[7]);
                    *(u32x4*)((bf16_t*)H + (size_t)row * ldo + col0) = w; } }
    }
};
struct EpiProjFused {
    static constexpr bool PERM = true; static constexpr bool SCALES = false;
    bf16_t* O;
    __device__ __forceinline__ void operator()(const f32x4 (&acc)[2][2][4][2], const Unit& u, int wr, int wc, int fr, int fq) const {
        const int row0 = u.pm * BM + wr * 64 + fr;
        if (u.pn < 4) {
            const int col0 = (u.pn < 2 ? P_GLU : P_V) + (u.pn & 1) * HALF + wc * 32 + 8 * fq;
#pragma unroll
            for (int ai = 0; ai < 2; ++ai)
#pragma unroll
                for (int m = 0; m < 4; ++m) { bf16_t* rowp = O + (size_t)(row0 + ai * HALF + m * 16) * PW + col0;
                    float o[8];
#pragma unroll
                    for (int n = 0; n < 2; ++n)
#pragma unroll
                        for (int j = 0; j < 4; j += 2) { const f32x2 a = {acc[ai][0][m][n][j], acc[ai][0][m][n][j + 1]}, b = {acc[ai][1][m][n][j], acc[ai][1][m][n][j + 1]};
                            f32x2 q;
                            if (u.pn < 2) { const f32x2 e = b * -1.4426950408889634f; f32x2 t = {__builtin_amdgcn_exp2f(e.x), __builtin_amdgcn_exp2f(e.y)}; t = t + 1.0f;
                                const f32x2 r = {__builtin_amdgcn_rcpf(t.x), __builtin_amdgcn_rcpf(t.y)}; q = a * r; }
                            else q = a * b;
                            o[n * 4 + j] = q.x; o[n * 4 + j + 1] = q.y; }
                    u32x4 w; w.x = cvt_pk_bf16(o[0], o[1]); w.y = cvt_pk_bf16(o[2], o[3]); w.z = cvt_pk_bf16(o[4], o[5]); w.w = cvt_pk_bf16(o[6], o[7]);
                    *(u32x4*)rowp = w; }
        } else {
            const int col0 = P_SBG + (u.pn - 4) * BM + wc * 32 + 8 * fq; const bool gl = u.pn >= 7;
#pragma unroll
            for (int ai = 0; ai < 2; ++ai)
#pragma unroll
                for (int m = 0; m < 4; ++m) { bf16_t* rowp = O + (size_t)(row0 + ai * HALF + m * 16) * PW + col0;
#pragma unroll
                    for (int bj = 0; bj < 2; ++bj) { f32x4 v0 = acc[ai][bj][m][0], v1 = acc[ai][bj][m][1];
                        if (gl) {
#pragma unroll
                            for (int j = 0; j < 4; ++j) { const f32x2 x = {v0[j], v1[j]};
                                const f32x2 e = x * ((x * x) * (-2.302208198f * 0.044715f) + -2.302208198f); f32x2 t = {__builtin_amdgcn_exp2f(e.x), __builtin_amdgcn_exp2f(e.y)}; t = t + 1.0f;
                                const f32x2 r = {__builtin_amdgcn_rcpf(t.x), __builtin_amdgcn_rcpf(t.y)}, q = x * r; v0[j] = q.x; v1[j] = q.y; } }
                        u32x4 w; w.x = cvt_pk_bf16(v0[0], v0[1]); w.y = cvt_pk_bf16(v0[2], v0[3]); w.z = cvt_pk_bf16(v1[0], v1[1]); w.w = cvt_pk_bf16(v1[2], v1[3]);
                        *(u32x4*)(rowp + bj * HALF) = w; } }
        }
    }
};
struct EpiProjFusedI8 {
    static constexpr bool PERM = true; static constexpr bool SCALES = true;
    bf16_t* O; const float* rs; const float* cs;
    __device__ __forceinline__ void dma(const Unit& u, LAS unsigned char* slot, int wid, int lane) const {
        const float* src = wid == 0 ? rs + (size_t)u.pm * BM + 4 * lane : cs + (size_t)u.pn * BM + 4 * lane;
        __builtin_amdgcn_global_load_lds((const unsigned*)src, (LAS unsigned*)(slot + wid * 1024), 16, 0, 0); }
    __device__ __forceinline__ void operator()(const v4i_t (&acc)[2][2][4][2], const Unit& u, int wr, int wc, int fr, int fq, const LAS float* sl) const {
        const int row0 = u.pm * BM + wr * 64 + fr, cc0 = u.pn * BM + wc * 32 + 8 * fq;
        const LAS float* cl = sl + 256 + wc * 32 + 8 * fq; const f32x4 ca0 = *(const LAS f32x4*)cl, ca1 = *(const LAS f32x4*)(cl + 4), cb0 = *(const LAS f32x4*)(cl + HALF), cb1 = *(const LAS f32x4*)(cl + HALF + 4);
        f32x2 ca[2][2], cb[2][2];
#pragma unroll
        for (int jp = 0; jp < 2; ++jp) { ca[0][jp] = (f32x2){ca0[2 * jp], ca0[2 * jp + 1]}; ca[1][jp] = (f32x2){ca1[2 * jp], ca1[2 * jp + 1]}; cb[0][jp] = (f32x2){cb0[2 * jp], cb0[2 * jp + 1]}; cb[1][jp] = (f32x2){cb1[2 * jp], cb1[2 * jp + 1]}; }
        if (u.pn < 4) {
            const int col0 = (u.pn < 2 ? P_GLU : P_V) + (u.pn & 1) * HALF + wc * 32 + 8 * fq;
#pragma unroll
            for (int ai = 0; ai < 2; ++ai)
#pragma unroll
                for (int m = 0; m < 4; ++m) { const int row = row0 + ai * HALF + m * 16; bf16_t* rowp = O + (size_t)row * PW + col0; const float r = sl[wr * 64 + fr + ai * HALF + m * 16];
                    float o[8];
#pragma unroll
                    for (int n = 0; n < 2; ++n)
#pragma unroll
                        for (int jp = 0; jp < 2; ++jp) {
                            const f32x2 a = (f32x2){(float)acc[ai][0][m][n][2 * jp], (float)acc[ai][0][m][n][2 * jp + 1]} * (ca[n][jp] * r);
                            const f32x2 b = (f32x2){(float)acc[ai][1][m][n][2 * jp], (float)acc[ai][1][m][n][2 * jp + 1]} * (cb[n][jp] * r);
                            f32x2 q;
                            if (u.pn < 2) { const f32x2 e = b * -1.4426950408889634f; f32x2 t = {__builtin_amdgcn_exp2f(e.x), __builtin_amdgcn_exp2f(e.y)}; t = t + 1.0f;
                                const f32x2 rr = {__builtin_amdgcn_rcpf(t.x), __builtin_amdgcn_rcpf(t.y)}; q = a * rr; }
                            else q = a * b;
                            o[n * 4 + 2 * jp] = q.x; o[n * 4 + 2 * jp + 1] = q.y; }
                    u32x4 w; w.x = cvt_pk_bf16(o[0], o[1]); w.y = cvt_pk_bf16(o[2], o[3]); w.z = cvt_pk_bf16(o[4], o[5]); w.w = cvt_pk_bf16(o[6], o[7]);
                    *(u32x4*)rowp = w; }
        } else {
            const int col0 = P_SBG + (u.pn - 4) * BM + wc * 32 + 8 * fq; const bool gl = u.pn >= 7;
#pragma unroll
            for (int ai = 0; ai < 2; ++ai)
#pragma unroll
                for (int m = 0; m < 4; ++m) { const int row = row0 + ai * HALF + m * 16; bf16_t* rowp = O + (size_t)row * PW + col0; const float r = sl[wr * 64 + fr + ai * HALF + m * 16];
#pragma unroll
                    for (int bj = 0; bj < 2; ++bj) { float o[8];
#pragma unroll
                        for (int n = 0; n < 2; ++n)
#pragma unroll
                            for (int jp = 0; jp < 2; ++jp) {
                                f32x2 x = (f32x2){(float)acc[ai][bj][m][n][2 * jp], (float)acc[ai][bj][m][n][2 * jp + 1]} * ((bj ? cb[n][jp] : ca[n][jp]) * r);
                                if (gl) { const f32x2 e = x * ((x * x) * (-2.302208198f * 0.044715f) + -2.302208198f); f32x2 t = {__builtin_amdgcn_exp2f(e.x), __builtin_amdgcn_exp2f(e.y)}; t = t + 1.0f;
                                    const f32x2 rr = {__builtin_amdgcn_rcpf(t.x), __builtin_amdgcn_rcpf(t.y)}; x = x * rr; }
                                o[n * 4 + 2 * jp] = x.x; o[n * 4 + 2 * jp + 1] = x.y; }
                        u32x4 w; w.x = cvt_pk_bf16(o[0], o[1]); w.y = cvt_pk_bf16(o[2], o[3]); w.z = cvt_pk_bf16(o[4], o[5]); w.w = cvt_pk_bf16(o[6], o[7]);
                        *(u32x4*)(rowp + bj * HALF) = w; } }
        }
    }
};
}

constexpr size_t MiB = 1u << 20;
constexpr size_t WS_CTL = 0;
constexpr size_t WS_MODV = 1 * MiB;
constexpr size_t WS_LRUW = 2 * MiB;
constexpr size_t WS_GCONST = 2 * MiB + 512 * 1024;
constexpr size_t WS_XCTX = 4 * MiB;
constexpr size_t WS_SUMM = 8 * MiB;
constexpr size_t WS_CR = 13 * MiB;
constexpr size_t WS_WIN = 16 * MiB;
constexpr size_t WS_WOUT = 25 * MiB;
constexpr bool WIN8 = false;
constexpr bool WINI8_L0 = true, WINI8_L1 = true;
constexpr bool DENSE_UPI8 = true;
constexpr bool DENSE_UP8 = false, DENSE_DOWN8 = true;
constexpr size_t WS_W13 = 29 * MiB;
constexpr size_t WS_W2 = 40 * MiB;
constexpr size_t WS_ROUTE = 45 * MiB + 512 * 1024;
constexpr size_t WS_WMOE = 48 * MiB;
constexpr size_t WS_HBUF = 114 * MiB;
constexpr size_t WS_BIG = 180 * MiB;
constexpr size_t WS_X16 = WS_BIG + 250 * MiB;
constexpr size_t WS_W13Q = WS_BIG + 317 * MiB;
constexpr size_t WS_W13QS = WS_W13Q + (size_t)2 * DFF * D;
constexpr size_t WS_RS = WS_W13QS + 64 * 1024;
constexpr size_t WS_WINQ = WS_BIG + 324 * MiB;
constexpr size_t WS_WINQS = WS_BIG + 329 * MiB;
constexpr size_t WS_RS1 = WS_WINQS + 64 * 1024;

__device__ __forceinline__ unsigned pk2(float lo, float hi) { return (unsigned)f2bf(lo) | ((unsigned)f2bf(hi) << 16); }
__device__ __forceinline__ int win_row(int n0) {
    if (n0 < 256) return 256 * (n0 >> 7) + (n0 & 127);
    if (n0 < 512) { const int q = n0 - 256; return 256 * (q >> 7) + 128 + (q & 127); }
    if (n0 < 768) return 1024 + (n0 - 512);
    if (n0 < 1024) { const int q = n0 - 768; return 512 + 256 * (q >> 7) + (q & 127); }
    if (n0 < 1280) { const int q = n0 - 1024; return 512 + 256 * (q >> 7) + 128 + (q & 127); }
    return n0;
}
__device__ __forceinline__ void transpose_item(const float* W, int K, int N, bf16_t* WT, int mode, LAS float* scr, int item, int lane) {
    const int nblk = N / 32, kb = item / nblk, nb = item % nblk, k0 = 64 * kb, n0 = 32 * nb;
    const int drow0 = (mode == 0) ? n0 : (mode == 3 ? win_row(n0) : (256 * (n0 >> 7) + (n0 & 127) + (mode == 2 ? 128 : 0)));
#pragma unroll 8
    for (int i = 0; i < 32; ++i) { const int kk = 2 * i + (lane >> 5); scr[kk * 33 + (lane & 31)] = __builtin_nontemporal_load(W + (size_t)(k0 + kk) * N + n0 + (lane & 31)); }
    asm volatile("s_waitcnt lgkmcnt(0)" ::: "memory");
    const int c = lane & 7;
#pragma unroll
    for (int j = 0; j < 4; ++j) { const int n = (lane >> 3) + 8 * j; const LAS float* s = scr + (8 * c) * 33 + n;
        u32x4 o; o.x = pk2(s[0 * 33], s[1 * 33]); o.y = pk2(s[2 * 33], s[3 * 33]); o.z = pk2(s[4 * 33], s[5 * 33]); o.w = pk2(s[6 * 33], s[7 * 33]);
        *(u32x4*)(WT + (size_t)(drow0 + n) * K + k0 + 8 * c) = o; }
    asm volatile("s_waitcnt lgkmcnt(0)" ::: "memory");
}


constexpr int XS = 68;
constexpr int NPOS = 132;
constexpr int CW_BYTES = 17408;
constexpr int CWL_OFF = NWAVES * CW_BYTES;
constexpr float LOG2E = 1.4426950408889634f;
struct MixArgs {
    const bf16_t* proj; bf16_t* ybuf;
    const float* conf_w; const float* conf_b; const float* ln_g; const float* ln_b;
    const float* sconv_w; const float* g_mix;
    const float* cw; const float* cb; const bf16_t* gwt; const float* gconst;
    float* SA; float* SB; float* CR;
    unsigned* AB;
};
__device__ __forceinline__ void unpack8(const u32x4 r, float (&v)[8]) {
    v[0] = __builtin_bit_cast(float, r.x << 16); v[1] = __builtin_bit_cast(float, r.x & 0xffff0000u);
    v[2] = __builtin_bit_cast(float, r.y << 16); v[3] = __builtin_bit_cast(float, r.y & 0xffff0000u);
    v[4] = __builtin_bit_cast(float, r.z << 16); v[5] = __builtin_bit_cast(float, r.z & 0xffff0000u);
    v[6] = __builtin_bit_cast(float, r.w << 16); v[7] = __builtin_bit_cast(float, r.w & 0xffff0000u);
}
__device__ __forceinline__ float fast_exp2(float x) { return __builtin_amdgcn_exp2f(x); }
__device__ __forceinline__ float fast_rcp(float x) { return __builtin_amdgcn_rcpf(x); }
__device__ __forceinline__ float fast_sigmoid(float x) { return fast_rcp(1.0f + fast_exp2(-LOG2E * x)); }
__device__ __forceinline__ float fast_gelu_tanh(float x) { return x * fast_sigmoid(1.5957691216057308f * (x + 0.044715f * x * x * x)); }

__device__ __forceinline__ void a_unit(LAS unsigned char* lds, int tid, int ua, const MixArgs& m) {
    LAS float* g = (LAS float*)lds;
    const int r0 = ua * 32;
    int lo, hi; if (r0 < ML) { lo = (r0 / GW) * GW; hi = lo + GW; } else { lo = ML + ((r0 - ML) / CTXL) * CTXL; hi = lo + CTXL; }
    {
        u32x4 rv[4];
#pragma unroll
        for (int i = 0; i < 4; ++i) {
            const int it = tid + NTHREADS * i, sr = it >> 5, cg = it & 31; int s = r0 - 15 + sr; s = s < lo ? lo : (s >= hi ? hi - 1 : s);
            rv[i] = *(const u32x4*)(m.proj + (size_t)s * PW + P_GLU + 8 * cg);
        }
#pragma unroll
        for (int i = 0; i < 4; ++i) {
            const int it = tid + NTHREADS * i, sr = it >> 5, cg = it & 31, s = r0 - 15 + sr;
            if (it < 62 * 32) {
                float av[8], o[8]; unpack8(rv[i], av);
                const bool ok = (s >= lo && s < hi);
#pragma unroll
                for (int j = 0; j < 8; ++j) o[j] = ok ? av[j] : 0.f;
                *(LAS f32x4*)(g + sr * 256 + 8 * cg) = (f32x4){o[0], o[1], o[2], o[3]};
                *(LAS f32x4*)(g + sr * 256 + 8 * cg + 4) = (f32x4){o[4], o[5], o[6], o[7]};
            }
        }
    }
    const int c = tid & 255, half = tid >> 8;
    float acc[16];
    {
        float w[CONFK];
#pragma unroll
        for (int k = 0; k < CONFK; ++k) w[k] = m.conf_w[k * 256 + c];
        const float cb = m.conf_b[c];
        f32x2 wp[CONFK + 1];
#pragma unroll
        for (int k = 0; k <= CONFK; ++k) wp[k] = (f32x2){k < CONFK ? w[k] : 0.f, k > 0 ? w[k - 1] : 0.f};
        __syncthreads();
        f32x2 ac2[8];
#pragma unroll
        for (int t = 0; t < 8; ++t) ac2[t] = (f32x2){cb, cb};
#pragma unroll
        for (int j = 0; j < 46; ++j) {
            const float gv = g[(half * 16 + j) * 256 + c];
#pragma unroll
            for (int tp = 0; tp < 8; ++tp) { const int k = j - 2 * tp; if (k >= 0 && k <= CONFK) ac2[tp] = wp[k] * gv + ac2[tp]; }
        }
#pragma unroll
        for (int t = 0; t < 8; ++t) { acc[2 * t] = ac2[t].x; acc[2 * t + 1] = ac2[t].y; }
    }
    __syncthreads();
#pragma unroll
    for (int t = 0; t < 16; ++t) g[(half * 16 + t) * 256 + c] = acc[t];
    __syncthreads();
    {
        const int wave = tid >> 6, lane = tid & 63;
        const f32x4 lg = *(const f32x4*)(m.ln_g + 4 * lane), lb = *(const f32x4*)(m.ln_b + 4 * lane), gm = *(const f32x4*)(m.g_mix + 4 * lane);
#pragma unroll
        for (int q = 0; q < 4; ++q) {
            const int t = wave * 4 + q;
            const f32x4 u4 = *(const LAS f32x4*)(g + t * 256 + 4 * lane);
            const float mean = wave_sum((u4[0] + u4[1]) + (u4[2] + u4[3])) * (1.0f / 256.0f);
            const f32x4 d = u4 - mean;
            const float var = wave_sum((d[0] * d[0] + d[1] * d[1]) + (d[2] * d[2] + d[3] * d[3])) * (1.0f / 256.0f);
            const float rstd = rsqrtf(var + EPS);
            f32x4 ya;
#pragma unroll
            for (int j = 0; j < 4; ++j) { const float ln = d[j] * rstd * lg[j] + lb[j]; ya[j] = ln * fast_sigmoid(ln); }
            float hs = (ya[0] * ya[0] + ya[1] * ya[1]) + (ya[2] * ya[2] + ya[3] * ya[3]);
            hs += __shfl_xor(hs, 1); hs += __shfl_xor(hs, 2); hs += __shfl_xor(hs, 4); hs += __shfl_xor(hs, 8);
            const float hr = rsqrtf(hs * (1.0f / 64.0f) + EPS);
            u32x2 o; o.x = cvt_pk_bf16(ya[0] * hr * gm[0], ya[1] * hr * gm[1]); o.y = cvt_pk_bf16(ya[2] * hr * gm[2], ya[3] * hr * gm[3]);
            *(u32x2*)(m.ybuf + (size_t)(r0 + t) * D + 4 * lane) = o;
        }
    }
    __syncthreads();
}
__device__ __forceinline__ void b_unit(int tid, int ub, const MixArgs& m) {
    const int r0 = ub * 64;
#pragma unroll
    for (int i = 0; i < 4; ++i) {
        const int it = tid + NTHREADS * i, r = r0 + (it >> 5), cg = it & 31;
        int lo, hi, step; if (r < ML) { lo = (r / SEQ) * SEQ; hi = lo + SEQ; step = GW; } else { lo = ML + ((r - ML) / CTXL) * CTXL; hi = lo + CTXL; step = 1; }
        u32x4 rc[3];
#pragma unroll
        for (int k = 0; k < 3; ++k) { int s = r + (k - 1) * step; s = (s >= lo && s < hi) ? s : r; rc[k] = *(const u32x4*)(m.proj + (size_t)s * PW + P_V + 8 * cg); }
        const u32x4 rb = *(const u32x4*)(m.proj + (size_t)r * PW + P_SBG + 8 * cg);
        float acc[8];
#pragma unroll
        for (int j = 0; j < 8; ++j) acc[j] = 0.f;
#pragma unroll
        for (int k = 0; k < 3; ++k) {
            const int s = r + (k - 1) * step; const float ok = (s >= lo && s < hi) ? 1.f : 0.f;
            float cv[8]; unpack8(rc[k], cv);
            const f32x4 w0 = *(const f32x4*)(m.sconv_w + k * 256 + 8 * cg) * ok, w1 = *(const f32x4*)(m.sconv_w + k * 256 + 8 * cg + 4) * ok;
#pragma unroll
            for (int j = 0; j < 4; ++j) { acc[j] += w0[j] * cv[j]; acc[4 + j] += w1[j] * cv[4 + j]; }
        }
        float bg[8]; unpack8(rb, bg);
        float ss = 0.f;
#pragma unroll
        for (int j = 0; j < 8; ++j) { acc[j] *= bg[j]; ss += acc[j] * acc[j]; }
        ss += __shfl_xor(ss, 1); ss += __shfl_xor(ss, 2); ss += __shfl_xor(ss, 4);
        const float hr = rsqrtf(ss * (1.0f / 64.0f) + EPS);
        const f32x4 g0 = *(const f32x4*)(m.g_mix + 256 + 8 * cg), g1 = *(const f32x4*)(m.g_mix + 256 + 8 * cg + 4);
        u32x4 o; o.x = cvt_pk_bf16(acc[0] * hr * g0[0], acc[1] * hr * g0[1]); o.y = cvt_pk_bf16(acc[2] * hr * g0[2], acc[3] * hr * g0[3]);
        o.z = cvt_pk_bf16(acc[4] * hr * g1[0], acc[5] * hr * g1[1]); o.w = cvt_pk_bf16(acc[6] * hr * g1[2], acc[7] * hr * g1[3]);
        *(u32x4*)(m.ybuf + (size_t)r * D + 256 + 8 * cg) = o;
    }
}
__device__ __forceinline__ void c_prep(LAS unsigned char* lds, int tid, const MixArgs& m) {
    LAS float* cwl = (LAS float*)(lds + CWL_OFF);
    for (int i = tid; i < 5 * LRU; i += NTHREADS) cwl[i] = i < 4 * LRU ? m.cw[i] : m.cb[i - 4 * LRU];
    __syncthreads();
}
__device__ __forceinline__ void c_summary_unit(LAS unsigned char* lds, int wave, int lane, int b, int p, const MixArgs& m) {
    const int ch0 = 64 * wave, fr = lane & 15, fq = lane >> 4, ch = ch0 + lane;
    LAS float* Xc = (LAS float*)(lds + wave * CW_BYTES);
    const LAS float* cwl = (const LAS float*)(lds + CWL_OFF);
    const int r0 = p < 4 ? ML + b * CTXL + 64 * p : b * SEQ + 64 * (p - 4);
    const int seq_lo = p < 4 ? ML + b * CTXL : b * SEQ, seq_hi = seq_lo + (p < 4 ? CTXL : SEQ);
    const int cl = ch0 + 8 * (lane & 7);
    const bf16_t* pcx = m.proj + P_CX + cl;
    {
        u32x4 raw[2][4];
        auto issue = [&](int blk) __attribute__((always_inline)) {
#pragma unroll
            for (int ps = 0; ps < 2; ++ps) { const int r = r0 + 16 * blk + ps * 8 + (lane >> 3);
#pragma unroll
                for (int k = 0; k < 4; ++k) { int s = r + k - 2; s = s < seq_lo ? seq_lo : (s >= seq_hi ? seq_hi - 1 : s); raw[ps][k] = *(const u32x4*)(pcx + (size_t)s * PW); } }
        };
        issue(0);
#pragma unroll 1
        for (int blk = 0; blk < 4; ++blk) {
#pragma unroll
            for (int ps = 0; ps < 2; ++ps) {
                const int tt = ps * 8 + (lane >> 3), r = r0 + 16 * blk + tt;
                const f32x4 b0 = *(const LAS f32x4*)(cwl + 4 * LRU + cl), b1 = *(const LAS f32x4*)(cwl + 4 * LRU + cl + 4);
                f32x2 a2[4] = {{b0[0], b0[1]}, {b0[2], b0[3]}, {b1[0], b1[1]}, {b1[2], b1[3]}};
#pragma unroll
                for (int k = 0; k < 4; ++k) { const int s = r + k - 2; const bool ok = (s >= seq_lo && s < seq_hi);
                    u32x4 rv = raw[ps][k]; if (!ok) rv = (u32x4){0u, 0u, 0u, 0u};
                    const f32x4 w0 = *(const LAS f32x4*)(cwl + k * LRU + cl), w1 = *(const LAS f32x4*)(cwl + k * LRU + cl + 4);
                    const f32x2 v0 = {__uint_as_float(rv.x << 16), __uint_as_float(rv.x & 0xffff0000u)}, v1 = {__uint_as_float(rv.y << 16), __uint_as_float(rv.y & 0xffff0000u)};
                    const f32x2 v2 = {__uint_as_float(rv.z << 16), __uint_as_float(rv.z & 0xffff0000u)}, v3 = {__uint_as_float(rv.w << 16), __uint_as_float(rv.w & 0xffff0000u)};
                    a2[0] = (f32x2){w0[0], w0[1]} * v0 + a2[0]; a2[1] = (f32x2){w0[2], w0[3]} * v1 + a2[1]; a2[2] = (f32x2){w1[0], w1[1]} * v2 + a2[2]; a2[3] = (f32x2){w1[2], w1[3]} * v3 + a2[3]; }
                *(LAS f32x4*)(Xc + (16 * blk + tt) * XS + 8 * (lane & 7)) = (f32x4){a2[0].x, a2[0].y, a2[1].x, a2[1].y};
                *(LAS f32x4*)(Xc + (16 * blk + tt) * XS + 8 * (lane & 7) + 4) = (f32x4){a2[2].x, a2[2].y, a2[3].x, a2[3].y};
            }
            if (blk < 3) issue(blk + 1);
        }
    }
#pragma unroll 1
    for (int dir = 0; dir < 2; ++dir) {
        bf16x8 fa[4][2], fx[4][2]; float bav[4], bxv[4], c1v[4];
        {
            const bf16_t* wA = m.gwt + ((size_t)((dir * 2 + 0) * 8 + wave) * 64 + fr) * 64 + 8 * fq;
            const bf16_t* wX = m.gwt + ((size_t)((dir * 2 + 1) * 8 + wave) * 64 + fr) * 64 + 8 * fq;
#pragma unroll
            for (int nt = 0; nt < 4; ++nt) {
#pragma unroll
                for (int ks = 0; ks < 2; ++ks) { fa[nt][ks] = *(const bf16x8*)(wA + (size_t)nt * 16 * 64 + 32 * ks); fx[nt][ks] = *(const bf16x8*)(wX + (size_t)nt * 16 * 64 + 32 * ks); }
                const int cc = ch0 + 16 * nt + fr;
                bav[nt] = m.gconst[(dir * 3 + 0) * LRU + cc]; bxv[nt] = m.gconst[(dir * 3 + 1) * LRU + cc]; c1v[nt] = m.gconst[(dir * 3 + 2) * LRU + cc];
            }
        }
        float Hn[4] = {0.f, 0.f, 0.f, 0.f}, Pn[4] = {1.f, 1.f, 1.f, 1.f};
        unsigned* abp = m.AB + ((size_t)dir * MA + r0) * LRU + ch0;
#pragma unroll 1
        for (int ib = 0; ib < 4; ++ib) {
            const int blk = dir == 0 ? ib : 3 - ib;
            bf16x8 xa[2];
#pragma unroll
            for (int ks = 0; ks < 2; ++ks) {
                const f32x4 lo4 = *(const LAS f32x4*)(Xc + (16 * blk + fr) * XS + 32 * ks + 8 * fq), hi4 = *(const LAS f32x4*)(Xc + (16 * blk + fr) * XS + 32 * ks + 8 * fq + 4);
                const unsigned p0 = cvt_pk_bf16(lo4[0], lo4[1]), p1 = cvt_pk_bf16(lo4[2], lo4[3]), p2 = cvt_pk_bf16(hi4[0], hi4[1]), p3 = cvt_pk_bf16(hi4[2], hi4[3]);
                xa[ks] = __builtin_bit_cast(bf16x8, (u32x4){p0, p1, p2, p3});
            }
#pragma unroll
            for (int nt = 0; nt < 4; ++nt) {
                f32x4 ga = (f32x4){0.f, 0.f, 0.f, 0.f}, gx = (f32x4){0.f, 0.f, 0.f, 0.f};
                float xcn[4];
#pragma unroll
                for (int j = 0; j < 4; ++j) xcn[j] = Xc[(16 * blk + 4 * fq + j) * XS + 16 * nt + fr];
#pragma unroll
                for (int ks = 0; ks < 2; ++ks) { ga = __builtin_amdgcn_mfma_f32_16x16x32_bf16(xa[ks], fa[nt][ks], ga, 0, 0, 0); gx = __builtin_amdgcn_mfma_f32_16x16x32_bf16(xa[ks], fx[nt][ks], gx, 0, 0, 0); }
                float av[4], bv[4];
#pragma unroll
                for (int j = 0; j < 4; j += 2) {
                    const f32x2 ea = (f32x2){ga[j], ga[j + 1]} + bav[nt], ex = (f32x2){gx[j], gx[j + 1]} + bxv[nt];
                    f32x2 ta = {fast_exp2(ea.x), fast_exp2(ea.y)}, tx = {fast_exp2(ex.x), fast_exp2(ex.y)}; ta = ta + 1.0f; tx = tx + 1.0f;
                    const f32x2 rr = {fast_rcp(ta.x), fast_rcp(ta.y)}, ii = {fast_rcp(tx.x), fast_rcp(tx.y)};
                    const f32x2 la = rr * c1v[nt]; const f32x2 a = {fast_exp2(la.x), fast_exp2(la.y)};
                    const f32x2 om = 1.0f - a * a;
                    const f32x2 mult = {__builtin_amdgcn_sqrtf(fmaxf(om.x, 0.f)), __builtin_amdgcn_sqrtf(fmaxf(om.y, 0.f))};
                    const f32x2 bb = mult * (ii * (f32x2){xcn[j], xcn[j + 1]});
                    av[j] = a.x; av[j + 1] = a.y; bv[j] = bb.x; bv[j + 1] = bb.y;
                }
                unsigned* abq = abp + (size_t)(16 * blk + 4 * fq) * LRU + 16 * nt + fr;
#pragma unroll
                for (int j = 0; j < 4; ++j) abq[(size_t)j * LRU] = cvt_pk_bf16(bv[j], 1.0f - av[j]);
                float Ac, Bc;
                { const bool bw = dir != 0;
                  const float a0 = bw ? av[3] : av[0], a1 = bw ? av[2] : av[1], a2 = bw ? av[1] : av[2], a3 = bw ? av[0] : av[3];
                  const float b0 = bw ? bv[3] : bv[0], b1 = bw ? bv[2] : bv[1], b2 = bw ? bv[1] : bv[2], b3 = bw ? bv[0] : bv[3];
                  Bc = a1 * b0 + b1; Ac = a0 * a1; Bc = a2 * Bc + b2; Ac *= a2; Bc = a3 * Bc + b3; Ac *= a3; }
#pragma unroll
                for (int st = 0; st < 2; ++st) {
                    const float Ap = __shfl_xor(Ac, 16 << st), Bp = __shfl_xor(Bc, 16 << st);
                    const bool mine_later = (((fq >> st) & 1) != 0) == (dir == 0);
                    const float Al = mine_later ? Ac : Ap, Bl = mine_later ? Bc : Bp, Ae = mine_later ? Ap : Ac, Be = mine_later ? Bp : Bc;
                    Ac = Al * Ae; Bc = Al * Be + Bl;
                }
                Hn[nt] = Ac * Hn[nt] + Bc; Pn[nt] *= Ac;
            }
        }
        if (fq == 0) {
#pragma unroll
            for (int nt = 0; nt < 4; ++nt) { const size_t o = ((size_t)(dir * NB + b) * NPOS + p) * LRU + ch0 + 16 * nt + fr; m.SA[o] = Pn[nt]; m.SB[o] = Hn[nt]; }
        }
    }
}
__device__ __forceinline__ void c_final_unit(LAS unsigned char* lds, int wave, int lane, int b, int p, const MixArgs& m, bool self_fold) {
    const int ch0 = 64 * wave, ch = ch0 + lane;
    LAS float* As = (LAS float*)(lds + wave * CW_BYTES);
    LAS bf16_t* hfb = (LAS bf16_t*)(lds + wave * CW_BYTES + 2 * 16 * XS * 4);
    const int r0 = p < 4 ? ML + b * CTXL + 64 * p : b * SEQ + 64 * (p - 4);
    float hf = 0.f, hb = 0.f;
    if (self_fold) {
        const float* sa0 = m.SA + (size_t)(0 * NB + b) * NPOS * LRU + ch; const float* sb0 = m.SB + (size_t)(0 * NB + b) * NPOS * LRU + ch;
        const float* sa1 = m.SA + (size_t)(1 * NB + b) * NPOS * LRU + ch; const float* sb1 = m.SB + (size_t)(1 * NB + b) * NPOS * LRU + ch;
        for (int j = 0; j < p; ++j) hf = sa0[(size_t)j * LRU] * hf + sb0[(size_t)j * LRU];
        for (int j = 3; j > p; --j) hb = sa1[(size_t)j * LRU] * hb + sb1[(size_t)j * LRU];
    } else {
        hf = m.CR[((size_t)(0 * NB + b) * NPOS + p) * LRU + ch]; hb = m.CR[((size_t)(1 * NB + b) * NPOS + p) * LRU + ch];
    }
    const unsigned* ab0 = m.AB + ((size_t)0 * MA + r0) * LRU + ch; const unsigned* ab1 = m.AB + ((size_t)1 * MA + r0) * LRU + ch;
    unsigned wf[64], wb[64];
#pragma unroll
    for (int t = 0; t < 64; ++t) wf[t] = ab0[(size_t)t * LRU];
#pragma unroll
    for (int t = 0; t < 64; ++t) wb[t] = ab1[(size_t)t * LRU];
#pragma unroll
    for (int t = 0; t < 64; ++t) { const float bb = __builtin_bit_cast(float, wf[t] << 16), om = __builtin_bit_cast(float, wf[t] & 0xffff0000u); hf = (1.0f - om) * hf + bb; hfb[t * 64 + lane] = f2bf(hf); }
    const f32x4 gm0 = *(const f32x4*)(m.g_mix + 512 + ch0 + 16 * (lane & 3)), gm1 = *(const f32x4*)(m.g_mix + 512 + ch0 + 16 * (lane & 3) + 4),
                gm2 = *(const f32x4*)(m.g_mix + 512 + ch0 + 16 * (lane & 3) + 8), gm3 = *(const f32x4*)(m.g_mix + 512 + ch0 + 16 * (lane & 3) + 12);
    const float gm[16] = {gm0[0], gm0[1], gm0[2], gm0[3], gm1[0], gm1[1], gm1[2], gm1[3], gm2[0], gm2[1], gm2[2], gm2[3], gm3[0], gm3[1], gm3[2], gm3[3]};
    u32x4 cgr[4][2];
#pragma unroll
    for (int blk = 0; blk < 4; ++blk) { const bf16_t* pg = m.proj + (size_t)(r0 + 16 * blk + (lane >> 2)) * PW + P_CG + ch0 + 16 * (lane & 3); cgr[blk][0] = *(const u32x4*)pg; cgr[blk][1] = *(const u32x4*)(pg + 8); }
#pragma unroll
    for (int blk = 3; blk >= 0; --blk) {
#pragma unroll
        for (int tt = 15; tt >= 0; --tt) { const unsigned w = wb[16 * blk + tt]; const float bb = __builtin_bit_cast(float, w << 16), om = __builtin_bit_cast(float, w & 0xffff0000u); hb = (1.0f - om) * hb + bb;
            As[tt * XS + lane] = hb + bf2f(hfb[(16 * blk + tt) * 64 + lane]); }
        {
            const int tt = lane >> 2, q = lane & 3, r = r0 + 16 * blk + tt;
            float ys[16], cg[16];
#pragma unroll
            for (int v4 = 0; v4 < 4; ++v4) { const f32x4 t4 = *(const LAS f32x4*)(As + tt * XS + 16 * q + 4 * v4); ys[4 * v4] = t4[0]; ys[4 * v4 + 1] = t4[1]; ys[4 * v4 + 2] = t4[2]; ys[4 * v4 + 3] = t4[3]; }
            { float t8[8]; unpack8(cgr[blk][0], t8);
#pragma unroll
              for (int j = 0; j < 8; ++j) cg[j] = t8[j];
              unpack8(cgr[blk][1], t8);
#pragma unroll
              for (int j = 0; j < 8; ++j) cg[8 + j] = t8[j]; }
            float ss = 0.f;
#pragma unroll
            for (int j = 0; j < 16; ++j) { ys[j] *= cg[j]; ss += ys[j] * ys[j]; }
            ss += __shfl_xor(ss, 1); ss += __shfl_xor(ss, 2);
            const float hr = rsqrtf(ss * (1.0f / 64.0f) + EPS);
            u32x4 o0, o1;
            o0.x = cvt_pk_bf16(ys[0] * hr * gm[0], ys[1] * hr * gm[1]); o0.y = cvt_pk_bf16(ys[2] * hr * gm[2], ys[3] * hr * gm[3]);
            o0.z = cvt_pk_bf16(ys[4] * hr * gm[4], ys[5] * hr * gm[5]); o0.w = cvt_pk_bf16(ys[6] * hr * gm[6], ys[7] * hr * gm[7]);
            o1.x = cvt_pk_bf16(ys[8] * hr * gm[8], ys[9] * hr * gm[9]); o1.y = cvt_pk_bf16(ys[10] * hr * gm[10], ys[11] * hr * gm[11]);
            o1.z = cvt_pk_bf16(ys[12] * hr * gm[12], ys[13] * hr * gm[13]); o1.w = cvt_pk_bf16(ys[14] * hr * gm[14], ys[15] * hr * gm[15]);
            bf16_t* yo = m.ybuf + (size_t)r * D + 512 + ch0 + 16 * q;
            *(u32x4*)yo = o0; *(u32x4*)(yo + 8) = o1;
        }
    }
}
__device__ __forceinline__ void carry_task(int gid, const MixArgs& m) {
    const int ch = gid & 511, dir = (gid >> 9) & 1, b = gid >> 10;
    const float* sa = m.SA + (size_t)(dir * NB + b) * NPOS * LRU + ch; const float* sb = m.SB + (size_t)(dir * NB + b) * NPOS * LRU + ch;
    float* cr = m.CR + (size_t)(dir * NB + b) * NPOS * LRU + ch;
    float h = 0.f;
    if (dir == 0) {
#pragma unroll 33
        for (int p = 0; p < NPOS; ++p) { const float a = sa[(size_t)p * LRU], bb = sb[(size_t)p * LRU]; cr[(size_t)p * LRU] = h; h = a * h + bb; }
    } else {
#pragma unroll
        for (int p = 3; p >= 0; --p) { const float a = sa[(size_t)p * LRU], bb = sb[(size_t)p * LRU]; cr[(size_t)p * LRU] = h; h = a * h + bb; }
#pragma unroll 32
        for (int p = NPOS - 1; p >= 4; --p) { const float a = sa[(size_t)p * LRU], bb = sb[(size_t)p * LRU]; cr[(size_t)p * LRU] = h; h = a * h + bb; }
    }
}
constexpr int REP_CS = 1, REP_B = 1, REP_CF = 1;
__device__ __forceinline__ void mix_phase(LAS unsigned char* lds, int tid, int wave, int lane, int G, const MixArgs& m, int n_a_units, unsigned* ctr) {
    const int nC = NB * NPOS, total = nC + n_a_units;
    volatile LAS int* nxt = (volatile LAS int*)(lds + LDS_BYTES - 32);
    c_prep(lds, tid, m);
    int u = blockIdx.x;
#pragma unroll 1
    for (int rep = 0; rep < REP_CS; ++rep) {
#pragma unroll 1
        while (u < nC) {
            if (tid == 0) *nxt = G + (int)__hip_atomic_fetch_add(ctr, 1u, __ATOMIC_RELAXED, __HIP_MEMORY_SCOPE_AGENT);
            c_summary_unit(lds, wave, lane, u / NPOS, u % NPOS, m);
            __syncthreads();
            u = *nxt;
            __syncthreads();
        }
        if (rep + 1 < REP_CS) u = blockIdx.x;
    }
#pragma unroll 1
    while (u < total) {
        if (tid == 0) *nxt = G + (int)__hip_atomic_fetch_add(ctr, 1u, __ATOMIC_RELAXED, __HIP_MEMORY_SCOPE_AGENT);
        a_unit(lds, tid, u - nC, m);
        u = *nxt;
        __syncthreads();
    }
}
__device__ __forceinline__ void carry_phase(LAS unsigned char* lds, int tid, int wave, int lane, int G, const MixArgs& m, int ctx_too, int n_b_units) {
    if (blockIdx.x < 8) carry_task((int)blockIdx.x * NTHREADS + tid, m);
    else if (ctx_too && blockIdx.x < 24) { const int u = (int)blockIdx.x - 8; c_final_unit(lds, wave, lane, u >> 2, u & 3, m, true); }
#pragma unroll 1
    for (int rep = 0; rep < REP_B; ++rep)
#pragma unroll 1
    for (int u = (int)((blockIdx.x + G - 24) % G); u < n_b_units; u += G) b_unit(tid, u, m);
}
__device__ __forceinline__ void cfin_phase(LAS unsigned char* lds, int tid, int wave, int lane, int G, const MixArgs& m) {
    const int nC = NB * (NPOS - 4);
#pragma unroll 1
    for (int rep = 0; rep < REP_CF; ++rep)
#pragma unroll 1
    for (int u = blockIdx.x; u < nC; u += G) c_final_unit(lds, wave, lane, u / (NPOS - 4), 4 + u % (NPOS - 4), m, false);
}

constexpr int CW_WQ = 2048;
constexpr int CW_CNT = 1024;
constexpr size_t EXP_STRIDE = (size_t)(2 * DFF * D + D * DFF);
constexpr size_t EXP_W2_OFF = (size_t)2 * DFF * D;
constexpr size_t RT_E = 0;
constexpr size_t RT_P = 256 * 1024;
constexpr size_t RT_POS = 512 * 1024;
constexpr size_t RT_IDX = 1024 * 1024;
constexpr int MAXT = 264;
constexpr size_t WS_Y = WS_HBUF;
constexpr size_t WS_H8MOE = WS_BIG + 66 * MiB;

typedef int i32x2 __attribute__((ext_vector_type(2)));

template <bool ROUTE, int OUTM  >
__device__ __forceinline__ void norm_phase(LAS unsigned char* lds, int tid, int wave, int lane, int G, const float* xl, const float* xc, const float* g, const float* modv_l, int sh_off, int sc_off,
                                           bf16_t* out, int rows, const float* wr, const float* br, unsigned* ctl, unsigned char* route, float* rsc = nullptr, bool nt_x = false, const bf16_t* xs16 = nullptr,
                                           int first_block = 0, int nblocks = 0, int row_lo = 0) {
    LAS float* wrT = (LAS float*)lds;
    LAS unsigned* lcnt = (LAS unsigned*)(lds + 32768);
    if (ROUTE) {
        for (int i = tid; i < D * NE; i += NTHREADS) wrT[(i & 7) * D + (i >> 3)] = wr[i];
        if (tid < 32) lcnt[tid] = 0u;
        __syncthreads();
    }
    const int gw = ((int)blockIdx.x - first_block) * NWAVES + wave, NGW = (nblocks ? nblocks : G) * NWAVES;
    const int rpw = (rows + NGW - 1) / NGW;
    const int rbeg0 = gw * rpw, rbeg = row_lo + (rbeg0 < rows ? rbeg0 : rows), rend = row_lo + ((rbeg0 + rpw < rows) ? rbeg0 + rpw : rows);
    int cur_mod = -1; f32x4 Gv[4], Sv[4];
    int my_e0 = 0, my_e1 = 0, my_l0 = 0, my_l1 = 0; float my_p0 = 0.f, my_p1 = 0.f;
#pragma unroll 1
    for (int row = rbeg; row < rend; ++row) {
        const int mr = row_modidx(row);
        if (mr != cur_mod) { cur_mod = mr; const float* mv = modv_l + (size_t)mr * 6144;
#pragma unroll
            for (int j = 0; j < 4; ++j) { const int c = 4 * lane + 256 * j; const f32x4 gg = *(const f32x4*)(g + c), sc = *(const f32x4*)(mv + sc_off + c); Gv[j] = gg * (sc + 1.0f); Sv[j] = *(const f32x4*)(mv + sh_off + c); } }
        const float* xr = row < ML ? xl + (size_t)row * D : xc + (size_t)(row - ML) * D;
        f32x4 v[4]; float ss = 0.f;
#pragma unroll
        for (int j = 0; j < 4; ++j) {
            if (xs16) { const u32x2 r = *(const u32x2*)(xs16 + (size_t)row * D + 4 * lane + 256 * j); v[j][0] = __builtin_bit_cast(float, r.x << 16); v[j][1] = __builtin_bit_cast(float, r.x & 0xffff0000u); v[j][2] = __builtin_bit_cast(float, r.y << 16); v[j][3] = __builtin_bit_cast(float, r.y & 0xffff0000u); }
            else v[j] = nt_x ? __builtin_nontemporal_load((const f32x4*)(xr + 4 * lane + 256 * j)) : *(const f32x4*)(xr + 4 * lane + 256 * j);
            ss += (v[j][0] * v[j][0] + v[j][1] * v[j][1]) + (v[j][2] * v[j][2] + v[j][3] * v[j][3]); }
        ss = wave_sum(ss);
        const float rstd = rsqrtf(ss * (1.0f / D) + EPS);
#pragma unroll
        for (int j = 0; j < 4; ++j) { v[j] = (v[j] * rstd) * Gv[j] + Sv[j];
            if (OUTM == 1) *(unsigned*)((unsigned char*)out + (size_t)row * D + 4 * lane + 256 * j) = pg8::pack4_fp8(v[j][0], v[j][1], v[j][2], v[j][3]);
            else if (OUTM == 0) { u32x2 o; o.x = cvt_pk_bf16(v[j][0], v[j][1]); o.y = cvt_pk_bf16(v[j][2], v[j][3]); *(u32x2*)(out + (size_t)row * D + 4 * lane + 256 * j) = o; } }
        if (OUTM == 2) {
            float am = 0.f;
#pragma unroll
            for (int j = 0; j < 4; ++j) am = fmaxf(am, fmaxf(fmaxf(fabsf(v[j][0]), fabsf(v[j][1])), fmaxf(fabsf(v[j][2]), fabsf(v[j][3]))));
#pragma unroll
            for (int o = 1; o < 64; o <<= 1) am = fmaxf(am, __shfl_xor(am, o));
            am = fmaxf(am, 1e-20f);
            const float qs = 127.0f / am;
#pragma unroll
            for (int j = 0; j < 4; ++j) { const int q0 = (int)__builtin_rintf(v[j][0] * qs), q1 = (int)__builtin_rintf(v[j][1] * qs), q2 = (int)__builtin_rintf(v[j][2] * qs), q3 = (int)__builtin_rintf(v[j][3] * qs);
                *(unsigned*)((unsigned char*)out + (size_t)row * D + 4 * lane + 256 * j) = (unsigned)(q0 & 0xff) | ((unsigned)(q1 & 0xff) << 8) | ((unsigned)(q2 & 0xff) << 16) | ((unsigned)(q3 & 0xff) << 24); }
            if (lane == 0) rsc[row] = am * (1.0f / 127.0f);
        }
        if (ROUTE) {
            float lg[NE];
#pragma unroll
            for (int e = 0; e < NE; ++e) { float a = 0.f;
#pragma unroll
                for (int j = 0; j < 4; ++j) { const f32x4 w4 = *(const LAS f32x4*)(wrT + e * D + 4 * lane + 256 * j); a += (v[j][0] * w4[0] + v[j][1] * w4[1]) + (v[j][2] * w4[2] + v[j][3] * w4[3]); }
                lg[e] = wave_sum(a) + br[e]; }
            int i0 = 0; float v0 = lg[0];
#pragma unroll
            for (int e = 1; e < NE; ++e) if (lg[e] > v0) { v0 = lg[e]; i0 = e; }
            int i1 = 0; float v1 = -3.0e38f;
#pragma unroll
            for (int e = 0; e < NE; ++e) if (e != i0 && lg[e] > v1) { v1 = lg[e]; i1 = e; }
            const float e1 = __expf(v1 - v0), p0 = 1.0f / (1.0f + e1), p1 = e1 / (1.0f + e1);
            if (lane == row - rbeg) {
                my_e0 = i0; my_e1 = i1; my_p0 = p0; my_p1 = p1;
                my_l0 = (int)__hip_atomic_fetch_add(lcnt + i0, 1u, __ATOMIC_RELAXED, __HIP_MEMORY_SCOPE_WORKGROUP);
                my_l1 = (int)__hip_atomic_fetch_add(lcnt + i1, 1u, __ATOMIC_RELAXED, __HIP_MEMORY_SCOPE_WORKGROUP);
            }
        }
    }
    if (ROUTE) {
        __syncthreads();
        if (tid < 8) { const unsigned n = lcnt[tid]; lcnt[16 + tid] = n ? __hip_atomic_fetch_add(ctl + CW_CNT + tid * 64, n, __ATOMIC_RELAXED, __HIP_MEMORY_SCOPE_AGENT) : 0u; }
        __syncthreads();
        const int row = rbeg + lane;
        if (row < rend) {
            const int pos0 = (int)lcnt[16 + my_e0] + my_l0, pos1 = (int)lcnt[16 + my_e1] + my_l1;
            ((i32x2*)(route + RT_E))[row] = (i32x2){my_e0, my_e1};
            ((f32x2*)(route + RT_P))[row] = (f32x2){my_p0, my_p1};
            ((i32x2*)(route + RT_POS))[row] = (i32x2){pos0, pos1};
            int* ridx = (int*)(route + RT_IDX);
            ridx[(size_t)my_e0 * ML + pos0] = row;
            ridx[(size_t)my_e1 * ML + pos1] = row;
        }
    }
}

struct MoeTiles { int toff[9]; };
__device__ __forceinline__ void moe_tiles(const unsigned* ctl, MoeTiles& t) {
    int acc = 0;
#pragma unroll
    for (int e = 0; e < 8; ++e) { const int c = (int)__builtin_amdgcn_readfirstlane(__hip_atomic_load(ctl + CW_CNT + e * 64, __ATOMIC_RELAXED, __HIP_MEMORY_SCOPE_AGENT)); t.toff[e] = acc; acc += (c + 255) >> 8; }
    t.toff[8] = acc;
}
namespace pg8 {
struct MoeUpSched {
    static constexpr bool GATHER = true;
    Order o; MoeTiles t; const char* hb; const char* wmoe; const int* ridx; const unsigned* cntp; size_t tstepB;
    __device__ __forceinline__ void init(const void* hbuf8, const unsigned char* wmoe_, const int* ridx_, const unsigned* ctl, int G, int c) {
        moe_tiles(ctl, t); o.init(t.toff[8], (2 * DFF) / BM, G, c); cntp = ctl + CW_CNT; hb = (const char*)hbuf8; wmoe = (const char*)wmoe_; ridx = ridx_; tstepB = (size_t)BM * D; }
    __device__ __forceinline__ bool next(int i, Unit& u) const {
        if (!o.lin(i, u.pm, u.pn)) return false;
        int e = 0, ts = 0;
#pragma unroll
        for (int k = 1; k < 8; ++k) if (u.pm >= t.toff[k]) { e = k; ts = t.toff[k]; }
        u.e = e; u.rb = (u.pm - ts) * BM; u.cnt = (int)cntp[e * 64];
        u.a = hb; u.b = wmoe + (size_t)e * EXP_STRIDE + (size_t)u.pn * tstepB; return true;
    }
    __device__ __forceinline__ unsigned arow(const Unit& u, int r) const { const int idx = u.rb + r; return (unsigned)ridx[(size_t)u.e * ML + (idx < u.cnt ? idx : 0)]; }
    __device__ __forceinline__ void idx_dma(const Unit& u, LAS unsigned char* slot, int lane) const {
        __builtin_amdgcn_global_load_lds((const unsigned*)(ridx + (size_t)u.e * ML + u.rb + lane * 4), (LAS unsigned*)slot, 16, 0, 0); }
    __device__ __forceinline__ unsigned arow_lds(const Unit& u, int r, const LAS int* ix) const { return (unsigned)ix[(u.rb + r < u.cnt) ? r : 0]; }
    __device__ __forceinline__ void a_ready(const Unit&) const {}
    __device__ __forceinline__ void done(const Unit&) const {}
};
struct MoeDownSched {
    static constexpr bool GATHER = false;
    Order o; MoeTiles t; const char* H; const char* wmoe; size_t tstep;
    __device__ __forceinline__ void init(const void* Hc, const unsigned char* wmoe_, const unsigned* ctl, int G, int c) {
        moe_tiles(ctl, t); o.init(t.toff[8], D / BM, G, c); H = (const char*)Hc; wmoe = (const char*)wmoe_; tstep = (size_t)BM * DFF; }
    __device__ __forceinline__ bool next(int i, Unit& u) const {
        if (!o.lin(i, u.pm, u.pn)) return false;
        u.pm = t.toff[8] - 1 - u.pm;
        int e = 0;
#pragma unroll
        for (int k = 1; k < 8; ++k) if (u.pm >= t.toff[k]) e = k;
        u.e = e; u.rb = 0; u.cnt = 0;
        u.a = H + (size_t)u.pm * tstep; u.b = wmoe + (size_t)e * EXP_STRIDE + EXP_W2_OFF + (size_t)u.pn * tstep; return true;
    }
    __device__ __forceinline__ unsigned arow(const Unit&, int r) const { return (unsigned)r; }
    __device__ __forceinline__ void a_ready(const Unit&) const {}
    __device__ __forceinline__ void done(const Unit&) const {}
};
}

__device__ __forceinline__ void final_phase(int wave, int lane, int G, float* x, const bf16_t* x16, const bf16_t* Y, const float* gt2  , const float* g_final, const unsigned* ctl, const unsigned char* route) {
    MoeTiles t; moe_tiles(ctl, t);
    const int gw = blockIdx.x * NWAVES + wave, NGW = G * NWAVES;
    const int rpw = (ML + NGW - 1) / NGW;
    const int rbeg = gw * rpw, rend = (rbeg + rpw < ML) ? rbeg + rpw : ML;
    f32x4 gf[4];
#pragma unroll
    for (int j = 0; j < 4; ++j) gf[j] = *(const f32x4*)(g_final + 4 * lane + 256 * j);
#pragma unroll 1
    for (int row = rbeg; row < rend; ++row) {
        const i32x2 ee = ((const i32x2*)(route + RT_E))[row]; const f32x2 pp = ((const f32x2*)(route + RT_P))[row]; const i32x2 ps = ((const i32x2*)(route + RT_POS))[row];
        int t0 = 0, t1 = 0;
#pragma unroll
        for (int k = 1; k < 8; ++k) { if (ee[0] >= k) t0 = t.toff[k]; if (ee[1] >= k) t1 = t.toff[k]; }
        const bf16_t* y0 = Y + ((size_t)t0 * 256 + ps[0]) * D; const bf16_t* y1 = Y + ((size_t)t1 * 256 + ps[1]) * D;
        const float* gt = gt2 + (size_t)(row / SEQ) * 6144;
        f32x4 v[4]; float ss = 0.f;
#pragma unroll
        for (int j = 0; j < 4; ++j) {
            const int c = 4 * lane + 256 * j;
            const u32x2 xr_ = *(const u32x2*)(x16 + (size_t)row * D + c); f32x4 xv; xv[0] = __builtin_bit_cast(float, xr_.x << 16); xv[1] = __builtin_bit_cast(float, xr_.x & 0xffff0000u); xv[2] = __builtin_bit_cast(float, xr_.y << 16); xv[3] = __builtin_bit_cast(float, xr_.y & 0xffff0000u);
            const f32x4 gv = *(const f32x4*)(gt + c);
            const u32x2 a = *(const u32x2*)(y0 + c), b2 = *(const u32x2*)(y1 + c);
            f32x4 ya, yb;
            ya[0] = __builtin_bit_cast(float, a.x << 16); ya[1] = __builtin_bit_cast(float, a.x & 0xffff0000u); ya[2] = __builtin_bit_cast(float, a.y << 16); ya[3] = __builtin_bit_cast(float, a.y & 0xffff0000u);
            yb[0] = __builtin_bit_cast(float, b2.x << 16); yb[1] = __builtin_bit_cast(float, b2.x & 0xffff0000u); yb[2] = __builtin_bit_cast(float, b2.y << 16); yb[3] = __builtin_bit_cast(float, b2.y & 0xffff0000u);
            v[j] = xv + gv * (ya * pp[0] + yb * pp[1]);
            ss += (v[j][0] * v[j][0] + v[j][1] * v[j][1]) + (v[j][2] * v[j][2] + v[j][3] * v[j][3]);
        }
        ss = wave_sum(ss);
        const float rstd = rsqrtf(ss * (1.0f / D) + EPS);
#pragma unroll
        for (int j = 0; j < 4; ++j) *(f32x4*)(x + (size_t)row * D + 4 * lane + 256 * j) = (v[j] * rstd) * gf[j];
    }
}

__device__ __forceinline__ void mod_task(LAS unsigned char* lds, int tid, int wave, int lane, int task, const float* c, const float* c_ctx, const float* w_mod, const float* b_mod, float* modv) {
    LAS float* sl = (LAS float*)lds;
    LAS float* red = (LAS float*)(lds + 20480);
    for (int i = tid; i < 5 * D; i += NTHREADS) { const float v = i < 4 * D ? c[i] : c_ctx[i - 4 * D]; sl[i] = v / (1.0f + __expf(-v)); }
    __syncthreads();
    const int l = task / 96, n = (task % 96) * 64 + lane;
    const float* w = w_mod + (size_t)l * D * 6144 + n;
    float acc[5] = {0.f, 0.f, 0.f, 0.f, 0.f};
#pragma unroll 16
    for (int kk = 0; kk < 128; ++kk) { const int k = wave * 128 + kk; const float wv = w[(size_t)k * 6144];
#pragma unroll
        for (int r = 0; r < 5; ++r) acc[r] += sl[r * D + k] * wv; }
#pragma unroll
    for (int r = 0; r < 5; ++r) red[(wave * 5 + r) * 64 + lane] = acc[r];
    __syncthreads();
    if (tid < 320) { const int r = tid >> 6, ln = tid & 63; float s = 0.f;
#pragma unroll
        for (int w8 = 0; w8 < 8; ++w8) s += red[(w8 * 5 + r) * 64 + ln];
        const int nn = (task % 96) * 64 + ln; modv[((size_t)l * 5 + r) * 6144 + nn] = s + b_mod[l * 6144 + nn]; }
    __syncthreads();
}

constexpr unsigned DUPMASK = 0u;
constexpr int CW_BAR = 4096;
#define XB_TMO      128
#define XB_XCNT(j)  (256  + 64 * (j))
#define XB_XSUB(j)  (1280 + 64 * (j))
#define XB_XGEN(j)  (2304 + 64 * (j))
#define XB_TOP      3328
#define XB_TOPGEN   3392
#define XCD_BAR_WORDS 3456
#define XB_SPIN_CAP (1u << 18)

__device__ __forceinline__ unsigned xb_ld(unsigned* p)              { return __hip_atomic_load(p, __ATOMIC_RELAXED, __HIP_MEMORY_SCOPE_AGENT); }
__device__ __forceinline__ unsigned xb_add(unsigned* p, unsigned v) { return __hip_atomic_fetch_add(p, v, __ATOMIC_RELAXED, __HIP_MEMORY_SCOPE_AGENT); }
__device__ __forceinline__ unsigned xb_xcc_id() { return (unsigned)__builtin_amdgcn_s_getreg((3 << 11) | 20) & 0xFu; }
#define XB_SPIN(cond, bar) do { unsigned _sp = 0; while (cond) { __builtin_amdgcn_s_sleep(1); \
    if ((++_sp & 255u) == 0u) { if (xb_ld(&(bar)[XB_TMO])) break; if (_sp > XB_SPIN_CAP) { atomicAdd(&(bar)[XB_TMO], 1u); break; } } } } while (0)

struct XcdBarrier {
    unsigned* bar; unsigned x;
    volatile LAS unsigned* st;
};

__device__ __forceinline__ XcdBarrier xcd_barrier_post(unsigned* bar, volatile LAS unsigned* st) {
    XcdBarrier b; b.bar = bar; b.x = xb_xcc_id(); b.st = st;
    if (threadIdx.x == 0) (void)xb_add(&bar[XB_XCNT(b.x)], 1u);
    return b;
}
__device__ __forceinline__ void xcd_barrier_complete(unsigned* bar, unsigned x, unsigned& nloc, unsigned& nx) {
    const unsigned G = gridDim.x * gridDim.y * gridDim.z;
    unsigned sum, cnt, mine, sp = 0u;
    for (;;) {
        sum = 0u; cnt = 0u; mine = 0u;
#pragma unroll
        for (unsigned j = 0; j < 16; ++j) { const unsigned c = xb_ld(&bar[XB_XCNT(j)]); sum += c; cnt += (c > 0u) ? 1u : 0u; mine = (j == x) ? c : mine; }
        if (sum == G) break;
        __builtin_amdgcn_s_sleep(1);
        if ((++sp & 255u) == 0u) { if (xb_ld(&bar[XB_TMO])) break; if (sp > XB_SPIN_CAP) { atomicAdd(&bar[XB_TMO], 1u); break; } }
    }
    nloc = mine > 0u ? mine : 1u; nx = cnt > 0u ? cnt : 1u;
}

__device__ __forceinline__ void xcd_barrier(const XcdBarrier& b) {
    asm volatile("s_waitcnt vmcnt(0)" ::: "memory");
    __syncthreads();
    if (threadIdx.x == 0) {
        unsigned* bar = b.bar;
        __builtin_amdgcn_s_waitcnt(0);
        unsigned nloc = b.st[0], nx = b.st[1];
        if (nloc == 0u) { xcd_barrier_complete(bar, b.x, nloc, nx); b.st[0] = nloc; b.st[1] = nx; }
        const unsigned old = xb_add(&bar[XB_XSUB(b.x)], 1u);
        const unsigned gen = old / nloc;
        if (old + 1u == (gen + 1u) * nloc) {
            __builtin_amdgcn_fence(__ATOMIC_RELEASE, "agent");
            asm volatile("s_waitcnt vmcnt(0)" ::: "memory");
            const unsigned og = xb_add(&bar[XB_TOP], 1u);
            const unsigned tg = og / nx;
            if (og + 1u == (tg + 1u) * nx) xb_add(&bar[XB_TOPGEN], 1u);
            else XB_SPIN(xb_ld(&bar[XB_TOPGEN]) == tg, bar);
            __builtin_amdgcn_fence(__ATOMIC_ACQUIRE, "agent");
            xb_add(&bar[XB_XGEN(b.x)], 1u);
            asm volatile("s_waitcnt vmcnt(0)" ::: "memory");
        } else {
            XB_SPIN(xb_ld(&bar[XB_XGEN(b.x)]) == gen, bar);
            __builtin_amdgcn_fence(__ATOMIC_ACQUIRE, "agent");
            asm volatile("s_waitcnt vmcnt(0)" ::: "memory");
        }
    }
    __syncthreads();
}


__device__ __forceinline__ void transpose_item8(const float* W, int K, int N, unsigned char* WT, int mode, LAS float* scr, int item, int lane) {
    const int nblk = N / 32, kb = item / nblk, nb = item % nblk, k0 = 64 * kb, n0 = 32 * nb;
    const int drow0 = (mode == 0) ? n0 : (mode == 3 ? win_row(n0) : (256 * (n0 >> 7) + (n0 & 127) + (mode == 2 ? 128 : 0)));
    {
        f32x4 v[8];
#pragma unroll
        for (int i = 0; i < 8; ++i) v[i] = __builtin_nontemporal_load((const f32x4*)(W + (size_t)(k0 + 8 * i + (lane >> 3)) * N + n0 + 4 * (lane & 7)));
#pragma unroll
        for (int i = 0; i < 8; ++i) { LAS float* d = scr + (8 * i + (lane >> 3)) * 33 + 4 * (lane & 7);
#pragma unroll
            for (int j = 0; j < 4; ++j) d[j] = v[i][j] * FP8_SW; }
    }
    asm volatile("s_waitcnt lgkmcnt(0)" ::: "memory");
    const int c = lane & 7;
#pragma unroll
    for (int j = 0; j < 4; ++j) { const int n = (lane >> 3) + 8 * j; const LAS float* q = scr + (8 * c) * 33 + n;
        u32x2 o; o.x = pg8::pack4_fp8(q[0 * 33], q[1 * 33], q[2 * 33], q[3 * 33]); o.y = pg8::pack4_fp8(q[4 * 33], q[5 * 33], q[6 * 33], q[7 * 33]);
        *(u32x2*)(WT + (size_t)(drow0 + n) * K + k0 + 8 * c) = o; }
    asm volatile("s_waitcnt lgkmcnt(0)" ::: "memory");
}

__device__ __forceinline__ void quant_rows_i8(const bf16_t* W, unsigned char* Q, float* scale, int nrows, int gw, int NGW, int lane) {
#pragma unroll 1
    for (int r = gw; r < nrows; r += NGW) {
        const u32x4 a = *(const u32x4*)(W + (size_t)r * D + 16 * lane), b = *(const u32x4*)(W + (size_t)r * D + 16 * lane + 8);
        float v[16]; { float t[8]; unpack8(a, t);
#pragma unroll
            for (int j = 0; j < 8; ++j) v[j] = t[j];
            unpack8(b, t);
#pragma unroll
            for (int j = 0; j < 8; ++j) v[8 + j] = t[j]; }
        float am = 0.f;
#pragma unroll
        for (int j = 0; j < 16; ++j) am = fmaxf(am, fabsf(v[j]));
#pragma unroll
        for (int o = 1; o < 64; o <<= 1) am = fmaxf(am, __shfl_xor(am, o));
        am = fmaxf(am, 1e-30f);
        const float qs = 127.0f / am;
        unsigned w[4];
#pragma unroll
        for (int g4 = 0; g4 < 4; ++g4) { const int q0 = (int)__builtin_rintf(v[4 * g4] * qs), q1 = (int)__builtin_rintf(v[4 * g4 + 1] * qs), q2 = (int)__builtin_rintf(v[4 * g4 + 2] * qs), q3 = (int)__builtin_rintf(v[4 * g4 + 3] * qs);
            w[g4] = (unsigned)(q0 & 0xff) | ((unsigned)(q1 & 0xff) << 8) | ((unsigned)(q2 & 0xff) << 16) | ((unsigned)(q3 & 0xff) << 24); }
        *(u32x4*)(Q + (size_t)r * D + 16 * lane) = (u32x4){w[0], w[1], w[2], w[3]};
        if (lane == 0) scale[r] = am * (1.0f / 127.0f);
    }
}

constexpr int CW_TEAM = 3200;
__device__ __forceinline__ void team_barrier(unsigned* ctr, unsigned n, int tid) {
    asm volatile("s_waitcnt vmcnt(0)" ::: "memory");
    __syncthreads();
    if (tid == 0) {
        __builtin_amdgcn_fence(__ATOMIC_RELEASE, "agent");
        asm volatile("s_waitcnt vmcnt(0)" ::: "memory");
        (void)__hip_atomic_fetch_add(ctr, 1u, __ATOMIC_RELAXED, __HIP_MEMORY_SCOPE_AGENT);
        unsigned sp = 0;
        while (__hip_atomic_load(ctr, __ATOMIC_RELAXED, __HIP_MEMORY_SCOPE_AGENT) < n) { __builtin_amdgcn_s_sleep(2); if (++sp > (1u << 20)) break; }
        __builtin_amdgcn_fence(__ATOMIC_ACQUIRE, "agent");
        asm volatile("s_waitcnt vmcnt(0)" ::: "memory");
    }
    __syncthreads();
}

struct Args { const float* in[32]; float* out; unsigned char* ws; int ph_lo, ph_hi; };

enum Phase { PH_PRO = 0, PH_NORM1_L0, PH_WIN_L0, PH_MIX_L0, PH_CARRY_L0, PH_CFIN_L0, PH_WOUT_L0, PH_NORM2_L0, PH_FFNUP, PH_FFNDOWN,
             PH_NORM1_L1, PH_WIN_L1, PH_MIX_L1, PH_CARRY_L1, PH_CFIN_L1, PH_WOUT_L1, PH_NORM2_L1, PH_MOE_UP, PH_MOE_DOWN, PH_FINAL, PH_COUNT };

constexpr int I_IN = (D / 64) * (WIN / 32), I_OUT = (D / 64) * (D / 32), I_13 = (D / 64) * (DFF / 32), I_2 = (DFF / 64) * (D / 32), I_E = 2 * I_13 + I_2;
constexpr int CONV_Q0 = I_IN;
constexpr int CONV_DENSE_END = 2 * I_IN + 2 * I_OUT + 2 * I_13 + I_2;
constexpr int CONV_TOTAL = CONV_DENSE_END + NE * I_E;
constexpr int CW_CQ = 3072;
__device__ __forceinline__ void conv_item(const float* const* in, unsigned char* ws, int r, LAS float* scr, int lane) {
    if (r < 2 * I_IN) { const int l = r / I_IN; if (WIN8) transpose_item8(in[8] + (size_t)l * D * WIN, D, WIN, ws + WS_WIN + (size_t)l * WIN * D, 0, scr, r % I_IN, lane); else transpose_item(in[8] + (size_t)l * D * WIN, D, WIN, (bf16_t*)(ws + WS_WIN) + (size_t)l * WIN * D, 3, scr, r % I_IN, lane); return; } r -= 2 * I_IN;
    if (r < 2 * I_OUT) { const int l = r / I_OUT; transpose_item(in[22] + (size_t)l * D * D, D, D, (bf16_t*)(ws + WS_WOUT) + (size_t)l * D * D, 0, scr, r % I_OUT, lane); return; } r -= 2 * I_OUT;
    if (r < I_13) { if (DENSE_UP8) transpose_item8(in[23], D, DFF, ws + WS_W13, 1, scr, r, lane); else transpose_item(in[23], D, DFF, (bf16_t*)(ws + WS_W13), 1, scr, r, lane); return; } r -= I_13;
    if (r < I_13) { if (DENSE_UP8) transpose_item8(in[24], D, DFF, ws + WS_W13, 2, scr, r, lane); else transpose_item(in[24], D, DFF, (bf16_t*)(ws + WS_W13), 2, scr, r, lane); return; } r -= I_13;
    if (r < I_2) { if (DENSE_DOWN8) transpose_item8(in[25], DFF, D, ws + WS_W2, 0, scr, r, lane); else transpose_item(in[25], DFF, D, (bf16_t*)(ws + WS_W2), 0, scr, r, lane); return; } r -= I_2;
    { const int e = r / I_E; int q = r % I_E; unsigned char* eb = ws + WS_WMOE + (size_t)e * EXP_STRIDE;
      if (q < I_13) { transpose_item8(in[28] + (size_t)e * D * DFF, D, DFF, eb, 1, scr, q, lane); return; } q -= I_13;
      if (q < I_13) { transpose_item8(in[29] + (size_t)e * D * DFF, D, DFF, eb, 2, scr, q, lane); return; } q -= I_13;
      transpose_item8(in[30] + (size_t)e * DFF * D, DFF, D, eb + EXP_W2_OFF, 0, scr, q, lane); }
}
__device__ __forceinline__ void conv_static(const float* const* in, unsigned char* ws, int lo, int hi, int first_block, int G, LAS unsigned char* lds, int wave, int lane) {
    if ((int)blockIdx.x < first_block) return;
    LAS float* scr = (LAS float*)(lds + wave * 16384);
    const int rank = ((int)blockIdx.x - first_block) * NWAVES + wave, stride = (G - first_block) * NWAVES;
#pragma unroll 1
    for (int it = lo + rank; it < hi; it += stride) conv_item(in, ws, it, scr, lane);
}

constexpr int CQ_CH = 2 * NWAVES, CQ_NCHUNK = (NE * I_E) / CQ_CH, CW_CQ2 = 7552, CW_DONE = 8064;
static_assert((NE * I_E) % CQ_CH == 0 && CQ_NCHUNK % 8 == 0, "conversion chunks");
__device__ __forceinline__ void conv_pull(const float* const* in, unsigned char* ws, unsigned* ctl, LAS unsigned char* lds, int tid, int wave, int lane, unsigned* done_ctr, unsigned done_target) {
    LAS float* scr = (LAS float*)(lds + wave * 16384);
    volatile LAS int* slot = (volatile LAS int*)(lds + LDS_BYTES - 64);
    const int x = (int)blockIdx.x & 7;
#pragma unroll 1
    for (;;) {
        __syncthreads();
        if (tid == 0) {
            int c = -1;
            const bool stop = done_ctr != nullptr && __hip_atomic_load(done_ctr, __ATOMIC_RELAXED, __HIP_MEMORY_SCOPE_AGENT) >= done_target;
            if (!stop) { const unsigned j = __hip_atomic_fetch_add(ctl + CW_CQ2 + x * 64, 1u, __ATOMIC_RELAXED, __HIP_MEMORY_SCOPE_AGENT); if (j < (unsigned)(CQ_NCHUNK / 8)) c = (int)(j * 8u) + x; }
            *slot = c;
        }
        __syncthreads();
        const int c = *slot;
        if (c < 0) break;
#pragma unroll 1
        for (int k = 0; k < CQ_CH / NWAVES; ++k) conv_item(in, ws, CONV_DENSE_END + c * CQ_CH + k * NWAVES + wave, scr, lane);
    }
}

__global__ void __launch_bounds__(NTHREADS, 2) fwd(Args args) {
    extern __shared__ __attribute__((aligned(16))) unsigned char lds_raw[];
    LAS unsigned char* lds = (LAS unsigned char*)lds_raw;
    const int tid = threadIdx.x, lane = tid & 63, wave = __builtin_amdgcn_readfirstlane(tid >> 6);
    const int G = gridDim.x;
    unsigned char* ws = args.ws;
    const int lo = args.ph_lo, hi = args.ph_hi;
#ifdef ONLY_PHASE
#define IN(k) ((k) == ONLY_PHASE && lo <= (k) && (k) < hi)
#else
#define IN(k) (lo <= (k) && (k) < hi)
#endif
    float* xl = args.out; float* xctx = (float*)(ws + WS_XCTX);
    float* modv = (float*)(ws + WS_MODV);
    unsigned* ctl = (unsigned*)(ws + WS_CTL);
    unsigned char* route = ws + WS_ROUTE;
    bf16_t* hbuf = (bf16_t*)(ws + WS_HBUF);
    bf16_t* proj = (bf16_t*)(ws + WS_BIG);
    unsigned char* H8 = ws + WS_BIG;
    bf16_t* Yb = (bf16_t*)(ws + WS_Y);
    unsigned char* H8m = ws + WS_H8MOE;
    bf16_t* x16 = (bf16_t*)(ws + WS_X16);
    volatile LAS unsigned* xb_st = (volatile LAS unsigned*)(lds + LDS_BYTES - 16);
    if (tid == 0) { xb_st[0] = 0u; xb_st[1] = 0u; xb_st[2] = 0u; xb_st[3] = 0u; }
    __syncthreads();
    XcdBarrier bar = xcd_barrier_post(ctl + CW_BAR, xb_st);
#define SEAM(k) if (IN(k) && IN((k) + 1)) xcd_barrier(bar);
#define REP(k) for (int rep_ = 0, nrep_ = ((DUPMASK >> (k)) & 1u) ? 2 : 1; rep_ < nrep_; ++rep_, (rep_ < nrep_ ? xcd_barrier(bar) : (void)0))

    if (IN(PH_PRO)) REP(PH_PRO) {
        if (blockIdx.x < 192) mod_task(lds, tid, wave, lane, (int)blockIdx.x, args.in[1], args.in[3], args.in[4], args.in[5], modv);
        LAS float* scr = (LAS float*)(lds + wave * 16384);
        const int gw = blockIdx.x * NWAVES + wave, NGW = G * NWAVES;
#pragma unroll 1
        for (int it = gw; it < CONV_DENSE_END; it += NGW) conv_item(args.in, ws, it, scr, lane);
        bf16_t* gwt = (bf16_t*)(ws + WS_LRUW);
        for (int i = blockIdx.x * NTHREADS + tid; i < 2 * 2 * 2 * 8 * 4096; i += G * NTHREADS) {
            const int k = i & 63, n = (i >> 6) & 63, h = (i >> 12) & 7, mat = (i >> 15) & 1, dir = (i >> 16) & 1, l = i >> 17;
            const float* src = (mat == 0 ? args.in[16] : args.in[18]) + ((size_t)((l * 2 + dir) * 8 + h) * 64 + k) * 64 + n;
            gwt[i] = f2bf(-LOG2E * *src);
        }
        float* gconst = (float*)(ws + WS_GCONST);
        for (int i = blockIdx.x * NTHREADS + tid; i < 2 * 2 * 3 * LRU; i += G * NTHREADS) {
            const int c = i & 511, which = (i >> 9) % 3, ld = (i >> 9) / 3;
            float v;
            if (which == 0) v = -LOG2E * args.in[17][ld * LRU + c];
            else if (which == 1) v = -LOG2E * args.in[19][ld * LRU + c];
            else { const float L = args.in[20][ld * LRU + c]; v = 8.0f * LOG2E * (fminf(L, 0.f) - log1pf(__expf(-fabsf(L)))); }
            gconst[i] = v;
        }
    }
#define GEMM_WIN(l) { constexpr int KB = WIN8 ? D : 2 * D; pg8::DenseSched S; S.init(hbuf, ws + WS_WIN + (size_t)(l) * WIN * KB, MA, WIN, KB, G, (int)blockIdx.x); \
        pg8::EpiProjFused E{proj}; pg8::gemm_phase<WIN8>(lds, KB, S, E); }
#define TAILFILL(k) { if (tid == 0) (void)__hip_atomic_fetch_add(ctl + CW_DONE + (k) * 16, 1u, __ATOMIC_RELAXED, __HIP_MEMORY_SCOPE_AGENT); \
        conv_pull(args.in, ws, ctl, lds, tid, wave, lane, ctl + CW_DONE + (k) * 16, (unsigned)G); }
#define GEMM_WIN_I8(l) { pg8::DenseSched S; S.init(hbuf, ws + WS_WINQ + (size_t)(l) * WIN * D, MA, WIN, D, G, (int)blockIdx.x); \
        pg8::EpiProjFusedI8 E{proj, (const float*)(ws + WS_RS1), (const float*)(ws + WS_WINQS) + (l) * WIN}; pg8::gemm_phase<2>(lds + 4096, D, S, E); }
#define MIXARGS(l) MixArgs m; m.proj = proj; m.ybuf = hbuf; m.conf_w = args.in[9] + (l) * CONFK * 256; m.conf_b = args.in[10] + (l) * 256; m.ln_g = args.in[11] + (l) * 256; m.ln_b = args.in[12] + (l) * 256; \
        m.sconv_w = args.in[13] + (l) * 3 * 256; m.g_mix = args.in[21] + (l) * D; m.cw = args.in[14] + (l) * 4 * LRU; m.cb = args.in[15] + (l) * LRU; \
        m.gwt = (const bf16_t*)(ws + WS_LRUW) + (size_t)(l) * 2 * 2 * 8 * 4096; m.gconst = (const float*)(ws + WS_GCONST) + (l) * 2 * 3 * LRU; \
        m.SA = (float*)(ws + WS_SUMM); m.SB = (float*)(ws + WS_SUMM) + 2 * NB * NPOS * LRU; m.CR = (float*)(ws + WS_CR); m.AB = (unsigned*)(ws + WS_BIG + 116 * MiB);
    SEAM(PH_PRO)
    if (IN(PH_NORM1_L0)) REP(PH_NORM1_L0) { norm_phase<false, WINI8_L0 ? 2 : (WIN8 ? 1 : 0)>(lds, tid, wave, lane, G, args.in[0], args.in[2], args.in[6], modv, M_SH1, M_SC1, hbuf, MA, nullptr, nullptr, ctl, route, (float*)(ws + WS_RS1), true);
        if (DENSE_UPI8) quant_rows_i8((const bf16_t*)(ws + WS_W13), ws + WS_W13Q, (float*)(ws + WS_W13QS), 2 * DFF, (int)blockIdx.x * NWAVES + wave, G * NWAVES, lane);
        if (WINI8_L0) quant_rows_i8((const bf16_t*)(ws + WS_WIN), ws + WS_WINQ, (float*)(ws + WS_WINQS), WIN, (int)blockIdx.x * NWAVES + wave, G * NWAVES, lane);
        if (WINI8_L1) quant_rows_i8((const bf16_t*)(ws + WS_WIN) + (size_t)WIN * D, ws + WS_WINQ + (size_t)WIN * D, (float*)(ws + WS_WINQS) + WIN, WIN, (int)blockIdx.x * NWAVES + wave, G * NWAVES, lane); }
    SEAM(PH_NORM1_L0)
    if (IN(PH_WIN_L0)) REP(PH_WIN_L0) { if constexpr (WINI8_L0) GEMM_WIN_I8(0) else GEMM_WIN(0) TAILFILL(0) }
    SEAM(PH_WIN_L0)
    if (IN(PH_MIX_L0)) REP(PH_MIX_L0) { MIXARGS(0) mix_phase(lds, tid, wave, lane, G, m, MA / 32, ctl + CW_WQ); }
    SEAM(PH_MIX_L0)
    if (IN(PH_CARRY_L0)) REP(PH_CARRY_L0) { MIXARGS(0) carry_phase(lds, tid, wave, lane, G, m, 1, MA / 64); }
    SEAM(PH_CARRY_L0)
    if (IN(PH_CFIN_L0)) REP(PH_CFIN_L0) { MIXARGS(0) cfin_phase(lds, tid, wave, lane, G, m); }
    SEAM(PH_CFIN_L0)
    if (IN(PH_WOUT_L0)) REP(PH_WOUT_L0) { pg8::DenseSched S; S.init(hbuf, (const bf16_t*)(ws + WS_WOUT), ML, D, 2 * D, G, (int)blockIdx.x);
        pg8::EpiRes16<true> E{args.in[0], args.in[2], x16, modv + M_GT1, 1.0f, 0}; pg8::gemm_phase<false>(lds, 2 * D, S, E); }
    SEAM(PH_WOUT_L0)
    if (IN(PH_NORM2_L0)) {
        constexpr int OM = DENSE_UPI8 ? 2 : (DENSE_UP8 ? 1 : 0);
        if (blockIdx.x < 16) {
            { pg8::DenseSched S; S.init(hbuf, (const bf16_t*)(ws + WS_WOUT), MC, D, 2 * D, 16, (int)blockIdx.x, ML / 256);
              pg8::EpiRes16<true> E{args.in[0], args.in[2], x16, modv + M_GT1, 1.0f, 0}; pg8::gemm_phase<false>(lds, 2 * D, S, E); }
            team_barrier(ctl + CW_TEAM, 16u, tid);
            norm_phase<false, OM>(lds, tid, wave, lane, G, xl, xctx, args.in[7], modv, M_SH2, M_SC2, hbuf, MC, nullptr, nullptr, ctl, route, (float*)(ws + WS_RS), false, x16, 0, 16, ML);
        } else norm_phase<false, OM>(lds, tid, wave, lane, G, xl, xctx, args.in[7], modv, M_SH2, M_SC2, hbuf, ML, nullptr, nullptr, ctl, route, (float*)(ws + WS_RS), false, x16, 16, G - 16, 0);
        TAILFILL(4)
    }
    SEAM(PH_NORM2_L0)
    if (IN(PH_FFNUP)) REP(PH_FFNUP) {
        if constexpr (DENSE_UPI8) { pg8::DenseSched S; S.init(hbuf, ws + WS_W13Q, MA, 2 * DFF, D, G, (int)blockIdx.x);
            pg8::EpiSwigluI8<DENSE_DOWN8> E{(void*)H8, DFF, (const float*)(ws + WS_RS), (const float*)(ws + WS_W13QS)}; pg8::gemm_phase<2>(lds + 4096, D, S, E); }
        else { constexpr int KB = DENSE_UP8 ? D : 2 * D; pg8::DenseSched S; S.init(hbuf, ws + WS_W13, MA, 2 * DFF, KB, G, (int)blockIdx.x);
        if constexpr (DENSE_DOWN8) { pg8::EpiSwiglu8 E{H8, DFF, DENSE_UP8 ? 1.0f / FP8_SW : 1.0f, FP8_SH}; pg8::gemm_phase<DENSE_UP8>(lds, KB, S, E); }
        else { pg8::EpiSwiglu E{(bf16_t*)H8, DFF, DENSE_UP8 ? 1.0f / FP8_SW : 1.0f}; pg8::gemm_phase<DENSE_UP8>(lds, KB, S, E); } }
        TAILFILL(2) }
    SEAM(PH_FFNUP)
    if (IN(PH_FFNDOWN)) REP(PH_FFNDOWN) { constexpr int KB = DENSE_DOWN8 ? DFF : 2 * DFF; pg8::DenseSched S; S.init(H8, ws + WS_W2, ML, D, KB, G, (int)blockIdx.x);
        pg8::EpiRes16<false> E{nullptr, nullptr, x16, modv + M_GT2, DENSE_DOWN8 ? 1.0f / (FP8_SW * FP8_SH) : 1.0f, 0}; pg8::gemm_phase<DENSE_DOWN8>(lds, KB, S, E); }
    SEAM(PH_FFNDOWN)
    if (IN(PH_NORM1_L1)) {
        if (blockIdx.x < 16) {
            { constexpr int KB = DENSE_DOWN8 ? DFF : 2 * DFF; pg8::DenseSched S; S.init(H8, ws + WS_W2, MC, D, KB, 16, (int)blockIdx.x, ML / 256);
              pg8::EpiRes16<false> E{nullptr, nullptr, x16, modv + M_GT2, DENSE_DOWN8 ? 1.0f / (FP8_SW * FP8_SH) : 1.0f, 0}; pg8::gemm_phase<DENSE_DOWN8>(lds, KB, S, E); }
            team_barrier(ctl + CW_TEAM + 64, 16u, tid);
            norm_phase<false, WINI8_L1 ? 2 : (WIN8 ? 1 : 0)>(lds, tid, wave, lane, G, xl, xctx, args.in[6] + D, modv + 5 * 6144, M_SH1, M_SC1, hbuf, MC, nullptr, nullptr, ctl, route, (float*)(ws + WS_RS1), false, x16, 0, 16, ML);
        } else {
            norm_phase<false, WINI8_L1 ? 2 : (WIN8 ? 1 : 0)>(lds, tid, wave, lane, G, xl, xctx, args.in[6] + D, modv + 5 * 6144, M_SH1, M_SC1, hbuf, ML, nullptr, nullptr, ctl, route, (float*)(ws + WS_RS1), false, x16, 16, G - 16, 0);
        }
        TAILFILL(3)
    }
    SEAM(PH_NORM1_L1)
    if (IN(PH_WIN_L1)) REP(PH_WIN_L1) { if constexpr (WINI8_L1) GEMM_WIN_I8(1) else GEMM_WIN(1) TAILFILL(1) }
    SEAM(PH_WIN_L1)
    if (IN(PH_MIX_L1)) REP(PH_MIX_L1) { MIXARGS(1) mix_phase(lds, tid, wave, lane, G, m, ML / 32, ctl + CW_WQ + 64); }
    SEAM(PH_MIX_L1)
    if (IN(PH_CARRY_L1)) REP(PH_CARRY_L1) { MIXARGS(1) carry_phase(lds, tid, wave, lane, G, m, 0, ML / 64); }
    SEAM(PH_CARRY_L1)
    if (IN(PH_CFIN_L1)) REP(PH_CFIN_L1) { MIXARGS(1) cfin_phase(lds, tid, wave, lane, G, m); }
    SEAM(PH_CFIN_L1)
    if (IN(PH_WOUT_L1)) REP(PH_WOUT_L1) { pg8::DenseSched S; S.init(hbuf, (const bf16_t*)(ws + WS_WOUT) + (size_t)D * D, ML, D, 2 * D, G, (int)blockIdx.x);
        pg8::EpiRes16<false> E{nullptr, nullptr, x16, modv + 5 * 6144 + M_GT1, 1.0f, 0}; pg8::gemm_phase<false>(lds, 2 * D, S, E); }
    SEAM(PH_WOUT_L1)
    if (IN(PH_NORM2_L1)) REP(PH_NORM2_L1) { norm_phase<true, 1>(lds, tid, wave, lane, G, xl, xctx, args.in[7] + D, modv + 5 * 6144, M_SH2, M_SC2, hbuf, ML, args.in[26], args.in[27], ctl, route, nullptr, false, x16);
        conv_pull(args.in, ws, ctl, lds, tid, wave, lane, nullptr, 0u); }
    SEAM(PH_NORM2_L1)
    if (IN(PH_MOE_UP)) REP(PH_MOE_UP) { pg8::MoeUpSched S; S.init(hbuf, ws + WS_WMOE, (const int*)(route + RT_IDX), ctl, G, (int)blockIdx.x);
        pg8::EpiSwiglu8 E{H8m, DFF, 1.0f / FP8_SW, FP8_SH}; pg8::gemm_phase<true>(lds + 2048, D, S, E); }
    SEAM(PH_MOE_UP)
    if (IN(PH_MOE_DOWN)) REP(PH_MOE_DOWN) { pg8::MoeDownSched S; S.init(H8m, ws + WS_WMOE, ctl, G, (int)blockIdx.x);
        pg8::EpiBf16Store E{Yb, D, 1.0f / (FP8_SW * FP8_SH)}; pg8::gemm_phase<true>(lds, DFF, S, E); }
    SEAM(PH_MOE_DOWN)
    if (IN(PH_FINAL)) REP(PH_FINAL) final_phase(wave, lane, G, xl, x16, Yb, modv + 5 * 6144 + M_GT2, args.in[31], ctl, route);
#undef IN
}

static_assert(CW_CQ2 >= CW_BAR + XCD_BAR_WORDS && CW_CQ2 + 8 * 64 <= CW_DONE && (CW_DONE + 8 * 16) * 4 <= 32 * 1024 && (CW_BAR + XCD_BAR_WORDS) * 4 <= 32 * 1024 && (CW_TEAM + 3 * 64) < CW_BAR && CW_CQ < CW_TEAM && (CW_WQ + 128) <= CW_CQ && (CW_CNT + 8 * 64) <= CW_WQ, "control words inside the per-call memset");
extern "C" void kernel_launch(void* const* d_in, const int* in_sizes, int n_in, void* d_out, int out_size, void* d_ws, size_t ws_size, hipStream_t stream) {
    static int grid = 0;
    if (grid == 0) {
        int dev = 0, cus = 0; (void)hipGetDevice(&dev); (void)hipDeviceGetAttribute(&cus, hipDeviceAttributeMultiprocessorCount, dev);
        (void)hipFuncSetAttribute((const void*)fwd, hipFuncAttributeMaxDynamicSharedMemorySize, LDS_BYTES);
        int per_cu = 0;
        (void)hipOccupancyMaxActiveBlocksPerMultiprocessor(&per_cu, (const void*)fwd, NTHREADS, LDS_BYTES);
        grid = cus > 0 ? cus : 256;
        if (per_cu < 1) fprintf(stderr, "kernel_launch: occupancy query reports %d blocks per CU\n", per_cu);
    }
    Args a{};
    for (int i = 0; i < 32; ++i) a.in[i] = (const float*)d_in[i];
    a.out = (float*)d_out; a.ws = (unsigned char*)d_ws;
    (void)hipMemsetAsync((char*)d_ws + WS_CTL, 0, 32 * 1024, stream);
#ifdef MULTI_LAUNCH
    for (int ph = 0; ph < PH_COUNT; ++ph) { a.ph_lo = ph; a.ph_hi = ph + 1; hipLaunchKernelGGL(fwd, dim3(grid), dim3(NTHREADS), LDS_BYTES, stream, a); }
#else
    a.ph_lo = 0; a.ph_hi = PH_COUNT; hipLaunchKernelGGL(fwd, dim3(grid), dim3(NTHREADS), LDS_BYTES, stream, a);
#endif
}
```

```cpp
#include <hip/hip_runtime.h>
#include <stdint.h>
#include <cstdio>

constexpr int D = 1024, NB = 4, SEQ = 8192, CTXL = 256, GW = 64;
constexpr int ML = NB * SEQ;
constexpr int MC = NB * CTXL;
constexpr int MA = ML + MC;
constexpr int WIN = 2304, DFF = 2816, NE = 8, LRU = 512;
constexpr int CONFK = 31;
constexpr float EPS = 1e-6f;
constexpr int C_AVAL = 0, C_AGATE = 256, C_SBG = 512, C_SCG = 768, C_SX = 1024, C_CX = 1280, C_CG = 1792;
constexpr int PW = 1792, P_GLU = 0, P_V = 256, P_SBG = 512, P_CX = 768, P_CG = 1280;
constexpr int M_SH1 = 0, M_SC1 = 1024, M_GT1 = 2048, M_SH2 = 3072, M_SC2 = 4096, M_GT2 = 5120;

typedef unsigned short bf16_t;
typedef short bf16x8 __attribute__((ext_vector_type(8)));
typedef float f32x4 __attribute__((ext_vector_type(4)));
typedef float f32x2 __attribute__((ext_vector_type(2)));

__device__ __forceinline__ bf16_t f2bf(float f) { unsigned u = __builtin_bit_cast(unsigned, f); return (bf16_t)((u + 0x7fffu + ((u >> 16) & 1u)) >> 16); }
__device__ __forceinline__ float bf2f(bf16_t b) { return __builtin_bit_cast(float, ((unsigned)b) << 16); }
__device__ __forceinline__ float sigmoidf_(float x) { return 1.0f / (1.0f + __expf(-x)); }
__device__ __forceinline__ float siluf_(float x) { return x * sigmoidf_(x); }
__device__ __forceinline__ float gelu_tanh(float x) { const float u = 0.7978845608028654f * (x + 0.044715f * x * x * x); return 0.5f * x * (1.0f + tanhf(u)); }
template <int CTRL> __device__ __forceinline__ float dpp_f(float v) { return __builtin_bit_cast(float, __builtin_amdgcn_update_dpp(0, __builtin_bit_cast(int, v), CTRL, 0xf, 0xf, true)); }
__device__ __forceinline__ float sum4(float v) { v += dpp_f<0xB1>(v); v += dpp_f<0x4E>(v); return v; }
__device__ __forceinline__ float sum8(float v) { v = sum4(v); v += dpp_f<0x141>(v); return v; }
__device__ __forceinline__ float sum16(float v) { v = sum8(v); v += dpp_f<0x140>(v); return v; }
__device__ __forceinline__ float rl_f(float v, int l) { return __builtin_bit_cast(float, __builtin_amdgcn_readlane(__builtin_bit_cast(int, v), l)); }
__device__ __forceinline__ float wave_sum(float v) { v = sum16(v); return (rl_f(v, 0) + rl_f(v, 16)) + (rl_f(v, 32) + rl_f(v, 48)); }
__device__ __forceinline__ float wave_max(float v) {
    v = fmaxf(v, dpp_f<0xB1>(v)); v = fmaxf(v, dpp_f<0x4E>(v)); v = fmaxf(v, dpp_f<0x141>(v)); v = fmaxf(v, dpp_f<0x140>(v));
    return fmaxf(fmaxf(rl_f(v, 0), rl_f(v, 16)), fmaxf(rl_f(v, 32), rl_f(v, 48)));
}

__device__ __forceinline__ int row_modidx(int r) { return r < ML ? r / SEQ : 4; }


#define LAS __attribute__((address_space(3)))
typedef unsigned u32x4 __attribute__((ext_vector_type(4)));
typedef unsigned u32x2 __attribute__((ext_vector_type(2)));
typedef int v4i_t __attribute__((ext_vector_type(4)));
typedef int v8i_t __attribute__((ext_vector_type(8)));
constexpr int NWAVES = 8, NTHREADS = 512;
constexpr int LDS_BYTES = 160 * 1024;

__device__ __forceinline__ unsigned cvt_pk_bf16(float lo, float hi) { unsigned r; asm volatile("v_cvt_pk_bf16_f32 %0, %1, %2" : "=v"(r) : "v"(lo), "v"(hi)); return r; }
__device__ __forceinline__ float fast_silu(float x) { return x * __builtin_amdgcn_rcpf(1.0f + __expf(-x)); }

constexpr float FP8_SW = 64.0f, FP8_SH = 8.0f;
namespace pg8 {
constexpr int BM = 256, BK = 64, HALF = 128, HTB = HALF * BK * 2, STAGE_BYTES = 8 * HTB, NXCD = 8, WGM = 4;
__device__ __forceinline__ int lds_byte(int r, int c) { const int st = (r >> 4) * 2 + (c >> 5), rr = r & 15, cc = c & 31, ob = rr * 64 + cc * 2; return st * 1024 + (ob ^ (((ob >> 9) & 1) << 5)); }
__device__ __forceinline__ void stage_rc(int b, int& R, int& C) { const int st = b / 1024, sb = b % 1024, swz = sb ^ (((sb >> 9) & 1) << 5); R = (st >> 1) * 16 + swz / 64; C = (st & 1) * 32 + (swz % 64) / 2; }
__device__ __forceinline__ int perm32(int rho) { const int n = rho >> 4, i = rho & 15; return 8 * (i >> 2) + 4 * n + (i & 3); }

constexpr int SC_OFF = -4096;
constexpr int IDX_OFF = -2048;
struct Unit { int pm, pn; const char* a; const char* b; int e, rb, cnt; };

struct Order {
    int nM, nN, nwg, G, c;
    __device__ __forceinline__ void init(int nM_, int nN_, int G_, int c_) { nM = nM_; nN = nN_; nwg = nM * nN; G = G_; c = c_; }
    __device__ __forceinline__ bool lin(int i, int& pm, int& pn) const {
        const long L = (long)i * G + c; if (L >= nwg) return false;
        int wgid = (int)L; { const int q = nwg / NXCD, r = nwg % NXCD, xcd = wgid % NXCD, off = wgid / NXCD; wgid = (xcd < r ? xcd * (q + 1) : r * (q + 1) + (xcd - r) * q) + off; }
        const int nig = WGM * nN, gid = wgid / nig, fm = gid * WGM, gsz = (nM - fm) < WGM ? (nM - fm) : WGM;
        pm = fm + ((wgid % nig) % gsz); pn = (wgid % nig) / gsz; return true;
    }
};
struct DenseSched {
    static constexpr bool GATHER = false;
    Order o; const char* A; const char* Bt; size_t tstep; int pm_off;
    __device__ __forceinline__ void init(const void* A_, const void* Bt_, int M, int N, int KB, int G, int c, int pm_off_ = 0) { o.init(M / BM, N / BM, G, c); A = (const char*)A_; Bt = (const char*)Bt_; tstep = (size_t)BM * KB; pm_off = pm_off_; }
    __device__ __forceinline__ bool next(int i, Unit& u) const { if (!o.lin(i, u.pm, u.pn)) return false; u.pm += pm_off; u.a = A + (size_t)u.pm * tstep; u.b = Bt + (size_t)u.pn * tstep; u.e = 0; u.rb = 0; u.cnt = 0; return true; }
    __device__ __forceinline__ unsigned arow(const Unit&, int r) const { return (unsigned)r; }
    __device__ __forceinline__ void a_ready(const Unit&) const {}
    __device__ __forceinline__ void done(const Unit&) const {}
};

template <int MODE> struct AccT { typedef f32x4 type; };
template <> struct AccT<2> { typedef v4i_t type; };
template <int MODE, class Epi, class Sched>
__device__ __forceinline__ void gemm_phase(LAS unsigned char* lds, const int KB, const Sched& S, const Epi& E) {
    const int tid = threadIdx.x, wid = __builtin_amdgcn_readfirstlane(tid >> 6), lane = tid & 63, wr = wid >> 2, wc = wid & 3, fr = lane & 15, fq = lane >> 4;
    const int nt = KB / (BK * 2);
    int sR[2], sC[2]; unsigned voffB[2];
#pragma unroll
    for (int i = 0; i < 2; ++i) { stage_rc(tid * 16 + i * 8192, sR[i], sC[i]); const int Rb = Epi::PERM ? ((sR[i] & ~31) + perm32(sR[i] & 31)) : sR[i]; voffB[i] = (unsigned)(Rb * KB) + (unsigned)sC[i] * 2u; }
    const size_t kstep = (size_t)(BK * 2);
    const size_t hstep = (size_t)HALF * KB;
    const unsigned ldsw = (unsigned)wid * 1024u;
    const int aoff = lds_byte(wr * 64 + fr, fq * 8), boff = lds_byte(wc * 32 + fr, fq * 8);
#define PG8_SA(b, h) (((b) * 2 + (h)) * HTB)
#define PG8_SB(b, h) ((4 + (b) * 2 + (h)) * HTB)
#define PG8_STAGE(bufoff, gbase, voff) do { _Pragma("unroll") for (int _i = 0; _i < 2; ++_i) \
        __builtin_amdgcn_global_load_lds((const unsigned*)((const char*)(gbase) + (voff)[_i]), (LAS unsigned*)(lds + (bufoff) + ldsw + _i * 8192), 16, 0, 0); } while (0)
#define PG8_LDA(dst, b, h) do { _Pragma("unroll") for (int m = 0; m < 4; ++m) _Pragma("unroll") for (int k = 0; k < 2; ++k) dst[m][k] = *(const LAS bf16x8*)(lds + PG8_SA(b, h) + aoff + m * 2048 + k * 1024); } while (0)
#define PG8_LDB(dst, b, h) do { _Pragma("unroll") for (int n = 0; n < 2; ++n) _Pragma("unroll") for (int k = 0; k < 2; ++k) dst[n][k] = *(const LAS bf16x8*)(lds + PG8_SB(b, h) + boff + n * 2048 + k * 1024); } while (0)
#define PG8_MMA(ai, bj, At, Bt) do { __builtin_amdgcn_s_setprio(1); _Pragma("unroll") for (int m = 0; m < 4; ++m) _Pragma("unroll") for (int n = 0; n < 2; ++n) { \
        if constexpr (MODE == 1) { const v8i_t b8 = __builtin_shufflevector(__builtin_bit_cast(v4i_t, Bt[n][0]), __builtin_bit_cast(v4i_t, Bt[n][1]), 0, 1, 2, 3, 4, 5, 6, 7), a8 = __builtin_shufflevector(__builtin_bit_cast(v4i_t, At[m][0]), __builtin_bit_cast(v4i_t, At[m][1]), 0, 1, 2, 3, 4, 5, 6, 7); \
            asm volatile("v_mfma_scale_f32_16x16x128_f8f6f4 %0, %1, %2, %0, %3, %3 op_sel_hi:[0,0,0]" : "+v"(acc[ai][bj][m][n]) : "v"(b8), "v"(a8), "v"(fp8_one)); } \
        else if constexpr (MODE == 2) { _Pragma("unroll") for (int k = 0; k < 2; ++k) acc[ai][bj][m][n] = __builtin_amdgcn_mfma_i32_16x16x64_i8(__builtin_bit_cast(v4i_t, Bt[n][k]), __builtin_bit_cast(v4i_t, At[m][k]), acc[ai][bj][m][n], 0, 0, 0); } \
        else { _Pragma("unroll") for (int k = 0; k < 2; ++k) acc[ai][bj][m][n] = __builtin_amdgcn_mfma_f32_16x16x32_bf16(Bt[n][k], At[m][k], acc[ai][bj][m][n], 0, 0, 0); } } \
        __builtin_amdgcn_s_setprio(0); } while (0)
#define PG8_WAIT_V(n) asm volatile("s_waitcnt vmcnt(" #n ")" ::: "memory")
#define PG8_WAIT_L(n) asm volatile("s_waitcnt lgkmcnt(" #n ")" ::: "memory")
#define PG8_BAR __builtin_amdgcn_s_barrier()
#define PG8_SCHED __builtin_amdgcn_sched_barrier(0)
    const int fp8_one = 0x7f7f7f7f;
    Unit cur, nxt; int ui = 0;
    if (!S.next(0, cur)) return;
    typedef typename AccT<MODE>::type acc_t;
    acc_t acc[2][2][4][2];
#pragma unroll
    for (int a = 0; a < 2; ++a)
#pragma unroll
        for (int b = 0; b < 2; ++b)
#pragma unroll
            for (int m = 0; m < 4; ++m)
#pragma unroll
                for (int n = 0; n < 2; ++n) acc[a][b][m][n] = (acc_t){0, 0, 0, 0};
    bf16x8 At[4][2], B0[2][2], B1[2][2];
    unsigned vA0[2], vA1[2], vA0n[2], vA1n[2];
#pragma unroll
    for (int i = 0; i < 2; ++i) {
        vA0[i] = S.arow(cur, sR[i]) * (unsigned)KB + (unsigned)sC[i] * 2u;
        vA1[i] = S.arow(cur, HALF + sR[i]) * (unsigned)KB + (unsigned)sC[i] * 2u;
        vA0n[i] = vA0[i]; vA1n[i] = vA1[i];
    }
    const char* cA = cur.a; const char* cB = cur.b;
    S.a_ready(cur);
    PG8_STAGE(PG8_SB(0, 0), cB, voffB); PG8_STAGE(PG8_SB(0, 1), cB + hstep, voffB); PG8_STAGE(PG8_SA(0, 0), cA, vA0); PG8_STAGE(PG8_SA(0, 1), cA, vA1);
    if (wr == 1) PG8_BAR;
    PG8_WAIT_V(2); PG8_BAR;
    PG8_STAGE(PG8_SB(1, 0), cB + kstep, voffB); PG8_STAGE(PG8_SA(1, 0), cA + kstep, vA0); PG8_STAGE(PG8_SB(1, 1), cB + hstep + kstep, voffB);
    PG8_WAIT_V(6); PG8_BAR;
    for (;;) {
        const bool has_next = S.next(ui + 1, nxt);
        const char* nA = has_next ? nxt.a : cA; const char* nB = has_next ? nxt.b : cB;
        if constexpr (Epi::SCALES) { if (wid < 2) E.dma(cur, lds + SC_OFF + (ui & 1) * 2048, wid, lane); }
        if constexpr (Sched::GATHER) {
            if (has_next && wid == 0) S.idx_dma(nxt, lds + IDX_OFF + ((ui + 1) & 1) * 1024, lane);
        }
#pragma unroll 1
        for (int t = 0; t < nt; t += 2) {
            const bool last = (t == nt - 2);
            const char* a1 = cA + (size_t)(t + 1) * kstep;
            const char* a2 = last ? nA : cA + (size_t)(t + 2) * kstep; const char* b2 = last ? nB : cB + (size_t)(t + 2) * kstep;
            const char* a3 = a2 + kstep; const char* b3 = b2 + kstep;
            if constexpr (Sched::GATHER) {
                if (last && has_next) {
                    const LAS int* ix = (const LAS int*)(lds + IDX_OFF + ((ui + 1) & 1) * 1024);
#pragma unroll
                    for (int i = 0; i < 2; ++i) {
                        vA0n[i] = S.arow_lds(nxt, sR[i], ix) * (unsigned)KB + (unsigned)sC[i] * 2u;
                        vA1n[i] = S.arow_lds(nxt, HALF + sR[i], ix) * (unsigned)KB + (unsigned)sC[i] * 2u;
                    }
                }
            }
            unsigned w0[2], w1[2];
#pragma unroll
            for (int i = 0; i < 2; ++i) { w0[i] = (Sched::GATHER && last) ? vA0n[i] : vA0[i]; w1[i] = (Sched::GATHER && last) ? vA1n[i] : vA1[i]; }
            if (last && has_next) S.a_ready(nxt);
            PG8_LDB(B0, 0, 0); PG8_LDB(B1, 0, 1); PG8_SCHED; PG8_LDA(At, 0, 0); PG8_STAGE(PG8_SA(1, 1), a1, vA1);
            PG8_WAIT_V(8); PG8_WAIT_L(0); PG8_BAR; PG8_MMA(0, 0, At, B0); PG8_MMA(0, 1, At, B1); PG8_BAR; PG8_SCHED;
            PG8_LDA(At, 0, 1); PG8_STAGE(PG8_SB(0, 0), b2, voffB); PG8_STAGE(PG8_SB(0, 1), b2 + hstep, voffB); PG8_STAGE(PG8_SA(0, 0), a2, w0);
            PG8_WAIT_V(8); PG8_WAIT_L(0); PG8_BAR; PG8_MMA(1, 0, At, B0); PG8_MMA(1, 1, At, B1); PG8_BAR; PG8_SCHED;
            PG8_LDB(B0, 1, 0); PG8_LDB(B1, 1, 1); PG8_SCHED; PG8_LDA(At, 1, 0); PG8_STAGE(PG8_SA(0, 1), a2, w1);
            PG8_WAIT_V(8); PG8_WAIT_L(0); PG8_BAR; PG8_MMA(0, 0, At, B0); PG8_MMA(0, 1, At, B1); PG8_BAR; PG8_SCHED;
            PG8_LDA(At, 1, 1); PG8_STAGE(PG8_SB(1, 0), b3, voffB); PG8_STAGE(PG8_SB(1, 1), b3 + hstep, voffB); PG8_STAGE(PG8_SA(1, 0), a3, w0);
            PG8_WAIT_V(8); PG8_WAIT_L(0); PG8_BAR; PG8_MMA(1, 0, At, B0); PG8_MMA(1, 1, At, B1); PG8_BAR; PG8_SCHED;
        }
        if constexpr (MODE == 1) asm volatile("s_nop 15\n\ts_nop 15" ::: "memory");
        if (wr == 0) PG8_BAR;
        if constexpr (Epi::SCALES) E(acc, cur, wr, wc, fr, fq, (const LAS float*)(lds + SC_OFF + (ui & 1) * 2048)); else E(acc, cur, wr, wc, fr, fq);
        S.done(cur);
        if (!has_next) break;
#pragma unroll
        for (int a = 0; a < 2; ++a)
#pragma unroll
            for (int b = 0; b < 2; ++b)
#pragma unroll
                for (int m = 0; m < 4; ++m)
#pragma unroll
                    for (int n = 0; n < 2; ++n) acc[a][b][m][n] = (acc_t){0, 0, 0, 0};
        cur = nxt; cA = nA; cB = nB; ++ui;
#pragma unroll
        for (int i = 0; i < 2; ++i) { vA0[i] = vA0n[i]; vA1[i] = vA1n[i]; }
        if (wr == 1) PG8_BAR;
    }
    PG8_WAIT_V(0);
    PG8_BAR;
#undef PG8_SA
#undef PG8_SB
#undef PG8_STAGE
#undef PG8_LDA
#undef PG8_LDB
#undef PG8_MMA
#undef PG8_WAIT_V
#undef PG8_WAIT_L
#undef PG8_BAR
#undef PG8_SCHED
}

struct EpiBf16Store {
    static constexpr bool PERM = true; static constexpr bool SCALES = false;
    bf16_t* O; int ldo; float sc;
    __device__ __forceinline__ void operator()(const f32x4 (&acc)[2][2][4][2], const Unit& u, int wr, int wc, int fr, int fq) const {
        const int row0 = u.pm * BM + wr * 64 + fr, col0 = u.pn * BM + wc * 32 + 8 * fq;
#pragma unroll
        for (int ai = 0; ai < 2; ++ai)
#pragma unroll
            for (int m = 0; m < 4; ++m) { bf16_t* rowp = O + (size_t)(row0 + ai * HALF + m * 16) * ldo + col0;
#pragma unroll
                for (int bj = 0; bj < 2; ++bj) { const f32x4 v0 = acc[ai][bj][m][0] * sc, v1 = acc[ai][bj][m][1] * sc;
                    u32x4 w; w.x = cvt_pk_bf16(v0[0], v0[1]); w.y = cvt_pk_bf16(v0[2], v0[3]); w.z = cvt_pk_bf16(v1[0], v1[1]); w.w = cvt_pk_bf16(v1[2], v1[3]);
                    *(u32x4*)(rowp + bj * HALF) = w; } }
    }
};
struct EpiRes {
    static constexpr bool PERM = false; static constexpr bool SCALES = false;
    const float* xin_l; const float* xin_c; float* xout_l; float* xout_c; const float* gate; float sc; int nt_in;
    __device__ __forceinline__ void operator()(const f32x4 (&acc)[2][2][4][2], const Unit& u, int wr, int wc, int fr, int fq) const {
        const int trow = u.pm * BM; const bool isc = trow >= ML;
        const int modrow = isc ? 4 : trow / SEQ;
        const float* xi = isc ? xin_c : xin_l; float* xo = isc ? xout_c : xout_l;
        const int row0 = (isc ? trow - ML : trow) + wr * 64 + fr, col0 = u.pn * BM + wc * 32 + 4 * fq;
        const float* gp = gate + (size_t)modrow * 6144 + col0;
        f32x4 gv[2][2];
#pragma unroll
        for (int bj = 0; bj < 2; ++bj)
#pragma unroll
            for (int n = 0; n < 2; ++n) gv[bj][n] = *(const f32x4*)(gp + bj * HALF + n * 16) * sc;
#pragma unroll
        for (int ai = 0; ai < 2; ++ai) {
            f32x4 xv[4][2][2];
#pragma unroll
            for (int m = 0; m < 4; ++m) { const size_t off = (size_t)(row0 + ai * HALF + m * 16) * D + col0;
#pragma unroll
                for (int bj = 0; bj < 2; ++bj)
#pragma unroll
                    for (int n = 0; n < 2; ++n) xv[m][bj][n] = nt_in ? __builtin_nontemporal_load((const f32x4*)(xi + off + bj * HALF + n * 16)) : *(const f32x4*)(xi + off + bj * HALF + n * 16); }
            asm volatile("s_waitcnt vmcnt(0)" ::: "memory");
#pragma unroll
            for (int m = 0; m < 4; ++m) { const size_t off = (size_t)(row0 + ai * HALF + m * 16) * D + col0;
#pragma unroll
                for (int bj = 0; bj < 2; ++bj)
#pragma unroll
                    for (int n = 0; n < 2; ++n) *(f32x4*)(xo + off + bj * HALF + n * 16) = xv[m][bj][n] + gv[bj][n] * acc[ai][bj][m][n]; }
        }
    }
};
template <bool IN_F32>
struct EpiRes16 {
    static constexpr bool PERM = true; static constexpr bool SCALES = false;
    const float* xin_l; const float* xin_c; bf16_t* x16; const float* gate; float sc; int pad;
    __device__ __forceinline__ void operator()(const f32x4 (&acc)[2][2][4][2], const Unit& u, int wr, int wc, int fr, int fq) const {
        const int trow = u.pm * BM; const bool isc = trow >= ML;
        const int modrow = isc ? 4 : trow / SEQ;
        const int row0 = trow + wr * 64 + fr, col0 = u.pn * BM + wc * 32 + 8 * fq;
        const float* gp = gate + (size_t)modrow * 6144 + col0;
        f32x4 gv[2][2];
#pragma unroll
        for (int bj = 0; bj < 2; ++bj)
#pragma unroll
            for (int n = 0; n < 2; ++n) gv[bj][n] = *(const f32x4*)(gp + bj * HALF + n * 4) * sc;
        if constexpr (IN_F32) {
            const float* xi = isc ? xin_c : xin_l; const int rb = isc ? row0 - ML : row0;
#pragma unroll
            for (int ai = 0; ai < 2; ++ai) {
                f32x4 xv[4][2][2];
#pragma unroll
                for (int m = 0; m < 4; ++m) { const size_t off = (size_t)(rb + ai * HALF + m * 16) * D + col0;
#pragma unroll
                    for (int bj = 0; bj < 2; ++bj)
#pragma unroll
                        for (int n = 0; n < 2; ++n) xv[m][bj][n] = __builtin_nontemporal_load((const f32x4*)(xi + off + bj * HALF + n * 4)); }
                asm volatile("s_waitcnt vmcnt(0)" ::: "memory");
#pragma unroll
                for (int m = 0; m < 4; ++m) { const size_t off = (size_t)(row0 + ai * HALF + m * 16) * D + col0;
#pragma unroll
                    for (int bj = 0; bj < 2; ++bj) { const f32x4 o0 = xv[m][bj][0] + gv[bj][0] * acc[ai][bj][m][0], o1 = xv[m][bj][1] + gv[bj][1] * acc[ai][bj][m][1];
                        u32x4 w; w.x = cvt_pk_bf16(o0[0], o0[1]); w.y = cvt_pk_bf16(o0[2], o0[3]); w.z = cvt_pk_bf16(o1[0], o1[1]); w.w = cvt_pk_bf16(o1[2], o1[3]);
                        *(u32x4*)(x16 + off + bj * HALF) = w; } }
            }
        } else {
#pragma unroll
            for (int ai = 0; ai < 2; ++ai) {
                u32x4 xr[4][2];
#pragma unroll
                for (int m = 0; m < 4; ++m) { const size_t off = (size_t)(row0 + ai * HALF + m * 16) * D + col0;
#pragma unroll
                    for (int bj = 0; bj < 2; ++bj) xr[m][bj] = *(const u32x4*)(x16 + off + bj * HALF); }
                asm volatile("s_waitcnt vmcnt(0)" ::: "memory");
#pragma unroll
                for (int m = 0; m < 4; ++m) { const size_t off = (size_t)(row0 + ai * HALF + m * 16) * D + col0;
#pragma unroll
                    for (int bj = 0; bj < 2; ++bj) { const u32x4 r = xr[m][bj]; f32x4 x0, x1;
                        x0[0] = __builtin_bit_cast(float, r.x << 16); x0[1] = __builtin_bit_cast(float, r.x & 0xffff0000u); x0[2] = __builtin_bit_cast(float, r.y << 16); x0[3] = __builtin_bit_cast(float, r.y & 0xffff0000u);
                        x1[0] = __builtin_bit_cast(float, r.z << 16); x1[1] = __builtin_bit_cast(float, r.z & 0xffff0000u); x1[2] = __builtin_bit_cast(float, r.w << 16); x1[3] = __builtin_bit_cast(float, r.w & 0xffff0000u);
                        const f32x4 o0 = x0 + gv[bj][0] * acc[ai][bj][m][0], o1 = x1 + gv[bj][1] * acc[ai][bj][m][1];
                        u32x4 w; w.x = cvt_pk_bf16(o0[0], o0[1]); w.y = cvt_pk_bf16(o0[2], o0[3]); w.z = cvt_pk_bf16(o1[0], o1[1]); w.w = cvt_pk_bf16(o1[2], o1[3]);
                        *(u32x4*)(x16 + off + bj * HALF) = w; } }
            }
        }
    }
};
struct EpiSwiglu {
    static constexpr bool PERM = true; static constexpr bool SCALES = false;
    bf16_t* H; int ldo; float sin;
    __device__ __forceinline__ void operator()(const f32x4 (&acc)[2][2][4][2], const Unit& u, int wr, int wc, int fr, int fq) const {
        const int row0 = u.pm * BM + wr * 64 + fr, col0 = u.pn * HALF + wc * 32 + 8 * fq;
#pragma unroll
        for (int ai = 0; ai < 2; ++ai)
#pragma unroll
            for (int m = 0; m < 4; ++m) { bf16_t* rowp = H + (size_t)(row0 + ai * HALF + m * 16) * ldo + col0;
                float o[8];
#pragma unroll
                for (int n = 0; n < 2; ++n)
#pragma unroll
                    for (int j = 0; j < 4; j += 2) {
                        const f32x2 G = {acc[ai][0][m][n][j], acc[ai][0][m][n][j + 1]}, U = {acc[ai][1][m][n][j], acc[ai][1][m][n][j + 1]};
                        const f32x2 Ee = G * (-1.4426950408889634f * sin); f32x2 T = {__builtin_amdgcn_exp2f(Ee.x), __builtin_amdgcn_exp2f(Ee.y)}; T = T + 1.0f;
                        const f32x2 R = {__builtin_amdgcn_rcpf(T.x), __builtin_amdgcn_rcpf(T.y)};
                        const f32x2 Q = (G * U) * (R * (sin * sin));
                        o[n * 4 + j] = Q.x; o[n * 4 + j + 1] = Q.y; }
                u32x4 w; w.x = cvt_pk_bf16(o[0], o[1]); w.y = cvt_pk_bf16(o[2], o[3]); w.z = cvt_pk_bf16(o[4], o[5]); w.w = cvt_pk_bf16(o[6], o[7]);
                *(u32x4*)rowp = w; }
    }
};
__device__ __forceinline__ unsigned pack4_fp8(float a, float b, float c, float d) {
    int p = 0; p = __builtin_amdgcn_cvt_pk_fp8_f32(a, b, p, false); p = __builtin_amdgcn_cvt_pk_fp8_f32(c, d, p, true); return (unsigned)p; }
struct EpiSwiglu8 {
    static constexpr bool PERM = true; static constexpr bool SCALES = false;
    unsigned char* H; int ldo; float sin, sout;
    __device__ __forceinline__ void operator()(const f32x4 (&acc)[2][2][4][2], const Unit& u, int wr, int wc, int fr, int fq) const {
        const int row0 = u.pm * BM + wr * 64 + fr, col0 = u.pn * HALF + wc * 32 + 8 * fq;
        const float c1 = -1.4426950408889634f * sin, c2 = sin * sin * sout;
#pragma unroll
        for (int ai = 0; ai < 2; ++ai)
#pragma unroll
            for (int m = 0; m < 4; ++m) { unsigned char* rowp = H + (size_t)(row0 + ai * HALF + m * 16) * ldo + col0;
                float o[8];
#pragma unroll
                for (int n = 0; n < 2; ++n)
#pragma unroll
                    for (int j = 0; j < 4; j += 2) {
                        const f32x2 G = {acc[ai][0][m][n][j], acc[ai][0][m][n][j + 1]}, U = {acc[ai][1][m][n][j], acc[ai][1][m][n][j + 1]};
                        const f32x2 Ee = G * c1; f32x2 T = {__builtin_amdgcn_exp2f(Ee.x), __builtin_amdgcn_exp2f(Ee.y)}; T = T + 1.0f;
                        const f32x2 R = {__builtin_amdgcn_rcpf(T.x), __builtin_amdgcn_rcpf(T.y)};
                        const f32x2 Q = (G * U) * (R * c2);
                        o[n * 4 + j] = __builtin_amdgcn_fmed3f(Q.x, -448.f, 448.f); o[n * 4 + j + 1] = __builtin_amdgcn_fmed3f(Q.y, -448.f, 448.f); }
                u32x2 w; w.x = pack4_fp8(o[0], o[1], o[2], o[3]); w.y = pack4_fp8(o[4], o[5], o[6], o[7]);
                *(u32x2*)rowp = w; }
    }
};
template <bool F8>
struct EpiSwigluI8 {
    static constexpr bool PERM = true; static constexpr bool SCALES = true;
    void* H; int ldo; const float* rs; const float* cs;
    __device__ __forceinline__ void dma(const Unit& u, LAS unsigned char* slot, int wid, int lane) const {
        const float* src = wid == 0 ? rs + (size_t)u.pm * BM + 4 * lane : cs + (size_t)u.pn * BM + 4 * lane;
        __builtin_amdgcn_global_load_lds((const unsigned*)src, (LAS unsigned*)(slot + wid * 1024), 16, 0, 0); }
    __device__ __forceinline__ void operator()(const v4i_t (&acc)[2][2][4][2], const Unit& u, int wr, int wc, int fr, int fq, const LAS float* sl) const {
        const int row0 = u.pm * BM + wr * 64 + fr, col0 = u.pn * HALF + wc * 32 + 8 * fq, cc0 = u.pn * BM + wc * 32 + 8 * fq;
        const LAS float* cl = sl + 256 + wc * 32 + 8 * fq; const f32x4 cg0 = *(const LAS f32x4*)cl, cg1 = *(const LAS f32x4*)(cl + 4), cu0 = *(const LAS f32x4*)(cl + HALF), cu1 = *(const LAS f32x4*)(cl + HALF + 4);
        f32x2 ce[2][2], cq[2][2];
#pragma unroll
        for (int n = 0; n < 2; ++n)
#pragma unroll
            for (int jp = 0; jp < 2; ++jp) { const f32x2 g2 = {n ? cg1[2 * jp] : cg0[2 * jp], n ? cg1[2 * jp + 1] : cg0[2 * jp + 1]}, u2 = {n ? cu1[2 * jp] : cu0[2 * jp], n ? cu1[2 * jp + 1] : cu0[2 * jp + 1]};
                ce[n][jp] = g2 * -1.4426950408889634f; cq[n][jp] = g2 * u2; }
#pragma unroll
        for (int ai = 0; ai < 2; ++ai)
#pragma unroll
            for (int m = 0; m < 4; ++m) { const int row = row0 + ai * HALF + m * 16; const float r = sl[wr * 64 + fr + ai * HALF + m * 16], r2 = F8 ? r * r * FP8_SH : r * r;
                float o[8];
#pragma unroll
                for (int n = 0; n < 2; ++n)
#pragma unroll
                    for (int jp = 0; jp < 2; ++jp) {
                        const f32x2 G = {(float)acc[ai][0][m][n][2 * jp], (float)acc[ai][0][m][n][2 * jp + 1]}, U = {(float)acc[ai][1][m][n][2 * jp], (float)acc[ai][1][m][n][2 * jp + 1]};
                        const f32x2 Ee = G * (ce[n][jp] * r); f32x2 T = {__builtin_amdgcn_exp2f(Ee.x), __builtin_amdgcn_exp2f(Ee.y)}; T = T + 1.0f;
                        const f32x2 R = {__builtin_amdgcn_rcpf(T.x), __builtin_amdgcn_rcpf(T.y)};
                        const f32x2 Q = (G * U) * (R * (cq[n][jp] * r2));
                        o[n * 4 + 2 * jp] = Q.x; o[n * 4 + 2 * jp + 1] = Q.y; }
                if constexpr (F8) {
#pragma unroll
                    for (int j = 0; j < 8; ++j) o[j] = __builtin_amdgcn_fmed3f(o[j], -448.f, 448.f);
                    u32x2 w; w.x = pack4_fp8(o[0], o[1], o[2], o[3]); w.y = pack4_fp8(o[4], o[5], o[6], o[7]);
                    *(u32x2*)((unsigned char*)H + (size_t)row * ldo + col0) = w;
                } else {
                    u32x4 w; w.x = cvt_pk_bf16(o[0], o[1]); w.y = cvt_pk_bf16(o[2], o[3]); w.z = cvt_pk_bf16(o[4], o[5]); w.w = cvt_pk_bf16(o[6], o[7]);
                    *(u32x4*)((bf16_t*)H + (size_t)row * ldo + col0) = w; } }
    }
};
struct EpiProjFused {
    static constexpr bool PERM = true; static constexpr bool SCALES = false;
    bf16_t* O;
    __device__ __forceinline__ void operator()(const f32x4 (&acc)[2][2][4][2], const Unit& u, int wr, int wc, int fr, int fq) const {
        const int row0 = u.pm * BM + wr * 64 + fr;
        if (u.pn < 4) {
            const int col0 = (u.pn < 2 ? P_GLU : P_V) + (u.pn & 1) * HALF + wc * 32 + 8 * fq;
#pragma unroll
            for (int ai = 0; ai < 2; ++ai)
#pragma unroll
                for (int m = 0; m < 4; ++m) { bf16_t* rowp = O + (size_t)(row0 + ai * HALF + m * 16) * PW + col0;
                    float o[8];
#pragma unroll
                    for (int n = 0; n < 2; ++n)
#pragma unroll
                        for (int j = 0; j < 4; j += 2) { const f32x2 a = {acc[ai][0][m][n][j], acc[ai][0][m][n][j + 1]}, b = {acc[ai][1][m][n][j], acc[ai][1][m][n][j + 1]};
                            f32x2 q;
                            if (u.pn < 2) { const f32x2 e = b * -1.4426950408889634f; f32x2 t = {__builtin_amdgcn_exp2f(e.x), __builtin_amdgcn_exp2f(e.y)}; t = t + 1.0f;
                                const f32x2 r = {__builtin_amdgcn_rcpf(t.x), __builtin_amdgcn_rcpf(t.y)}; q = a * r; }
                            else q = a * b;
                            o[n * 4 + j] = q.x; o[n * 4 + j + 1] = q.y; }
                    u32x4 w; w.x = cvt_pk_bf16(o[0], o[1]); w.y = cvt_pk_bf16(o[2], o[3]); w.z = cvt_pk_bf16(o[4], o[5]); w.w = cvt_pk_bf16(o[6], o[7]);
                    *(u32x4*)rowp = w; }
        } else {
            const int col0 = P_SBG + (u.pn - 4) * BM + wc * 32 + 8 * fq; const bool gl = u.pn >= 7;
#pragma unroll
            for (int ai = 0; ai < 2; ++ai)
#pragma unroll
                for (int m = 0; m < 4; ++m) { bf16_t* rowp = O + (size_t)(row0 + ai * HALF + m * 16) * PW + col0;
#pragma unroll
                    for (int bj = 0; bj < 2; ++bj) { f32x4 v0 = acc[ai][bj][m][0], v1 = acc[ai][bj][m][1];
                        if (gl) {
#pragma unroll
                            for (int j = 0; j < 4; ++j) { const f32x2 x = {v0[j], v1[j]};
                                const f32x2 e = x * ((x * x) * (-2.302208198f * 0.044715f) + -2.302208198f); f32x2 t = {__builtin_amdgcn_exp2f(e.x), __builtin_amdgcn_exp2f(e.y)}; t = t + 1.0f;
                                const f32x2 r = {__builtin_amdgcn_rcpf(t.x), __builtin_amdgcn_rcpf(t.y)}, q = x * r; v0[j] = q.x; v1[j] = q.y; } }
                        u32x4 w; w.x = cvt_pk_bf16(v0[0], v0[1]); w.y = cvt_pk_bf16(v0[2], v0[3]); w.z = cvt_pk_bf16(v1[0], v1[1]); w.w = cvt_pk_bf16(v1[2], v1[3]);
                        *(u32x4*)(rowp + bj * HALF) = w; } }
        }
    }
};
struct EpiProjFusedI8 {
    static constexpr bool PERM = true; static constexpr bool SCALES = true;
    bf16_t* O; const float* rs; const float* cs;
    __device__ __forceinline__ void dma(const Unit& u, LAS unsigned char* slot, int wid, int lane) const {
        const float* src = wid == 0 ? rs + (size_t)u.pm * BM + 4 * lane : cs + (size_t)u.pn * BM + 4 * lane;
        __builtin_amdgcn_global_load_lds((const unsigned*)src, (LAS unsigned*)(slot + wid * 1024), 16, 0, 0); }
    __device__ __forceinline__ void operator()(const v4i_t (&acc)[2][2][4][2], const Unit& u, int wr, int wc, int fr, int fq, const LAS float* sl) const {
        const int row0 = u.pm * BM + wr * 64 + fr, cc0 = u.pn * BM + wc * 32 + 8 * fq;
        const LAS float* cl = sl + 256 + wc * 32 + 8 * fq; const f32x4 ca0 = *(const LAS f32x4*)cl, ca1 = *(const LAS f32x4*)(cl + 4), cb0 = *(const LAS f32x4*)(cl + HALF), cb1 = *(const LAS f32x4*)(cl + HALF + 4);
        f32x2 ca[2][2], cb[2][2];
#pragma unroll
        for (int jp = 0; jp < 2; ++jp) { ca[0][jp] = (f32x2){ca0[2 * jp], ca0[2 * jp + 1]}; ca[1][jp] = (f32x2){ca1[2 * jp], ca1[2 * jp + 1]}; cb[0][jp] = (f32x2){cb0[2 * jp], cb0[2 * jp + 1]}; cb[1][jp] = (f32x2){cb1[2 * jp], cb1[2 * jp + 1]}; }
        if (u.pn < 4) {
            const int col0 = (u.pn < 2 ? P_GLU : P_V) + (u.pn & 1) * HALF + wc * 32 + 8 * fq;
#pragma unroll
            for (int ai = 0; ai < 2; ++ai)
#pragma unroll
                for (int m = 0; m < 4; ++m) { const int row = row0 + ai * HALF + m * 16; bf16_t* rowp = O + (size_t)row * PW + col0; const float r = sl[wr * 64 + fr + ai * HALF + m * 16];
                    float o[8];
#pragma unroll
                    for (int n = 0; n < 2; ++n)
#pragma unroll
                        for (int jp = 0; jp < 2; ++jp) {
                            const f32x2 a = (f32x2){(float)acc[ai][0][m][n][2 * jp], (float)acc[ai][0][m][n][2 * jp + 1]} * (ca[n][jp] * r);
                            const f32x2 b = (f32x2){(float)acc[ai][1][m][n][2 * jp], (float)acc[ai][1][m][n][2 * jp + 1]} * (cb[n][jp] * r);
                            f32x2 q;
                            if (u.pn < 2) { const f32x2 e = b * -1.4426950408889634f; f32x2 t = {__builtin_amdgcn_exp2f(e.x), __builtin_amdgcn_exp2f(e.y)}; t = t + 1.0f;
                                const f32x2 rr = {__builtin_amdgcn_rcpf(t.x), __builtin_amdgcn_rcpf(t.y)}; q = a * rr; }
                            else q = a * b;
                            o[n * 4 + 2 * jp] = q.x; o[n * 4 + 2 * jp + 1] = q.y; }
                    u32x4 w; w.x = cvt_pk_bf16(o[0], o[1]); w.y = cvt_pk_bf16(o[2], o[3]); w.z = cvt_pk_bf16(o[4], o[5]); w.w = cvt_pk_bf16(o[6], o[7]);
                    *(u32x4*)rowp = w; }
        } else {
            const int col0 = P_SBG + (u.pn - 4) * BM + wc * 32 + 8 * fq; const bool gl = u.pn >= 7;
#pragma unroll
            for (int ai = 0; ai < 2; ++ai)
#pragma unroll
                for (int m = 0; m < 4; ++m) { const int row = row0 + ai * HALF + m * 16; bf16_t* rowp = O + (size_t)row * PW + col0; const float r = sl[wr * 64 + fr + ai * HALF + m * 16];
#pragma unroll
                    for (int bj = 0; bj < 2; ++bj) { float o[8];
#pragma unroll
                        for (int n = 0; n < 2; ++n)
#pragma unroll
                            for (int jp = 0; jp < 2; ++jp) {
                                f32x2 x = (f32x2){(float)acc[ai][bj][m][n][2 * jp], (float)acc[ai][bj][m][n][2 * jp + 1]} * ((bj ? cb[n][jp] : ca[n][jp]) * r);
                                if (gl) { const f32x2 e = x * ((x * x) * (-2.302208198f * 0.044715f) + -2.302208198f); f32x2 t = {__builtin_amdgcn_exp2f(e.x), __builtin_amdgcn_exp2f(e.y)}; t = t + 1.0f;
                                    const f32x2 rr = {__builtin_amdgcn_rcpf(t.x), __builtin_amdgcn_rcpf(t.y)}; x = x * rr; }
                                o[n * 4 + 2 * jp] = x.x; o[n * 4 + 2 * jp + 1] = x.y; }
                        u32x4 w; w.x = cvt_pk_bf16(o[0], o[1]); w.y = cvt_pk_bf16(o[2], o[3]); w.z = cvt_pk_bf16(o[4], o[5]); w.w = cvt_pk_bf16(o[6], o[7]);
                        *(u32x4*)(rowp + bj * HALF) = w; } }
        }
    }
};
}

constexpr size_t MiB = 1u << 20;
constexpr size_t WS_CTL = 0;
constexpr size_t WS_MODV = 1 * MiB;
constexpr size_t WS_LRUW = 2 * MiB;
constexpr size_t WS_GCONST = 2 * MiB + 512 * 1024;
constexpr size_t WS_XCTX = 4 * MiB;
constexpr size_t WS_SUMM = 8 * MiB;
constexpr size_t WS_CR = 13 * MiB;
constexpr size_t WS_WIN = 16 * MiB;
constexpr size_t WS_WOUT = 25 * MiB;
constexpr bool WIN8 = false;
constexpr bool WINI8_L0 = true, WINI8_L1 = true;
constexpr bool DENSE_UPI8 = true;
constexpr bool DENSE_UP8 = false, DENSE_DOWN8 = true;
constexpr size_t WS_W13 = 29 * MiB;
constexpr size_t WS_W2 = 40 * MiB;
constexpr size_t WS_ROUTE = 45 * MiB + 512 * 1024;
constexpr size_t WS_WMOE = 48 * MiB;
constexpr size_t WS_HBUF = 114 * MiB;
constexpr size_t WS_BIG = 180 * MiB;
constexpr size_t WS_X16 = WS_BIG + 250 * MiB;
constexpr size_t WS_W13Q = WS_BIG + 317 * MiB;
constexpr size_t WS_W13QS = WS_W13Q + (size_t)2 * DFF * D;
constexpr size_t WS_RS = WS_W13QS + 64 * 1024;
constexpr size_t WS_WINQ = WS_BIG + 324 * MiB;
constexpr size_t WS_WINQS = WS_BIG + 329 * MiB;
constexpr size_t WS_RS1 = WS_WINQS + 64 * 1024;

__device__ __forceinline__ unsigned pk2(float lo, float hi) { return (unsigned)f2bf(lo) | ((unsigned)f2bf(hi) << 16); }
__device__ __forceinline__ int win_row(int n0) {
    if (n0 < 256) return 256 * (n0 >> 7) + (n0 & 127);
    if (n0 < 512) { const int q = n0 - 256; return 256 * (q >> 7) + 128 + (q & 127); }
    if (n0 < 768) return 1024 + (n0 - 512);
    if (n0 < 1024) { const int q = n0 - 768; return 512 + 256 * (q >> 7) + (q & 127); }
    if (n0 < 1280) { const int q = n0 - 1024; return 512 + 256 * (q >> 7) + 128 + (q & 127); }
    return n0;
}
__device__ __forceinline__ void transpose_item(const float* W, int K, int N, bf16_t* WT, int mode, LAS float* scr, int item, int lane) {
    const int nblk = N / 32, kb = item / nblk, nb = item % nblk, k0 = 64 * kb, n0 = 32 * nb;
    const int drow0 = (mode == 0) ? n0 : (mode == 3 ? win_row(n0) : (256 * (n0 >> 7) + (n0 & 127) + (mode == 2 ? 128 : 0)));
#pragma unroll 8
    for (int i = 0; i < 32; ++i) { const int kk = 2 * i + (lane >> 5); scr[kk * 33 + (lane & 31)] = __builtin_nontemporal_load(W + (size_t)(k0 + kk) * N + n0 + (lane & 31)); }
    asm volatile("s_waitcnt lgkmcnt(0)" ::: "memory");
    const int c = lane & 7;
#pragma unroll
    for (int j = 0; j < 4; ++j) { const int n = (lane >> 3) + 8 * j; const LAS float* s = scr + (8 * c) * 33 + n;
        u32x4 o; o.x = pk2(s[0 * 33], s[1 * 33]); o.y = pk2(s[2 * 33], s[3 * 33]); o.z = pk2(s[4 * 33], s[5 * 33]); o.w = pk2(s[6 * 33], s[7 * 33]);
        *(u32x4*)(WT + (size_t)(drow0 + n) * K + k0 + 8 * c) = o; }
    asm volatile("s_waitcnt lgkmcnt(0)" ::: "memory");
}


constexpr int XS = 68;
constexpr int NPOS = 132;
constexpr int CW_BYTES = 17408;
constexpr int CWL_OFF = NWAVES * CW_BYTES;
constexpr float LOG2E = 1.4426950408889634f;
struct MixArgs {
    const bf16_t* proj; bf16_t* ybuf;
    const float* conf_w; const float* conf_b; const float* ln_g; const float* ln_b;
    const float* sconv_w; const float* g_mix;
    const float* cw; const float* cb; const bf16_t* gwt; const float* gconst;
    float* SA; float* SB; float* CR;
    unsigned* AB;
};
__device__ __forceinline__ void unpack8(const u32x4 r, float (&v)[8]) {
    v[0] = __builtin_bit_cast(float, r.x << 16); v[1] = __builtin_bit_cast(float, r.x & 0xffff0000u);
    v[2] = __builtin_bit_cast(float, r.y << 16); v[3] = __builtin_bit_cast(float, r.y & 0xffff0000u);
    v[4] = __builtin_bit_cast(float, r.z << 16); v[5] = __builtin_bit_cast(float, r.z & 0xffff0000u);
    v[6] = __builtin_bit_cast(float, r.w << 16); v[7] = __builtin_bit_cast(float, r.w & 0xffff0000u);
}
__device__ __forceinline__ float fast_exp2(float x) { return __builtin_amdgcn_exp2f(x); }
__device__ __forceinline__ float fast_rcp(float x) { return __builtin_amdgcn_rcpf(x); }
__device__ __forceinline__ float fast_sigmoid(float x) { return fast_rcp(1.0f + fast_exp2(-LOG2E * x)); }
__device__ __forceinline__ float fast_gelu_tanh(float x) { return x * fast_sigmoid(1.5957691216057308f * (x + 0.044715f * x * x * x)); }

__device__ __forceinline__ void a_unit(LAS unsigned char* lds, int tid, int ua, const MixArgs& m) {
    LAS float* g = (LAS float*)lds;
    const int r0 = ua * 32;
    int lo, hi; if (r0 < ML) { lo = (r0 / GW) * GW; hi = lo + GW; } else { lo = ML + ((r0 - ML) / CTXL) * CTXL; hi = lo + CTXL; }
    {
        u32x4 rv[4];
#pragma unroll
        for (int i = 0; i < 4; ++i) {
            const int it = tid + NTHREADS * i, sr = it >> 5, cg = it & 31; int s = r0 - 15 + sr; s = s < lo ? lo : (s >= hi ? hi - 1 : s);
            rv[i] = *(const u32x4*)(m.proj + (size_t)s * PW + P_GLU + 8 * cg);
        }
#pragma unroll
        for (int i = 0; i < 4; ++i) {
            const int it = tid + NTHREADS * i, sr = it >> 5, cg = it & 31, s = r0 - 15 + sr;
            if (it < 62 * 32) {
                float av[8], o[8]; unpack8(rv[i], av);
                const bool ok = (s >= lo && s < hi);
#pragma unroll
                for (int j = 0; j < 8; ++j) o[j] = ok ? av[j] : 0.f;
                *(LAS f32x4*)(g + sr * 256 + 8 * cg) = (f32x4){o[0], o[1], o[2], o[3]};
                *(LAS f32x4*)(g + sr * 256 + 8 * cg + 4) = (f32x4){o[4], o[5], o[6], o[7]};
            }
        }
    }
    const int c = tid & 255, half = tid >> 8;
    float acc[16];
    {
        float w[CONFK];
#pragma unroll
        for (int k = 0; k < CONFK; ++k) w[k] = m.conf_w[k * 256 + c];
        const float cb = m.conf_b[c];
        f32x2 wp[CONFK + 1];
#pragma unroll
        for (int k = 0; k <= CONFK; ++k) wp[k] = (f32x2){k < CONFK ? w[k] : 0.f, k > 0 ? w[k - 1] : 0.f};
        __syncthreads();
        f32x2 ac2[8];
#pragma unroll
        for (int t = 0; t < 8; ++t) ac2[t] = (f32x2){cb, cb};
#pragma unroll
        for (int j = 0; j < 46; ++j) {
            const float gv = g[(half * 16 + j) * 256 + c];
#pragma unroll
            for (int tp = 0; tp < 8; ++tp) { const int k = j - 2 * tp; if (k >= 0 && k <= CONFK) ac2[tp] = wp[k] * gv + ac2[tp]; }
        }
#pragma unroll
        for (int t = 0; t < 8; ++t) { acc[2 * t] = ac2[t].x; acc[2 * t + 1] = ac2[t].y; }
    }
    __syncthreads();
#pragma unroll
    for (int t = 0; t < 16; ++t) g[(half * 16 + t) * 256 + c] = acc[t];
    __syncthreads();
    {
        const int wave = tid >> 6, lane = tid & 63;
        const f32x4 lg = *(const f32x4*)(m.ln_g + 4 * lane), lb = *(const f32x4*)(m.ln_b + 4 * lane), gm = *(const f32x4*)(m.g_mix + 4 * lane);
#pragma unroll
        for (int q = 0; q < 4; ++q) {
            const int t = wave * 4 + q;
            const f32x4 u4 = *(const LAS f32x4*)(g + t * 256 + 4 * lane);
            const float mean = wave_sum((u4[0] + u4[1]) + (u4[2] + u4[3])) * (1.0f / 256.0f);
            const f32x4 d = u4 - mean;
            const float var = wave_sum((d[0] * d[0] + d[1] * d[1]) + (d[2] * d[2] + d[3] * d[3])) * (1.0f / 256.0f);
            const float rstd = rsqrtf(var + EPS);
            f32x4 ya;
#pragma unroll
            for (int j = 0; j < 4; ++j) { const float ln = d[j] * rstd * lg[j] + lb[j]; ya[j] = ln * fast_sigmoid(ln); }
            float hs = (ya[0] * ya[0] + ya[1] * ya[1]) + (ya[2] * ya[2] + ya[3] * ya[3]);
            hs = sum16(hs);
            const float hr = rsqrtf(hs * (1.0f / 64.0f) + EPS);
            u32x2 o; o.x = cvt_pk_bf16(ya[0] * hr * gm[0], ya[1] * hr * gm[1]); o.y = cvt_pk_bf16(ya[2] * hr * gm[2], ya[3] * hr * gm[3]);
            *(u32x2*)(m.ybuf + (size_t)(r0 + t) * D + 4 * lane) = o;
        }
    }
    __syncthreads();
}
__device__ __forceinline__ void b_unit(int tid, int ub, const MixArgs& m) {
    const int r0 = ub * 64;
    u32x4 rc[4][3], rb[4];
#pragma unroll
    for (int i = 0; i < 4; ++i) {
        const int it = tid + NTHREADS * i, r = r0 + (it >> 5), cg = it & 31;
        int lo, hi, step; if (r < ML) { lo = (r / SEQ) * SEQ; hi = lo + SEQ; step = GW; } else { lo = ML + ((r - ML) / CTXL) * CTXL; hi = lo + CTXL; step = 1; }
#pragma unroll
        for (int k = 0; k < 3; ++k) { int s = r + (k - 1) * step; s = (s >= lo && s < hi) ? s : r; rc[i][k] = *(const u32x4*)(m.proj + (size_t)s * PW + P_V + 8 * cg); }
        rb[i] = *(const u32x4*)(m.proj + (size_t)r * PW + P_SBG + 8 * cg);
    }
#pragma unroll
    for (int i = 0; i < 4; ++i) {
        const int it = tid + NTHREADS * i, r = r0 + (it >> 5), cg = it & 31;
        int lo, hi, step; if (r < ML) { lo = (r / SEQ) * SEQ; hi = lo + SEQ; step = GW; } else { lo = ML + ((r - ML) / CTXL) * CTXL; hi = lo + CTXL; step = 1; }
        float acc[8];
#pragma unroll
        for (int j = 0; j < 8; ++j) acc[j] = 0.f;
#pragma unroll
        for (int k = 0; k < 3; ++k) {
            const int s = r + (k - 1) * step; const float ok = (s >= lo && s < hi) ? 1.f : 0.f;
            float cv[8]; unpack8(rc[i][k], cv);
            const f32x4 w0 = *(const f32x4*)(m.sconv_w + k * 256 + 8 * cg) * ok, w1 = *(const f32x4*)(m.sconv_w + k * 256 + 8 * cg + 4) * ok;
#pragma unroll
            for (int j = 0; j < 4; ++j) { acc[j] += w0[j] * cv[j]; acc[4 + j] += w1[j] * cv[4 + j]; }
        }
        float bg[8]; unpack8(rb[i], bg);
        float ss = 0.f;
#pragma unroll
        for (int j = 0; j < 8; ++j) { acc[j] *= bg[j]; ss += acc[j] * acc[j]; }
        ss = sum8(ss);
        const float hr = rsqrtf(ss * (1.0f / 64.0f) + EPS);
        const f32x4 g0 = *(const f32x4*)(m.g_mix + 256 + 8 * cg), g1 = *(const f32x4*)(m.g_mix + 256 + 8 * cg + 4);
        u32x4 o; o.x = cvt_pk_bf16(acc[0] * hr * g0[0], acc[1] * hr * g0[1]); o.y = cvt_pk_bf16(acc[2] * hr * g0[2], acc[3] * hr * g0[3]);
        o.z = cvt_pk_bf16(acc[4] * hr * g1[0], acc[5] * hr * g1[1]); o.w = cvt_pk_bf16(acc[6] * hr * g1[2], acc[7] * hr * g1[3]);
        *(u32x4*)(m.ybuf + (size_t)r * D + 256 + 8 * cg) = o;
    }
}
__device__ __forceinline__ void c_prep(LAS unsigned char* lds, int tid, const MixArgs& m) {
    LAS float* cwl = (LAS float*)(lds + CWL_OFF);
    for (int i = tid; i < 5 * LRU; i += NTHREADS) cwl[i] = i < 4 * LRU ? m.cw[i] : m.cb[i - 4 * LRU];
    __syncthreads();
}
__device__ __forceinline__ void c_summary_unit(LAS unsigned char* lds, int wave, int lane, int b, int p, const MixArgs& m) {
    const int ch0 = 64 * wave, fr = lane & 15, fq = lane >> 4, ch = ch0 + lane;
    LAS float* Xc = (LAS float*)(lds + wave * CW_BYTES);
    const LAS float* cwl = (const LAS float*)(lds + CWL_OFF);
    const int r0 = p < 4 ? ML + b * CTXL + 64 * p : b * SEQ + 64 * (p - 4);
    const int seq_lo = p < 4 ? ML + b * CTXL : b * SEQ, seq_hi = seq_lo + (p < 4 ? CTXL : SEQ);
    const int cl = ch0 + 8 * (lane & 7);
    const bf16_t* pcx = m.proj + P_CX + cl;
    {
        u32x4 raw[2][4];
        auto issue = [&](int blk) __attribute__((always_inline)) {
#pragma unroll
            for (int ps = 0; ps < 2; ++ps) { const int r = r0 + 16 * blk + ps * 8 + (lane >> 3);
#pragma unroll
                for (int k = 0; k < 4; ++k) { int s = r + k - 2; s = s < seq_lo ? seq_lo : (s >= seq_hi ? seq_hi - 1 : s); raw[ps][k] = *(const u32x4*)(pcx + (size_t)s * PW); } }
        };
        issue(0);
#pragma unroll 1
        for (int blk = 0; blk < 4; ++blk) {
#pragma unroll
            for (int ps = 0; ps < 2; ++ps) {
                const int tt = ps * 8 + (lane >> 3), r = r0 + 16 * blk + tt;
                const f32x4 b0 = *(const LAS f32x4*)(cwl + 4 * LRU + cl), b1 = *(const LAS f32x4*)(cwl + 4 * LRU + cl + 4);
                f32x2 a2[4] = {{b0[0], b0[1]}, {b0[2], b0[3]}, {b1[0], b1[1]}, {b1[2], b1[3]}};
#pragma unroll
                for (int k = 0; k < 4; ++k) { const int s = r + k - 2; const bool ok = (s >= seq_lo && s < seq_hi);
                    u32x4 rv = raw[ps][k]; if (!ok) rv = (u32x4){0u, 0u, 0u, 0u};
                    const f32x4 w0 = *(const LAS f32x4*)(cwl + k * LRU + cl), w1 = *(const LAS f32x4*)(cwl + k * LRU + cl + 4);
                    const f32x2 v0 = {__uint_as_float(rv.x << 16), __uint_as_float(rv.x & 0xffff0000u)}, v1 = {__uint_as_float(rv.y << 16), __uint_as_float(rv.y & 0xffff0000u)};
                    const f32x2 v2 = {__uint_as_float(rv.z << 16), __uint_as_float(rv.z & 0xffff0000u)}, v3 = {__uint_as_float(rv.w << 16), __uint_as_float(rv.w & 0xffff0000u)};
                    a2[0] = (f32x2){w0[0], w0[1]} * v0 + a2[0]; a2[1] = (f32x2){w0[2], w0[3]} * v1 + a2[1]; a2[2] = (f32x2){w1[0], w1[1]} * v2 + a2[2]; a2[3] = (f32x2){w1[2], w1[3]} * v3 + a2[3]; }
                *(LAS f32x4*)(Xc + (16 * blk + tt) * XS + 8 * (lane & 7)) = (f32x4){a2[0].x, a2[0].y, a2[1].x, a2[1].y};
                *(LAS f32x4*)(Xc + (16 * blk + tt) * XS + 8 * (lane & 7) + 4) = (f32x4){a2[2].x, a2[2].y, a2[3].x, a2[3].y};
            }
            if (blk < 3) issue(blk + 1);
        }
    }
#pragma unroll 1
    for (int dir = 0; dir < 2; ++dir) {
        bf16x8 fa[4][2], fx[4][2]; float bav[4], bxv[4], c1v[4];
        {
            const bf16_t* wA = m.gwt + ((size_t)((dir * 2 + 0) * 8 + wave) * 64 + fr) * 64 + 8 * fq;
            const bf16_t* wX = m.gwt + ((size_t)((dir * 2 + 1) * 8 + wave) * 64 + fr) * 64 + 8 * fq;
#pragma unroll
            for (int nt = 0; nt < 4; ++nt) {
#pragma unroll
                for (int ks = 0; ks < 2; ++ks) { fa[nt][ks] = *(const bf16x8*)(wA + (size_t)nt * 16 * 64 + 32 * ks); fx[nt][ks] = *(const bf16x8*)(wX + (size_t)nt * 16 * 64 + 32 * ks); }
                const int cc = ch0 + 16 * nt + fr;
                bav[nt] = m.gconst[(dir * 3 + 0) * LRU + cc]; bxv[nt] = m.gconst[(dir * 3 + 1) * LRU + cc]; c1v[nt] = m.gconst[(dir * 3 + 2) * LRU + cc];
            }
        }
        float Hn[4] = {0.f, 0.f, 0.f, 0.f}, Pn[4] = {1.f, 1.f, 1.f, 1.f};
        unsigned* abp = m.AB + ((size_t)dir * MA + r0) * LRU + ch0;
#pragma unroll 1
        for (int ib = 0; ib < 4; ++ib) {
            const int blk = dir == 0 ? ib : 3 - ib;
            bf16x8 xa[2];
#pragma unroll
            for (int ks = 0; ks < 2; ++ks) {
                const f32x4 lo4 = *(const LAS f32x4*)(Xc + (16 * blk + fr) * XS + 32 * ks + 8 * fq), hi4 = *(const LAS f32x4*)(Xc + (16 * blk + fr) * XS + 32 * ks + 8 * fq + 4);
                const unsigned p0 = cvt_pk_bf16(lo4[0], lo4[1]), p1 = cvt_pk_bf16(lo4[2], lo4[3]), p2 = cvt_pk_bf16(hi4[0], hi4[1]), p3 = cvt_pk_bf16(hi4[2], hi4[3]);
                xa[ks] = __builtin_bit_cast(bf16x8, (u32x4){p0, p1, p2, p3});
            }
#pragma unroll
            for (int nt = 0; nt < 4; ++nt) {
                f32x4 ga = (f32x4){0.f, 0.f, 0.f, 0.f}, gx = (f32x4){0.f, 0.f, 0.f, 0.f};
                float xcn[4];
#pragma unroll
                for (int j = 0; j < 4; ++j) xcn[j] = Xc[(16 * blk + 4 * fq + j) * XS + 16 * nt + fr];
#pragma unroll
                for (int ks = 0; ks < 2; ++ks) { ga = __builtin_amdgcn_mfma_f32_16x16x32_bf16(xa[ks], fa[nt][ks], ga, 0, 0, 0); gx = __builtin_amdgcn_mfma_f32_16x16x32_bf16(xa[ks], fx[nt][ks], gx, 0, 0, 0); }
                float av[4], bv[4];
#pragma unroll
                for (int j = 0; j < 4; j += 2) {
                    const f32x2 ea = (f32x2){ga[j], ga[j + 1]} + bav[nt], ex = (f32x2){gx[j], gx[j + 1]} + bxv[nt];
                    f32x2 ta = {fast_exp2(ea.x), fast_exp2(ea.y)}, tx = {fast_exp2(ex.x), fast_exp2(ex.y)}; ta = ta + 1.0f; tx = tx + 1.0f;
                    const f32x2 rr = {fast_rcp(ta.x), fast_rcp(ta.y)}, ii = {fast_rcp(tx.x), fast_rcp(tx.y)};
                    const f32x2 la = rr * c1v[nt]; const f32x2 a = {fast_exp2(la.x), fast_exp2(la.y)};
                    const f32x2 om = 1.0f - a * a;
                    const f32x2 mult = {__builtin_amdgcn_sqrtf(fmaxf(om.x, 0.f)), __builtin_amdgcn_sqrtf(fmaxf(om.y, 0.f))};
                    const f32x2 bb = mult * (ii * (f32x2){xcn[j], xcn[j + 1]});
                    av[j] = a.x; av[j + 1] = a.y; bv[j] = bb.x; bv[j + 1] = bb.y;
                }
                unsigned* abq = abp + (size_t)(16 * blk + 4 * fq) * LRU + 16 * nt + fr;
#pragma unroll
                for (int j = 0; j < 4; ++j) abq[(size_t)j * LRU] = cvt_pk_bf16(bv[j], 1.0f - av[j]);
                float Ac, Bc;
                { const bool bw = dir != 0;
                  const float a0 = bw ? av[3] : av[0], a1 = bw ? av[2] : av[1], a2 = bw ? av[1] : av[2], a3 = bw ? av[0] : av[3];
                  const float b0 = bw ? bv[3] : bv[0], b1 = bw ? bv[2] : bv[1], b2 = bw ? bv[1] : bv[2], b3 = bw ? bv[0] : bv[3];
                  Bc = a1 * b0 + b1; Ac = a0 * a1; Bc = a2 * Bc + b2; Ac *= a2; Bc = a3 * Bc + b3; Ac *= a3; }
#pragma unroll
                for (int st = 0; st < 2; ++st) {
                    const float Ap = __shfl_xor(Ac, 16 << st), Bp = __shfl_xor(Bc, 16 << st);
                    const bool mine_later = (((fq >> st) & 1) != 0) == (dir == 0);
                    const float Al = mine_later ? Ac : Ap, Bl = mine_later ? Bc : Bp, Ae = mine_later ? Ap : Ac, Be = mine_later ? Bp : Bc;
                    Ac = Al * Ae; Bc = Al * Be + Bl;
                }
                Hn[nt] = Ac * Hn[nt] + Bc; Pn[nt] *= Ac;
            }
        }
        if (fq == 0) {
#pragma unroll
            for (int nt = 0; nt < 4; ++nt) { const size_t o = ((size_t)(dir * NB + b) * NPOS + p) * LRU + ch0 + 16 * nt + fr; m.SA[o] = Pn[nt]; m.SB[o] = Hn[nt]; }
        }
    }
}
__device__ __forceinline__ void c_final_unit(LAS unsigned char* lds, int wave, int lane, int b, int p, const MixArgs& m, bool self_fold) {
    const int ch0 = 64 * wave, ch = ch0 + lane;
    LAS float* As = (LAS float*)(lds + wave * CW_BYTES);
    LAS bf16_t* hfb = (LAS bf16_t*)(lds + wave * CW_BYTES + 2 * 16 * XS * 4);
    const int r0 = p < 4 ? ML + b * CTXL + 64 * p : b * SEQ + 64 * (p - 4);
    float hf = 0.f, hb = 0.f;
    if (self_fold) {
        const float* sa0 = m.SA + (size_t)(0 * NB + b) * NPOS * LRU + ch; const float* sb0 = m.SB + (size_t)(0 * NB + b) * NPOS * LRU + ch;
        const float* sa1 = m.SA + (size_t)(1 * NB + b) * NPOS * LRU + ch; const float* sb1 = m.SB + (size_t)(1 * NB + b) * NPOS * LRU + ch;
        for (int j = 0; j < p; ++j) hf = sa0[(size_t)j * LRU] * hf + sb0[(size_t)j * LRU];
        for (int j = 3; j > p; --j) hb = sa1[(size_t)j * LRU] * hb + sb1[(size_t)j * LRU];
    } else {
        hf = m.CR[((size_t)(0 * NB + b) * NPOS + p) * LRU + ch]; hb = m.CR[((size_t)(1 * NB + b) * NPOS + p) * LRU + ch];
    }
    const unsigned* ab0 = m.AB + ((size_t)0 * MA + r0) * LRU + ch; const unsigned* ab1 = m.AB + ((size_t)1 * MA + r0) * LRU + ch;
    unsigned wf[64], wb[64];
#pragma unroll
    for (int t = 0; t < 64; ++t) wf[t] = ab0[(size_t)t * LRU];
#pragma unroll
    for (int t = 0; t < 64; ++t) wb[t] = ab1[(size_t)t * LRU];
#pragma unroll
    for (int t = 0; t < 64; ++t) { const float bb = __builtin_bit_cast(float, wf[t] << 16), om = __builtin_bit_cast(float, wf[t] & 0xffff0000u); hf = (1.0f - om) * hf + bb; hfb[t * 64 + lane] = f2bf(hf); }
    const f32x4 gm0 = *(const f32x4*)(m.g_mix + 512 + ch0 + 16 * (lane & 3)), gm1 = *(const f32x4*)(m.g_mix + 512 + ch0 + 16 * (lane & 3) + 4),
                gm2 = *(const f32x4*)(m.g_mix + 512 + ch0 + 16 * (lane & 3) + 8), gm3 = *(const f32x4*)(m.g_mix + 512 + ch0 + 16 * (lane & 3) + 12);
    const float gm[16] = {gm0[0], gm0[1], gm0[2], gm0[3], gm1[0], gm1[1], gm1[2], gm1[3], gm2[0], gm2[1], gm2[2], gm2[3], gm3[0], gm3[1], gm3[2], gm3[3]};
    u32x4 cgr[4][2];
#pragma unroll
    for (int blk = 0; blk < 4; ++blk) { const bf16_t* pg = m.proj + (size_t)(r0 + 16 * blk + (lane >> 2)) * PW + P_CG + ch0 + 16 * (lane & 3); cgr[blk][0] = *(const u32x4*)pg; cgr[blk][1] = *(const u32x4*)(pg + 8); }
#pragma unroll
    for (int blk = 3; blk >= 0; --blk) {
#pragma unroll
        for (int tt = 15; tt >= 0; --tt) { const unsigned w = wb[16 * blk + tt]; const float bb = __builtin_bit_cast(float, w << 16), om = __builtin_bit_cast(float, w & 0xffff0000u); hb = (1.0f - om) * hb + bb;
            As[tt * XS + lane] = hb + bf2f(hfb[(16 * blk + tt) * 64 + lane]); }
        {
            const int tt = lane >> 2, q = lane & 3, r = r0 + 16 * blk + tt;
            float ys[16], cg[16];
#pragma unroll
            for (int v4 = 0; v4 < 4; ++v4) { const f32x4 t4 = *(const LAS f32x4*)(As + tt * XS + 16 * q + 4 * v4); ys[4 * v4] = t4[0]; ys[4 * v4 + 1] = t4[1]; ys[4 * v4 + 2] = t4[2]; ys[4 * v4 + 3] = t4[3]; }
            { float t8[8]; unpack8(cgr[blk][0], t8);
#pragma unroll
              for (int j = 0; j < 8; ++j) cg[j] = t8[j];
              unpack8(cgr[blk][1], t8);
#pragma unroll
              for (int j = 0; j < 8; ++j) cg[8 + j] = t8[j]; }
            float ss = 0.f;
#pragma unroll
            for (int j = 0; j < 16; ++j) { ys[j] *= cg[j]; ss += ys[j] * ys[j]; }
            ss = sum4(ss);
            const float hr = rsqrtf(ss * (1.0f / 64.0f) + EPS);
            u32x4 o0, o1;
            o0.x = cvt_pk_bf16(ys[0] * hr * gm[0], ys[1] * hr * gm[1]); o0.y = cvt_pk_bf16(ys[2] * hr * gm[2], ys[3] * hr * gm[3]);
            o0.z = cvt_pk_bf16(ys[4] * hr * gm[4], ys[5] * hr * gm[5]); o0.w = cvt_pk_bf16(ys[6] * hr * gm[6], ys[7] * hr * gm[7]);
            o1.x = cvt_pk_bf16(ys[8] * hr * gm[8], ys[9] * hr * gm[9]); o1.y = cvt_pk_bf16(ys[10] * hr * gm[10], ys[11] * hr * gm[11]);
            o1.z = cvt_pk_bf16(ys[12] * hr * gm[12], ys[13] * hr * gm[13]); o1.w = cvt_pk_bf16(ys[14] * hr * gm[14], ys[15] * hr * gm[15]);
            bf16_t* yo = m.ybuf + (size_t)r * D + 512 + ch0 + 16 * q;
            *(u32x4*)yo = o0; *(u32x4*)(yo + 8) = o1;
        }
    }
}
__device__ __forceinline__ void carry_task(int gid, const MixArgs& m) {
    const int ch = gid & 511, dir = (gid >> 9) & 1, b = gid >> 10;
    const float* sa = m.SA + (size_t)(dir * NB + b) * NPOS * LRU + ch; const float* sb = m.SB + (size_t)(dir * NB + b) * NPOS * LRU + ch;
    float* cr = m.CR + (size_t)(dir * NB + b) * NPOS * LRU + ch;
    float h = 0.f;
    if (dir == 0) {
#pragma unroll 33
        for (int p = 0; p < NPOS; ++p) { const float a = sa[(size_t)p * LRU], bb = sb[(size_t)p * LRU]; cr[(size_t)p * LRU] = h; h = a * h + bb; }
    } else {
#pragma unroll
        for (int p = 3; p >= 0; --p) { const float a = sa[(size_t)p * LRU], bb = sb[(size_t)p * LRU]; cr[(size_t)p * LRU] = h; h = a * h + bb; }
#pragma unroll 32
        for (int p = NPOS - 1; p >= 4; --p) { const float a = sa[(size_t)p * LRU], bb = sb[(size_t)p * LRU]; cr[(size_t)p * LRU] = h; h = a * h + bb; }
    }
}
constexpr int REP_CS = 1, REP_B = 1, REP_CF = 1;
__device__ __forceinline__ void team_arrive(unsigned* ctr, int tid);
__device__ __forceinline__ void team_wait(unsigned* ctr, unsigned n, int tid);
__device__ __forceinline__ void mix_phase(LAS unsigned char* lds, int tid, int wave, int lane, int G, const MixArgs& m, int n_a_units, unsigned* ctr, int n_cf, unsigned* cfc) {
    const int nC = NB * NPOS, total = nC + n_a_units;
    volatile LAS int* nxt = (volatile LAS int*)(lds + LDS_BYTES - 32);
    c_prep(lds, tid, m);
    int u = blockIdx.x;
#pragma unroll 1
    for (int rep = 0; rep < REP_CS; ++rep) {
#pragma unroll 1
        while (u < nC) {
            if (tid == 0) *nxt = G + (int)__hip_atomic_fetch_add(ctr, 1u, __ATOMIC_RELAXED, __HIP_MEMORY_SCOPE_AGENT);
            c_summary_unit(lds, wave, lane, u / NPOS, u % NPOS, m);
            if (n_cf > 0 && (u % NPOS) < 4) team_arrive(cfc, tid);
            __syncthreads();
            u = *nxt;
            __syncthreads();
        }
        if (rep + 1 < REP_CS) u = blockIdx.x;
    }
#pragma unroll 1
    while (u < total) {
        if (tid == 0) *nxt = G + (int)__hip_atomic_fetch_add(ctr, 1u, __ATOMIC_RELAXED, __HIP_MEMORY_SCOPE_AGENT);
        a_unit(lds, tid, u - nC, m);
        u = *nxt;
        __syncthreads();
    }
#pragma unroll 1
    while (u < total + n_cf) {
        if (tid == 0) *nxt = G + (int)__hip_atomic_fetch_add(ctr, 1u, __ATOMIC_RELAXED, __HIP_MEMORY_SCOPE_AGENT);
        team_wait(cfc, (unsigned)(NB * 4), tid);
        { const int k = u - total; c_final_unit(lds, wave, lane, k >> 2, k & 3, m, true); }
        __syncthreads();
        u = *nxt;
        __syncthreads();
    }
}
__device__ __forceinline__ void carry_phase(LAS unsigned char* lds, int tid, int wave, int lane, int G, const MixArgs& m, int ctx_too, int n_b_units, unsigned* bq) {
    if (blockIdx.x < 8) carry_task((int)blockIdx.x * NTHREADS + tid, m);
    volatile LAS int* nxt = (volatile LAS int*)(lds + LDS_BYTES - 32);
    if (tid == 0) *nxt = (int)__hip_atomic_fetch_add(bq, 1u, __ATOMIC_RELAXED, __HIP_MEMORY_SCOPE_AGENT);
    __syncthreads();
    int u = *nxt;
    __syncthreads();
#pragma unroll 1
    while (u < n_b_units) {
        if (tid == 0) *nxt = (int)__hip_atomic_fetch_add(bq, 1u, __ATOMIC_RELAXED, __HIP_MEMORY_SCOPE_AGENT);
        b_unit(tid, u, m);
        __syncthreads();
        u = *nxt;
        __syncthreads();
    }
}
__device__ __forceinline__ void cfin_phase(LAS unsigned char* lds, int tid, int wave, int lane, int G, const MixArgs& m) {
    const int nC = NB * (NPOS - 4);
#pragma unroll 1
    for (int rep = 0; rep < REP_CF; ++rep)
#pragma unroll 1
    for (int u = blockIdx.x; u < nC; u += G) c_final_unit(lds, wave, lane, u / (NPOS - 4), 4 + u % (NPOS - 4), m, false);
}

constexpr int CW_WQ = 2048;
constexpr int CW_CNT = 1024;
constexpr size_t EXP_STRIDE = (size_t)(2 * DFF * D + D * DFF);
constexpr size_t EXP_W2_OFF = (size_t)2 * DFF * D;
constexpr size_t RT_E = 0;
constexpr size_t RT_P = 256 * 1024;
constexpr size_t RT_POS = 512 * 1024;
constexpr size_t RT_IDX = 1024 * 1024;
constexpr int MAXT = 264;
constexpr size_t WS_Y = WS_HBUF;
constexpr size_t WS_H8MOE = WS_BIG + 66 * MiB;

typedef int i32x2 __attribute__((ext_vector_type(2)));

template <bool ROUTE, int OUTM  >
__device__ __forceinline__ void norm_phase(LAS unsigned char* lds, int tid, int wave, int lane, int G, const float* xl, const float* xc, const float* g, const float* modv_l, int sh_off, int sc_off,
                                           bf16_t* out, int rows, const float* wr, const float* br, unsigned* ctl, unsigned char* route, float* rsc = nullptr, bool nt_x = false, const bf16_t* xs16 = nullptr,
                                           int first_block = 0, int nblocks = 0, int row_lo = 0) {
    LAS float* wrT = (LAS float*)lds;
    LAS unsigned* lcnt = (LAS unsigned*)(lds + 32768);
    if (ROUTE) {
        for (int i = tid; i < D * NE; i += NTHREADS) wrT[(i & 7) * D + (i >> 3)] = wr[i];
        if (tid < 32) lcnt[tid] = 0u;
        __syncthreads();
    }
    const int gw = ((int)blockIdx.x - first_block) * NWAVES + wave, NGW = (nblocks ? nblocks : G) * NWAVES;
    const int rpw = (rows + NGW - 1) / NGW;
    const int rbeg0 = gw * rpw, rbeg = row_lo + (rbeg0 < rows ? rbeg0 : rows), rend = row_lo + ((rbeg0 + rpw < rows) ? rbeg0 + rpw : rows);
    int cur_mod = -1; f32x4 Gv[4], Sv[4];
    int my_e0 = 0, my_e1 = 0, my_l0 = 0, my_l1 = 0; float my_p0 = 0.f, my_p1 = 0.f;
    float brv[NE];
#pragma unroll
    for (int e = 0; e < NE; ++e) brv[e] = ROUTE ? br[e] : 0.f;
    f32x4 nxf[4]; u32x2 nxb[4];
    auto loadrow = [&](int row) __attribute__((always_inline)) {
        const float* xr = row < ML ? xl + (size_t)row * D : xc + (size_t)(row - ML) * D;
#pragma unroll
        for (int j = 0; j < 4; ++j) {
            if (xs16) nxb[j] = *(const u32x2*)(xs16 + (size_t)row * D + 4 * lane + 256 * j);
            else nxf[j] = nt_x ? __builtin_nontemporal_load((const f32x4*)(xr + 4 * lane + 256 * j)) : *(const f32x4*)(xr + 4 * lane + 256 * j); }
    };
    const int rstep = ROUTE ? 1 : NGW, rfirst = ROUTE ? rbeg : row_lo + gw, rlast = ROUTE ? rend : row_lo + rows;
    if (rfirst < rlast) loadrow(rfirst);
#pragma unroll 1
    for (int row = rfirst; row < rlast; row += rstep) {
        const int mr = row_modidx(row);
        if (mr != cur_mod) { cur_mod = mr; const float* mv = modv_l + (size_t)mr * 6144;
#pragma unroll
            for (int j = 0; j < 4; ++j) { const int c = 4 * lane + 256 * j; const f32x4 gg = *(const f32x4*)(g + c), sc = *(const f32x4*)(mv + sc_off + c); Gv[j] = gg * (sc + 1.0f); Sv[j] = *(const f32x4*)(mv + sh_off + c); } }
        f32x4 v[4]; float ss = 0.f;
#pragma unroll
        for (int j = 0; j < 4; ++j) {
            if (xs16) { const u32x2 r = nxb[j]; v[j][0] = __builtin_bit_cast(float, r.x << 16); v[j][1] = __builtin_bit_cast(float, r.x & 0xffff0000u); v[j][2] = __builtin_bit_cast(float, r.y << 16); v[j][3] = __builtin_bit_cast(float, r.y & 0xffff0000u); }
            else v[j] = nxf[j];
            ss += (v[j][0] * v[j][0] + v[j][1] * v[j][1]) + (v[j][2] * v[j][2] + v[j][3] * v[j][3]); }
        if (row + rstep < rlast) loadrow(row + rstep);
        ss = wave_sum(ss);
        const float rstd = rsqrtf(ss * (1.0f / D) + EPS);
#pragma unroll
        for (int j = 0; j < 4; ++j) { v[j] = (v[j] * rstd) * Gv[j] + Sv[j];
            if (OUTM == 1) *(unsigned*)((unsigned char*)out + (size_t)row * D + 4 * lane + 256 * j) = pg8::pack4_fp8(v[j][0], v[j][1], v[j][2], v[j][3]);
            else if (OUTM == 0) { u32x2 o; o.x = cvt_pk_bf16(v[j][0], v[j][1]); o.y = cvt_pk_bf16(v[j][2], v[j][3]); *(u32x2*)(out + (size_t)row * D + 4 * lane + 256 * j) = o; } }
        if (OUTM == 2) {
            float am = 0.f;
#pragma unroll
            for (int j = 0; j < 4; ++j) am = fmaxf(am, fmaxf(fmaxf(fabsf(v[j][0]), fabsf(v[j][1])), fmaxf(fabsf(v[j][2]), fabsf(v[j][3]))));
            am = fmaxf(wave_max(am), 1e-20f);
            const float qs = 127.0f / am;
#pragma unroll
            for (int j = 0; j < 4; ++j) { const int q0 = (int)__builtin_rintf(v[j][0] * qs), q1 = (int)__builtin_rintf(v[j][1] * qs), q2 = (int)__builtin_rintf(v[j][2] * qs), q3 = (int)__builtin_rintf(v[j][3] * qs);
                *(unsigned*)((unsigned char*)out + (size_t)row * D + 4 * lane + 256 * j) = (unsigned)(q0 & 0xff) | ((unsigned)(q1 & 0xff) << 8) | ((unsigned)(q2 & 0xff) << 16) | ((unsigned)(q3 & 0xff) << 24); }
            if (lane == 0) rsc[row] = am * (1.0f / 127.0f);
        }
        if (ROUTE) {
            float lg[NE];
#pragma unroll
            for (int e = 0; e < NE; ++e) { f32x2 a2 = {0.f, 0.f};
#pragma unroll
                for (int j = 0; j < 4; ++j) { const f32x4 w4 = *(const LAS f32x4*)(wrT + e * D + 4 * lane + 256 * j);
                    a2 = (f32x2){v[j][0], v[j][1]} * (f32x2){w4[0], w4[1]} + a2; a2 = (f32x2){v[j][2], v[j][3]} * (f32x2){w4[2], w4[3]} + a2; }
                lg[e] = wave_sum(a2.x + a2.y) + brv[e]; }
            int i0 = 0; float v0 = lg[0];
#pragma unroll
            for (int e = 1; e < NE; ++e) if (lg[e] > v0) { v0 = lg[e]; i0 = e; }
            int i1 = 0; float v1 = -3.0e38f;
#pragma unroll
            for (int e = 0; e < NE; ++e) if (e != i0 && lg[e] > v1) { v1 = lg[e]; i1 = e; }
            const float e1 = __expf(v1 - v0), p0 = 1.0f / (1.0f + e1), p1 = e1 / (1.0f + e1);
            if (lane == row - rbeg) {
                my_e0 = i0; my_e1 = i1; my_p0 = p0; my_p1 = p1;
                my_l0 = (int)__hip_atomic_fetch_add(lcnt + i0, 1u, __ATOMIC_RELAXED, __HIP_MEMORY_SCOPE_WORKGROUP);
                my_l1 = (int)__hip_atomic_fetch_add(lcnt + i1, 1u, __ATOMIC_RELAXED, __HIP_MEMORY_SCOPE_WORKGROUP);
            }
        }
    }
    if (ROUTE) {
        __syncthreads();
        if (tid < 8) { const unsigned n = lcnt[tid]; lcnt[16 + tid] = n ? __hip_atomic_fetch_add(ctl + CW_CNT + tid * 64, n, __ATOMIC_RELAXED, __HIP_MEMORY_SCOPE_AGENT) : 0u; }
        __syncthreads();
        const int row = rbeg + lane;
        if (row < rend) {
            const int pos0 = (int)lcnt[16 + my_e0] + my_l0, pos1 = (int)lcnt[16 + my_e1] + my_l1;
            ((i32x2*)(route + RT_E))[row] = (i32x2){my_e0, my_e1};
            ((f32x2*)(route + RT_P))[row] = (f32x2){my_p0, my_p1};
            ((i32x2*)(route + RT_POS))[row] = (i32x2){pos0, pos1};
            int* ridx = (int*)(route + RT_IDX);
            ridx[(size_t)my_e0 * ML + pos0] = row;
            ridx[(size_t)my_e1 * ML + pos1] = row;
        }
    }
}

struct MoeTiles { int toff[9]; };
__device__ __forceinline__ void moe_tiles(const unsigned* ctl, MoeTiles& t) {
    int acc = 0;
#pragma unroll
    for (int e = 0; e < 8; ++e) { const int c = (int)__builtin_amdgcn_readfirstlane(__hip_atomic_load(ctl + CW_CNT + e * 64, __ATOMIC_RELAXED, __HIP_MEMORY_SCOPE_AGENT)); t.toff[e] = acc; acc += (c + 255) >> 8; }
    t.toff[8] = acc;
}
namespace pg8 {
struct MoeUpSched {
    static constexpr bool GATHER = true;
    Order o; MoeTiles t; const char* hb; const char* wmoe; const int* ridx; const unsigned* cntp; size_t tstepB;
    __device__ __forceinline__ void init(const void* hbuf8, const unsigned char* wmoe_, const int* ridx_, const unsigned* ctl, int G, int c) {
        moe_tiles(ctl, t); o.init(t.toff[8], (2 * DFF) / BM, G, c); cntp = ctl + CW_CNT; hb = (const char*)hbuf8; wmoe = (const char*)wmoe_; ridx = ridx_; tstepB = (size_t)BM * D; }
    __device__ __forceinline__ bool next(int i, Unit& u) const {
        if (!o.lin(i, u.pm, u.pn)) return false;
        int e = 0, ts = 0;
#pragma unroll
        for (int k = 1; k < 8; ++k) if (u.pm >= t.toff[k]) { e = k; ts = t.toff[k]; }
        u.e = e; u.rb = (u.pm - ts) * BM; u.cnt = (int)cntp[e * 64];
        u.a = hb; u.b = wmoe + (size_t)e * EXP_STRIDE + (size_t)u.pn * tstepB; return true;
    }
    __device__ __forceinline__ unsigned arow(const Unit& u, int r) const { const int idx = u.rb + r; return (unsigned)ridx[(size_t)u.e * ML + (idx < u.cnt ? idx : 0)]; }
    __device__ __forceinline__ void idx_dma(const Unit& u, LAS unsigned char* slot, int lane) const {
        __builtin_amdgcn_global_load_lds((const unsigned*)(ridx + (size_t)u.e * ML + u.rb + lane * 4), (LAS unsigned*)slot, 16, 0, 0); }
    __device__ __forceinline__ unsigned arow_lds(const Unit& u, int r, const LAS int* ix) const { return (unsigned)ix[(u.rb + r < u.cnt) ? r : 0]; }
    __device__ __forceinline__ void a_ready(const Unit&) const {}
    __device__ __forceinline__ void done(const Unit&) const {}
};
struct MoeDownSched {
    static constexpr bool GATHER = false;
    Order o; MoeTiles t; const char* H; const char* wmoe; size_t tstep;
    __device__ __forceinline__ void init(const void* Hc, const unsigned char* wmoe_, const unsigned* ctl, int G, int c) {
        moe_tiles(ctl, t); o.init(t.toff[8], D / BM, G, c); H = (const char*)Hc; wmoe = (const char*)wmoe_; tstep = (size_t)BM * DFF; }
    __device__ __forceinline__ bool next(int i, Unit& u) const {
        if (!o.lin(i, u.pm, u.pn)) return false;
        u.pm = t.toff[8] - 1 - u.pm;
        int e = 0;
#pragma unroll
        for (int k = 1; k < 8; ++k) if (u.pm >= t.toff[k]) e = k;
        u.e = e; u.rb = 0; u.cnt = 0;
        u.a = H + (size_t)u.pm * tstep; u.b = wmoe + (size_t)e * EXP_STRIDE + EXP_W2_OFF + (size_t)u.pn * tstep; return true;
    }
    __device__ __forceinline__ unsigned arow(const Unit&, int r) const { return (unsigned)r; }
    __device__ __forceinline__ void a_ready(const Unit&) const {}
    __device__ __forceinline__ void done(const Unit&) const {}
};
}

__device__ __forceinline__ void final_phase(int wave, int lane, int G, float* x, const bf16_t* x16, const bf16_t* Y, const float* gt2  , const float* g_final, const unsigned* ctl, const unsigned char* route) {
    MoeTiles t; moe_tiles(ctl, t);
    const int gw = blockIdx.x * NWAVES + wave, NGW = G * NWAVES;
    const int rpw = (ML + NGW - 1) / NGW;
    const int rbeg = gw * rpw, rend = (rbeg + rpw < ML) ? rbeg + rpw : ML;
    f32x4 gf[4];
#pragma unroll
    for (int j = 0; j < 4; ++j) gf[j] = *(const f32x4*)(g_final + 4 * lane + 256 * j);
#pragma unroll 1
    for (int row = rbeg; row < rend; ++row) {
        const i32x2 ee = ((const i32x2*)(route + RT_E))[row]; const f32x2 pp = ((const f32x2*)(route + RT_P))[row]; const i32x2 ps = ((const i32x2*)(route + RT_POS))[row];
        int t0 = 0, t1 = 0;
#pragma unroll
        for (int k = 1; k < 8; ++k) { if (ee[0] >= k) t0 = t.toff[k]; if (ee[1] >= k) t1 = t.toff[k]; }
        const bf16_t* y0 = Y + ((size_t)t0 * 256 + ps[0]) * D; const bf16_t* y1 = Y + ((size_t)t1 * 256 + ps[1]) * D;
        const float* gt = gt2 + (size_t)(row / SEQ) * 6144;
        f32x4 v[4]; float ss = 0.f;
#pragma unroll
        for (int j = 0; j < 4; ++j) {
            const int c = 4 * lane + 256 * j;
            const u32x2 xr_ = *(const u32x2*)(x16 + (size_t)row * D + c); f32x4 xv; xv[0] = __builtin_bit_cast(float, xr_.x << 16); xv[1] = __builtin_bit_cast(float, xr_.x & 0xffff0000u); xv[2] = __builtin_bit_cast(float, xr_.y << 16); xv[3] = __builtin_bit_cast(float, xr_.y & 0xffff0000u);
            const f32x4 gv = *(const f32x4*)(gt + c);
            const u32x2 a = *(const u32x2*)(y0 + c), b2 = *(const u32x2*)(y1 + c);
            f32x4 ya, yb;
            ya[0] = __builtin_bit_cast(float, a.x << 16); ya[1] = __builtin_bit_cast(float, a.x & 0xffff0000u); ya[2] = __builtin_bit_cast(float, a.y << 16); ya[3] = __builtin_bit_cast(float, a.y & 0xffff0000u);
            yb[0] = __builtin_bit_cast(float, b2.x << 16); yb[1] = __builtin_bit_cast(float, b2.x & 0xffff0000u); yb[2] = __builtin_bit_cast(float, b2.y << 16); yb[3] = __builtin_bit_cast(float, b2.y & 0xffff0000u);
            v[j] = xv + gv * (ya * pp[0] + yb * pp[1]);
            ss += (v[j][0] * v[j][0] + v[j][1] * v[j][1]) + (v[j][2] * v[j][2] + v[j][3] * v[j][3]);
        }
        ss = wave_sum(ss);
        const float rstd = rsqrtf(ss * (1.0f / D) + EPS);
#pragma unroll
        for (int j = 0; j < 4; ++j) *(f32x4*)(x + (size_t)row * D + 4 * lane + 256 * j) = (v[j] * rstd) * gf[j];
    }
}

__device__ __forceinline__ void mod_task(LAS unsigned char* lds, int tid, int wave, int lane, int task, const float* c, const float* c_ctx, const float* w_mod, const float* b_mod, float* modv) {
    LAS float* sl = (LAS float*)lds;
    LAS float* red = (LAS float*)(lds + 20480);
    for (int i = tid; i < 5 * D; i += NTHREADS) { const float v = i < 4 * D ? c[i] : c_ctx[i - 4 * D]; sl[i] = v / (1.0f + __expf(-v)); }
    __syncthreads();
    const int l = task / 96, n = (task % 96) * 64 + lane;
    const float* w = w_mod + (size_t)l * D * 6144 + n;
    float acc[5] = {0.f, 0.f, 0.f, 0.f, 0.f};
#pragma unroll 16
    for (int kk = 0; kk < 128; ++kk) { const int k = wave * 128 + kk; const float wv = w[(size_t)k * 6144];
#pragma unroll
        for (int r = 0; r < 5; ++r) acc[r] += sl[r * D + k] * wv; }
#pragma unroll
    for (int r = 0; r < 5; ++r) red[(wave * 5 + r) * 64 + lane] = acc[r];
    __syncthreads();
    if (tid < 320) { const int r = tid >> 6, ln = tid & 63; float s = 0.f;
#pragma unroll
        for (int w8 = 0; w8 < 8; ++w8) s += red[(w8 * 5 + r) * 64 + ln];
        const int nn = (task % 96) * 64 + ln; modv[((size_t)l * 5 + r) * 6144 + nn] = s + b_mod[l * 6144 + nn]; }
    __syncthreads();
}

constexpr unsigned DUPMASK = 0u;
constexpr int CW_BAR = 4096;
#define XB_TMO      128
#define XB_XCNT(j)  (256  + 64 * (j))
#define XB_XSUB(j)  (1280 + 64 * (j))
#define XB_XGEN(j)  (2304 + 64 * (j))
#define XB_TOP      3328
#define XB_TOPGEN   3392
#define XCD_BAR_WORDS 3456
#define XB_SPIN_CAP (1u << 18)

__device__ __forceinline__ unsigned xb_ld(unsigned* p)              { return __hip_atomic_load(p, __ATOMIC_RELAXED, __HIP_MEMORY_SCOPE_AGENT); }
__device__ __forceinline__ unsigned xb_add(unsigned* p, unsigned v) { return __hip_atomic_fetch_add(p, v, __ATOMIC_RELAXED, __HIP_MEMORY_SCOPE_AGENT); }
__device__ __forceinline__ unsigned xb_xcc_id() { return (unsigned)__builtin_amdgcn_s_getreg((3 << 11) | 20) & 0xFu; }
#define XB_SPIN(cond, bar) do { unsigned _sp = 0; while (cond) { __builtin_amdgcn_s_sleep(1); \
    if ((++_sp & 255u) == 0u) { if (xb_ld(&(bar)[XB_TMO])) break; if (_sp > XB_SPIN_CAP) { atomicAdd(&(bar)[XB_TMO], 1u); break; } } } } while (0)

struct XcdBarrier {
    unsigned* bar; unsigned x;
    volatile LAS unsigned* st;
};

__device__ __forceinline__ XcdBarrier xcd_barrier_post(unsigned* bar, volatile LAS unsigned* st) {
    XcdBarrier b; b.bar = bar; b.x = xb_xcc_id(); b.st = st;
    if (threadIdx.x == 0) (void)xb_add(&bar[XB_XCNT(b.x)], 1u);
    return b;
}
__device__ __forceinline__ void xcd_barrier_complete(unsigned* bar, unsigned x, unsigned& nloc, unsigned& nx) {
    const unsigned G = gridDim.x * gridDim.y * gridDim.z;
    unsigned sum, cnt, mine, sp = 0u;
    for (;;) {
        sum = 0u; cnt = 0u; mine = 0u;
#pragma unroll
        for (unsigned j = 0; j < 16; ++j) { const unsigned c = xb_ld(&bar[XB_XCNT(j)]); sum += c; cnt += (c > 0u) ? 1u : 0u; mine = (j == x) ? c : mine; }
        if (sum == G) break;
        __builtin_amdgcn_s_sleep(1);
        if ((++sp & 255u) == 0u) { if (xb_ld(&bar[XB_TMO])) break; if (sp > XB_SPIN_CAP) { atomicAdd(&bar[XB_TMO], 1u); break; } }
    }
    nloc = mine > 0u ? mine : 1u; nx = cnt > 0u ? cnt : 1u;
}

__device__ __forceinline__ void xcd_barrier(const XcdBarrier& b) {
    asm volatile("s_waitcnt vmcnt(0)" ::: "memory");
    __syncthreads();
    if (threadIdx.x == 0) {
        unsigned* bar = b.bar;
        __builtin_amdgcn_s_waitcnt(0);
        unsigned nloc = b.st[0], nx = b.st[1];
        if (nloc == 0u) { xcd_barrier_complete(bar, b.x, nloc, nx); b.st[0] = nloc; b.st[1] = nx; }
        const unsigned old = xb_add(&bar[XB_XSUB(b.x)], 1u);
        const unsigned gen = old / nloc;
        if (old + 1u == (gen + 1u) * nloc) {
            __builtin_amdgcn_fence(__ATOMIC_RELEASE, "agent");
            asm volatile("s_waitcnt vmcnt(0)" ::: "memory");
            const unsigned og = xb_add(&bar[XB_TOP], 1u);
            const unsigned tg = og / nx;
            if (og + 1u == (tg + 1u) * nx) xb_add(&bar[XB_TOPGEN], 1u);
            else XB_SPIN(xb_ld(&bar[XB_TOPGEN]) == tg, bar);
            __builtin_amdgcn_fence(__ATOMIC_ACQUIRE, "agent");
            xb_add(&bar[XB_XGEN(b.x)], 1u);
            asm volatile("s_waitcnt vmcnt(0)" ::: "memory");
        } else {
            XB_SPIN(xb_ld(&bar[XB_XGEN(b.x)]) == gen, bar);
            __builtin_amdgcn_fence(__ATOMIC_ACQUIRE, "agent");
            asm volatile("s_waitcnt vmcnt(0)" ::: "memory");
        }
    }
    __syncthreads();
}


__device__ __forceinline__ void t8_load(const float* W, int N, int item, int lane, f32x4 (&v)[8]) {
    const int nblk = N / 32, kb = item / nblk, nb = item % nblk, k0 = 64 * kb, n0 = 32 * nb;
#pragma unroll
    for (int i = 0; i < 8; ++i) v[i] = __builtin_nontemporal_load((const f32x4*)(W + (size_t)(k0 + 8 * i + (lane >> 3)) * N + n0 + 4 * (lane & 7)));
}
__device__ __forceinline__ void t8_finish(int K, int N, unsigned char* WT, int mode, LAS float* scr, int item, int lane, const f32x4 (&v)[8]) {
    const int nblk = N / 32, kb = item / nblk, nb = item % nblk, k0 = 64 * kb, n0 = 32 * nb;
    const int drow0 = (mode == 0) ? n0 : (mode == 3 ? win_row(n0) : (256 * (n0 >> 7) + (n0 & 127) + (mode == 2 ? 128 : 0)));
#pragma unroll
    for (int i = 0; i < 8; ++i) { LAS float* d = scr + (8 * i + (lane >> 3)) * 33 + 4 * (lane & 7);
#pragma unroll
        for (int j = 0; j < 4; ++j) d[j] = v[i][j] * FP8_SW; }
    asm volatile("s_waitcnt lgkmcnt(0)" ::: "memory");
    const int c = lane & 7;
#pragma unroll
    for (int j = 0; j < 4; ++j) { const int n = (lane >> 3) + 8 * j; const LAS float* q = scr + (8 * c) * 33 + n;
        u32x2 o; o.x = pg8::pack4_fp8(q[0 * 33], q[1 * 33], q[2 * 33], q[3 * 33]); o.y = pg8::pack4_fp8(q[4 * 33], q[5 * 33], q[6 * 33], q[7 * 33]);
        *(u32x2*)(WT + (size_t)(drow0 + n) * K + k0 + 8 * c) = o; }
    asm volatile("s_waitcnt lgkmcnt(0)" ::: "memory");
}
__device__ __forceinline__ void transpose_item8(const float* W, int K, int N, unsigned char* WT, int mode, LAS float* scr, int item, int lane) {
    f32x4 v[8]; t8_load(W, N, item, lane, v); t8_finish(K, N, WT, mode, scr, item, lane, v);
}

__device__ __forceinline__ void t8b_load(const float* W, int N, int item, int lane, f32x4 (&v)[16]) {
    const int nblk = N / 32, kb = item / nblk, nb = item % nblk, k0 = 128 * kb, n0 = 32 * nb;
#pragma unroll
    for (int i = 0; i < 16; ++i) v[i] = __builtin_nontemporal_load((const f32x4*)(W + (size_t)(k0 + 8 * i + (lane >> 3)) * N + n0 + 4 * (lane & 7)));
}
__device__ __forceinline__ void t8b_finish(int K, int N, unsigned char* WT, int mode, LAS float* scr, int item, int lane, const f32x4 (&v)[16]) {
    const int nblk = N / 32, kb = item / nblk, nb = item % nblk, k0 = 128 * kb, n0 = 32 * nb;
    const int drow0 = (mode == 0) ? n0 : (256 * (n0 >> 7) + (n0 & 127) + (mode == 2 ? 128 : 0));
#pragma unroll
    for (int i = 0; i < 16; ++i) { LAS float* d = scr + (8 * i + (lane >> 3)) * 33 + 4 * (lane & 7);
#pragma unroll
        for (int j = 0; j < 4; ++j) d[j] = v[i][j] * FP8_SW; }
    asm volatile("s_waitcnt lgkmcnt(0)" ::: "memory");
    const int c = lane & 15;
#pragma unroll
    for (int j = 0; j < 8; ++j) { const int n = (lane >> 4) + 4 * j; const LAS float* q = scr + (8 * c) * 33 + n;
        u32x2 o; o.x = pg8::pack4_fp8(q[0 * 33], q[1 * 33], q[2 * 33], q[3 * 33]); o.y = pg8::pack4_fp8(q[4 * 33], q[5 * 33], q[6 * 33], q[7 * 33]);
        *(u32x2*)(WT + (size_t)(drow0 + n) * K + k0 + 8 * c) = o; }
    asm volatile("s_waitcnt lgkmcnt(0)" ::: "memory");
}

__device__ __forceinline__ void quant_rows_i8(const bf16_t* W, unsigned char* Q, float* scale, int nrows, int gw, int NGW, int lane) {
#pragma unroll 1
    for (int r = gw; r < nrows; r += NGW) {
        const u32x4 a = *(const u32x4*)(W + (size_t)r * D + 16 * lane), b = *(const u32x4*)(W + (size_t)r * D + 16 * lane + 8);
        float v[16]; { float t[8]; unpack8(a, t);
#pragma unroll
            for (int j = 0; j < 8; ++j) v[j] = t[j];
            unpack8(b, t);
#pragma unroll
            for (int j = 0; j < 8; ++j) v[8 + j] = t[j]; }
        float am = 0.f;
#pragma unroll
        for (int j = 0; j < 16; ++j) am = fmaxf(am, fabsf(v[j]));
        am = fmaxf(wave_max(am), 1e-30f);
        const float qs = 127.0f / am;
        unsigned w[4];
#pragma unroll
        for (int g4 = 0; g4 < 4; ++g4) { const int q0 = (int)__builtin_rintf(v[4 * g4] * qs), q1 = (int)__builtin_rintf(v[4 * g4 + 1] * qs), q2 = (int)__builtin_rintf(v[4 * g4 + 2] * qs), q3 = (int)__builtin_rintf(v[4 * g4 + 3] * qs);
            w[g4] = (unsigned)(q0 & 0xff) | ((unsigned)(q1 & 0xff) << 8) | ((unsigned)(q2 & 0xff) << 16) | ((unsigned)(q3 & 0xff) << 24); }
        *(u32x4*)(Q + (size_t)r * D + 16 * lane) = (u32x4){w[0], w[1], w[2], w[3]};
        if (lane == 0) scale[r] = am * (1.0f / 127.0f);
    }
}

constexpr int CW_TEAM = 3200;
__device__ __forceinline__ void team_barrier(unsigned* ctr, unsigned n, int tid) {
    asm volatile("s_waitcnt vmcnt(0)" ::: "memory");
    __syncthreads();
    if (tid == 0) {
        __builtin_amdgcn_fence(__ATOMIC_RELEASE, "agent");
        asm volatile("s_waitcnt vmcnt(0)" ::: "memory");
        (void)__hip_atomic_fetch_add(ctr, 1u, __ATOMIC_RELAXED, __HIP_MEMORY_SCOPE_AGENT);
        unsigned sp = 0;
        while (__hip_atomic_load(ctr, __ATOMIC_RELAXED, __HIP_MEMORY_SCOPE_AGENT) < n) { __builtin_amdgcn_s_sleep(2); if (++sp > (1u << 20)) break; }
        __builtin_amdgcn_fence(__ATOMIC_ACQUIRE, "agent");
        asm volatile("s_waitcnt vmcnt(0)" ::: "memory");
    }
    __syncthreads();
}
__device__ __forceinline__ void team_arrive(unsigned* ctr, int tid) {
    asm volatile("s_waitcnt vmcnt(0)" ::: "memory");
    __syncthreads();
    if (tid == 0) {
        __builtin_amdgcn_fence(__ATOMIC_RELEASE, "agent");
        asm volatile("s_waitcnt vmcnt(0)" ::: "memory");
        (void)__hip_atomic_fetch_add(ctr, 1u, __ATOMIC_RELAXED, __HIP_MEMORY_SCOPE_AGENT);
    }
}
__device__ __forceinline__ void team_wait(unsigned* ctr, unsigned n, int tid) {
    if (tid == 0) {
        unsigned sp = 0;
        while (__hip_atomic_load(ctr, __ATOMIC_RELAXED, __HIP_MEMORY_SCOPE_AGENT) < n) { __builtin_amdgcn_s_sleep(2); if (++sp > (1u << 20)) break; }
        __builtin_amdgcn_fence(__ATOMIC_ACQUIRE, "agent");
        asm volatile("s_waitcnt vmcnt(0)" ::: "memory");
    }
    __syncthreads();
}

struct Args { const float* in[32]; float* out; unsigned char* ws; int ph_lo, ph_hi; };

enum Phase { PH_PRO = 0, PH_NORM1_L0, PH_WIN_L0, PH_MIX_L0, PH_CARRY_L0, PH_CFIN_L0, PH_WOUT_L0, PH_NORM2_L0, PH_FFNUP, PH_FFNDOWN,
             PH_NORM1_L1, PH_WIN_L1, PH_MIX_L1, PH_CARRY_L1, PH_CFIN_L1, PH_WOUT_L1, PH_NORM2_L1, PH_MOE_UP, PH_MOE_DOWN, PH_FINAL, PH_COUNT };

constexpr int I_IN = (D / 64) * (WIN / 32), I_OUT = (D / 64) * (D / 32), I_13 = (D / 64) * (DFF / 32), I_2 = (DFF / 64) * (D / 32), I_E = 2 * I_13 + I_2;
constexpr int CONV_Q0 = I_IN;
constexpr int CONV_DENSE_END = 2 * I_IN + 2 * I_OUT + 2 * I_13 + I_2;
constexpr int CONV_TOTAL = CONV_DENSE_END + NE * I_E;
constexpr int CW_CQ = 3072;
__device__ __forceinline__ void conv_item(const float* const* in, unsigned char* ws, int r, LAS float* scr, int lane) {
    if (r < 2 * I_IN) { const int l = r / I_IN; if (WIN8) transpose_item8(in[8] + (size_t)l * D * WIN, D, WIN, ws + WS_WIN + (size_t)l * WIN * D, 0, scr, r % I_IN, lane); else transpose_item(in[8] + (size_t)l * D * WIN, D, WIN, (bf16_t*)(ws + WS_WIN) + (size_t)l * WIN * D, 3, scr, r % I_IN, lane); return; } r -= 2 * I_IN;
    if (r < 2 * I_OUT) { const int l = r / I_OUT; transpose_item(in[22] + (size_t)l * D * D, D, D, (bf16_t*)(ws + WS_WOUT) + (size_t)l * D * D, 0, scr, r % I_OUT, lane); return; } r -= 2 * I_OUT;
    if (r < I_13) { if (DENSE_UP8) transpose_item8(in[23], D, DFF, ws + WS_W13, 1, scr, r, lane); else transpose_item(in[23], D, DFF, (bf16_t*)(ws + WS_W13), 1, scr, r, lane); return; } r -= I_13;
    if (r < I_13) { if (DENSE_UP8) transpose_item8(in[24], D, DFF, ws + WS_W13, 2, scr, r, lane); else transpose_item(in[24], D, DFF, (bf16_t*)(ws + WS_W13), 2, scr, r, lane); return; } r -= I_13;
    if (r < I_2) { if (DENSE_DOWN8) transpose_item8(in[25], DFF, D, ws + WS_W2, 0, scr, r, lane); else transpose_item(in[25], DFF, D, (bf16_t*)(ws + WS_W2), 0, scr, r, lane); return; } r -= I_2;
    { const int e = r / I_E; int q = r % I_E; unsigned char* eb = ws + WS_WMOE + (size_t)e * EXP_STRIDE;
      if (q < I_13) { transpose_item8(in[28] + (size_t)e * D * DFF, D, DFF, eb, 1, scr, q, lane); return; } q -= I_13;
      if (q < I_13) { transpose_item8(in[29] + (size_t)e * D * DFF, D, DFF, eb, 2, scr, q, lane); return; } q -= I_13;
      transpose_item8(in[30] + (size_t)e * DFF * D, DFF, D, eb + EXP_W2_OFF, 0, scr, q, lane); }
}
__device__ __forceinline__ void conv_static(const float* const* in, unsigned char* ws, int lo, int hi, int first_block, int G, LAS unsigned char* lds, int wave, int lane) {
    if ((int)blockIdx.x < first_block) return;
    LAS float* scr = (LAS float*)(lds + wave * 16384);
    const int rank = ((int)blockIdx.x - first_block) * NWAVES + wave, stride = (G - first_block) * NWAVES;
#pragma unroll 1
    for (int it = lo + rank; it < hi; it += stride) conv_item(in, ws, it, scr, lane);
}

constexpr int E_I13 = (D / 128) * (DFF / 32), E_I2 = (DFF / 128) * (D / 32), E_IE = 2 * E_I13 + E_I2;
struct ExpItem { const float* W; int K, N; unsigned char* WT; int mode, item; };
__device__ __forceinline__ ExpItem exp_item(const float* const* in, unsigned char* ws, int r) {
    const int e = r / E_IE; int q = r % E_IE; unsigned char* eb = ws + WS_WMOE + (size_t)e * EXP_STRIDE;
    if (q < E_I13) return ExpItem{in[28] + (size_t)e * D * DFF, D, DFF, eb, 1, q};
    q -= E_I13;
    if (q < E_I13) return ExpItem{in[29] + (size_t)e * D * DFF, D, DFF, eb, 2, q};
    q -= E_I13;
    return ExpItem{in[30] + (size_t)e * DFF * D, DFF, D, eb + EXP_W2_OFF, 0, q};
}
constexpr int CQ_CH = NWAVES, CQ_NCHUNK = (NE * E_IE) / CQ_CH, CW_CQ2 = 7552, CW_DONE = 8064;
static_assert((NE * E_IE) % CQ_CH == 0 && CQ_NCHUNK % 8 == 0, "conversion chunks");
__device__ __forceinline__ void conv_pull(const float* const* in, unsigned char* ws, unsigned* ctl, LAS unsigned char* lds, int tid, int wave, int lane, unsigned* done_ctr, unsigned done_target) {
    LAS float* scr = (LAS float*)(lds + wave * 17408);
    volatile LAS int* slot = (volatile LAS int*)(lds + LDS_BYTES - 64);
    const int x = (int)blockIdx.x & 7;
#pragma unroll 1
    for (;;) {
        __syncthreads();
        if (tid == 0) {
            int c = -1;
            const bool stop = done_ctr != nullptr && __hip_atomic_load(done_ctr, __ATOMIC_RELAXED, __HIP_MEMORY_SCOPE_AGENT) >= done_target;
            if (!stop) { const unsigned j = __hip_atomic_fetch_add(ctl + CW_CQ2 + x * 64, 1u, __ATOMIC_RELAXED, __HIP_MEMORY_SCOPE_AGENT); if (j < (unsigned)(CQ_NCHUNK / 8)) c = (int)(j * 8u) + x; }
            *slot = c;
        }
        __syncthreads();
        const int c = *slot;
        if (c < 0) break;
        {
            const ExpItem d0 = exp_item(in, ws, c * CQ_CH + wave);
            f32x4 v0[16];
            t8b_load(d0.W, d0.N, d0.item, lane, v0);
            t8b_finish(d0.K, d0.N, d0.WT, d0.mode, scr, d0.item, lane, v0);
        }
    }
}

__global__ void __launch_bounds__(NTHREADS, 2) fwd(Args args) {
    extern __shared__ __attribute__((aligned(16))) unsigned char lds_raw[];
    LAS unsigned char* lds = (LAS unsigned char*)lds_raw;
    const int tid = threadIdx.x, lane = tid & 63, wave = __builtin_amdgcn_readfirstlane(tid >> 6);
    const int G = gridDim.x;
    unsigned char* ws = args.ws;
    const int lo = args.ph_lo, hi = args.ph_hi;
#ifdef ONLY_PHASE
#define IN(k) ((k) == ONLY_PHASE && lo <= (k) && (k) < hi)
#else
#define IN(k) (lo <= (k) && (k) < hi)
#endif
    float* xl = args.out; float* xctx = (float*)(ws + WS_XCTX);
    float* modv = (float*)(ws + WS_MODV);
    unsigned* ctl = (unsigned*)(ws + WS_CTL);
    unsigned char* route = ws + WS_ROUTE;
    bf16_t* hbuf = (bf16_t*)(ws + WS_HBUF);
    bf16_t* proj = (bf16_t*)(ws + WS_BIG);
    unsigned char* H8 = ws + WS_BIG;
    bf16_t* Yb = (bf16_t*)(ws + WS_Y);
    unsigned char* H8m = ws + WS_H8MOE;
    bf16_t* x16 = (bf16_t*)(ws + WS_X16);
    volatile LAS unsigned* xb_st = (volatile LAS unsigned*)(lds + LDS_BYTES - 16);
    if (tid == 0) { xb_st[0] = 0u; xb_st[1] = 0u; xb_st[2] = 0u; xb_st[3] = 0u; }
    __syncthreads();
    XcdBarrier bar = xcd_barrier_post(ctl + CW_BAR, xb_st);
#define SEAM(k) if (IN(k) && IN((k) + 1)) xcd_barrier(bar);
#define REP(k) for (int rep_ = 0, nrep_ = ((DUPMASK >> (k)) & 1u) ? 2 : 1; rep_ < nrep_; ++rep_, (rep_ < nrep_ ? xcd_barrier(bar) : (void)0))

    if (IN(PH_PRO)) REP(PH_PRO) {
        if (blockIdx.x < 192) mod_task(lds, tid, wave, lane, (int)blockIdx.x, args.in[1], args.in[3], args.in[4], args.in[5], modv);
        LAS float* scr = (LAS float*)(lds + wave * 16384);
        const int gw = blockIdx.x * NWAVES + wave, NGW = G * NWAVES;
#pragma unroll 1
        for (int it = gw; it < CONV_DENSE_END; it += NGW) conv_item(args.in, ws, it, scr, lane);
        bf16_t* gwt = (bf16_t*)(ws + WS_LRUW);
        for (int i = blockIdx.x * NTHREADS + tid; i < 2 * 2 * 2 * 8 * 4096; i += G * NTHREADS) {
            const int k = i & 63, n = (i >> 6) & 63, h = (i >> 12) & 7, mat = (i >> 15) & 1, dir = (i >> 16) & 1, l = i >> 17;
            const float* src = (mat == 0 ? args.in[16] : args.in[18]) + ((size_t)((l * 2 + dir) * 8 + h) * 64 + k) * 64 + n;
            gwt[i] = f2bf(-LOG2E * *src);
        }
        float* gconst = (float*)(ws + WS_GCONST);
        for (int i = blockIdx.x * NTHREADS + tid; i < 2 * 2 * 3 * LRU; i += G * NTHREADS) {
            const int c = i & 511, which = (i >> 9) % 3, ld = (i >> 9) / 3;
            float v;
            if (which == 0) v = -LOG2E * args.in[17][ld * LRU + c];
            else if (which == 1) v = -LOG2E * args.in[19][ld * LRU + c];
            else { const float L = args.in[20][ld * LRU + c]; v = 8.0f * LOG2E * (fminf(L, 0.f) - log1pf(__expf(-fabsf(L)))); }
            gconst[i] = v;
        }
    }
#define GEMM_WIN(l) { constexpr int KB = WIN8 ? D : 2 * D; pg8::DenseSched S; S.init(hbuf, ws + WS_WIN + (size_t)(l) * WIN * KB, MA, WIN, KB, G, (int)blockIdx.x); \
        pg8::EpiProjFused E{proj}; pg8::gemm_phase<WIN8>(lds, KB, S, E); }
#define TAILFILL(k) { if (tid == 0) (void)__hip_atomic_fetch_add(ctl + CW_DONE + (k) * 16, 1u, __ATOMIC_RELAXED, __HIP_MEMORY_SCOPE_AGENT); \
        conv_pull(args.in, ws, ctl, lds, tid, wave, lane, ctl + CW_DONE + (k) * 16, (unsigned)G); }
#define GEMM_WIN_I8(l) { pg8::DenseSched S; S.init(hbuf, ws + WS_WINQ + (size_t)(l) * WIN * D, MA, WIN, D, G, (int)blockIdx.x); \
        pg8::EpiProjFusedI8 E{proj, (const float*)(ws + WS_RS1), (const float*)(ws + WS_WINQS) + (l) * WIN}; pg8::gemm_phase<2>(lds + 4096, D, S, E); }
#define MIXARGS(l) MixArgs m; m.proj = proj; m.ybuf = hbuf; m.conf_w = args.in[9] + (l) * CONFK * 256; m.conf_b = args.in[10] + (l) * 256; m.ln_g = args.in[11] + (l) * 256; m.ln_b = args.in[12] + (l) * 256; \
        m.sconv_w = args.in[13] + (l) * 3 * 256; m.g_mix = args.in[21] + (l) * D; m.cw = args.in[14] + (l) * 4 * LRU; m.cb = args.in[15] + (l) * LRU; \
        m.gwt = (const bf16_t*)(ws + WS_LRUW) + (size_t)(l) * 2 * 2 * 8 * 4096; m.gconst = (const float*)(ws + WS_GCONST) + (l) * 2 * 3 * LRU; \
        m.SA = (float*)(ws + WS_SUMM); m.SB = (float*)(ws + WS_SUMM) + 2 * NB * NPOS * LRU; m.CR = (float*)(ws + WS_CR); m.AB = (unsigned*)(ws + WS_BIG + 116 * MiB);
    SEAM(PH_PRO)
    if (IN(PH_NORM1_L0)) REP(PH_NORM1_L0) { norm_phase<false, WINI8_L0 ? 2 : (WIN8 ? 1 : 0)>(lds, tid, wave, lane, G, args.in[0], args.in[2], args.in[6], modv, M_SH1, M_SC1, hbuf, MA, nullptr, nullptr, ctl, route, (float*)(ws + WS_RS1), true);
        if (DENSE_UPI8) quant_rows_i8((const bf16_t*)(ws + WS_W13), ws + WS_W13Q, (float*)(ws + WS_W13QS), 2 * DFF, (int)blockIdx.x * NWAVES + wave, G * NWAVES, lane);
        if (WINI8_L0) quant_rows_i8((const bf16_t*)(ws + WS_WIN), ws + WS_WINQ, (float*)(ws + WS_WINQS), WIN, (int)blockIdx.x * NWAVES + wave, G * NWAVES, lane);
        if (WINI8_L1) quant_rows_i8((const bf16_t*)(ws + WS_WIN) + (size_t)WIN * D, ws + WS_WINQ + (size_t)WIN * D, (float*)(ws + WS_WINQS) + WIN, WIN, (int)blockIdx.x * NWAVES + wave, G * NWAVES, lane); }
    SEAM(PH_NORM1_L0)
    if (IN(PH_WIN_L0)) REP(PH_WIN_L0) { if constexpr (WINI8_L0) GEMM_WIN_I8(0) else GEMM_WIN(0) TAILFILL(0) }
    SEAM(PH_WIN_L0)
    if (IN(PH_MIX_L0)) REP(PH_MIX_L0) { MIXARGS(0) mix_phase(lds, tid, wave, lane, G, m, MA / 32, ctl + CW_WQ, NB * 4, ctl + CW_TEAM + 128); }
    SEAM(PH_MIX_L0)
    if (IN(PH_CARRY_L0)) REP(PH_CARRY_L0) { MIXARGS(0) carry_phase(lds, tid, wave, lane, G, m, 1, MA / 64, ctl + CW_WQ + 128); }
    SEAM(PH_CARRY_L0)
    if (IN(PH_CFIN_L0)) REP(PH_CFIN_L0) { MIXARGS(0) cfin_phase(lds, tid, wave, lane, G, m); }
    SEAM(PH_CFIN_L0)
    if (IN(PH_WOUT_L0)) REP(PH_WOUT_L0) { pg8::DenseSched S; S.init(hbuf, (const bf16_t*)(ws + WS_WOUT), ML, D, 2 * D, G, (int)blockIdx.x);
        pg8::EpiRes16<true> E{args.in[0], args.in[2], x16, modv + M_GT1, 1.0f, 0}; pg8::gemm_phase<false>(lds, 2 * D, S, E); }
    SEAM(PH_WOUT_L0)
    if (IN(PH_NORM2_L0)) {
        constexpr int OM = DENSE_UPI8 ? 2 : (DENSE_UP8 ? 1 : 0);
        if (blockIdx.x < 16) {
            { pg8::DenseSched S; S.init(hbuf, (const bf16_t*)(ws + WS_WOUT), MC, D, 2 * D, 16, (int)blockIdx.x, ML / 256);
              pg8::EpiRes16<true> E{args.in[0], args.in[2], x16, modv + M_GT1, 1.0f, 0}; pg8::gemm_phase<false>(lds, 2 * D, S, E); }
            team_arrive(ctl + CW_TEAM, tid);
        } else {
            norm_phase<false, OM>(lds, tid, wave, lane, G, xl, xctx, args.in[7], modv, M_SH2, M_SC2, hbuf, ML, nullptr, nullptr, ctl, route, (float*)(ws + WS_RS), false, x16, 16, G - 16, 0);
            conv_pull(args.in, ws, ctl, lds, tid, wave, lane, ctl + CW_TEAM, 16u);
        }
        team_wait(ctl + CW_TEAM, 16u, tid);
        norm_phase<false, OM>(lds, tid, wave, lane, G, xl, xctx, args.in[7], modv, M_SH2, M_SC2, hbuf, MC, nullptr, nullptr, ctl, route, (float*)(ws + WS_RS), false, x16, 0, 0, ML);
    }
    SEAM(PH_NORM2_L0)
    if (IN(PH_FFNUP)) REP(PH_FFNUP) {
        if constexpr (DENSE_UPI8) { pg8::DenseSched S; S.init(hbuf, ws + WS_W13Q, MA, 2 * DFF, D, G, (int)blockIdx.x);
            pg8::EpiSwigluI8<DENSE_DOWN8> E{(void*)H8, DFF, (const float*)(ws + WS_RS), (const float*)(ws + WS_W13QS)}; pg8::gemm_phase<2>(lds + 4096, D, S, E); }
        else { constexpr int KB = DENSE_UP8 ? D : 2 * D; pg8::DenseSched S; S.init(hbuf, ws + WS_W13, MA, 2 * DFF, KB, G, (int)blockIdx.x);
        if constexpr (DENSE_DOWN8) { pg8::EpiSwiglu8 E{H8, DFF, DENSE_UP8 ? 1.0f / FP8_SW : 1.0f, FP8_SH}; pg8::gemm_phase<DENSE_UP8>(lds, KB, S, E); }
        else { pg8::EpiSwiglu E{(bf16_t*)H8, DFF, DENSE_UP8 ? 1.0f / FP8_SW : 1.0f}; pg8::gemm_phase<DENSE_UP8>(lds, KB, S, E); } }
        TAILFILL(2) }
    SEAM(PH_FFNUP)
    if (IN(PH_FFNDOWN)) REP(PH_FFNDOWN) { constexpr int KB = DENSE_DOWN8 ? DFF : 2 * DFF; pg8::DenseSched S; S.init(H8, ws + WS_W2, ML, D, KB, G, (int)blockIdx.x);
        pg8::EpiRes16<false> E{nullptr, nullptr, x16, modv + M_GT2, DENSE_DOWN8 ? 1.0f / (FP8_SW * FP8_SH) : 1.0f, 0}; pg8::gemm_phase<DENSE_DOWN8>(lds, KB, S, E); }
    SEAM(PH_FFNDOWN)
    if (IN(PH_NORM1_L1)) {
        if (blockIdx.x < 16) {
            { constexpr int KB = DENSE_DOWN8 ? DFF : 2 * DFF; pg8::DenseSched S; S.init(H8, ws + WS_W2, MC, D, KB, 16, (int)blockIdx.x, ML / 256);
              pg8::EpiRes16<false> E{nullptr, nullptr, x16, modv + M_GT2, DENSE_DOWN8 ? 1.0f / (FP8_SW * FP8_SH) : 1.0f, 0}; pg8::gemm_phase<DENSE_DOWN8>(lds, KB, S, E); }
            team_arrive(ctl + CW_TEAM + 64, tid);
        } else {
            norm_phase<false, WINI8_L1 ? 2 : (WIN8 ? 1 : 0)>(lds, tid, wave, lane, G, xl, xctx, args.in[6] + D, modv + 5 * 6144, M_SH1, M_SC1, hbuf, ML, nullptr, nullptr, ctl, route, (float*)(ws + WS_RS1), false, x16, 16, G - 16, 0);
            conv_pull(args.in, ws, ctl, lds, tid, wave, lane, ctl + CW_TEAM + 64, 16u);
        }
        team_wait(ctl + CW_TEAM + 64, 16u, tid);
        norm_phase<false, WINI8_L1 ? 2 : (WIN8 ? 1 : 0)>(lds, tid, wave, lane, G, xl, xctx, args.in[6] + D, modv + 5 * 6144, M_SH1, M_SC1, hbuf, MC, nullptr, nullptr, ctl, route, (float*)(ws + WS_RS1), false, x16, 0, 0, ML);
    }
    SEAM(PH_NORM1_L1)
    if (IN(PH_WIN_L1)) REP(PH_WIN_L1) { if constexpr (WINI8_L1) GEMM_WIN_I8(1) else GEMM_WIN(1) TAILFILL(1) }
    SEAM(PH_WIN_L1)
    if (IN(PH_MIX_L1)) REP(PH_MIX_L1) { MIXARGS(1) mix_phase(lds, tid, wave, lane, G, m, ML / 32, ctl + CW_WQ + 64, 0, ctl + CW_TEAM + 128); }
    SEAM(PH_MIX_L1)
    if (IN(PH_CARRY_L1)) REP(PH_CARRY_L1) { MIXARGS(1) carry_phase(lds, tid, wave, lane, G, m, 0, ML / 64, ctl + CW_WQ + 192); }
    SEAM(PH_CARRY_L1)
    if (IN(PH_CFIN_L1)) REP(PH_CFIN_L1) { MIXARGS(1) cfin_phase(lds, tid, wave, lane, G, m); }
    SEAM(PH_CFIN_L1)
    if (IN(PH_WOUT_L1)) REP(PH_WOUT_L1) { pg8::DenseSched S; S.init(hbuf, (const bf16_t*)(ws + WS_WOUT) + (size_t)D * D, ML, D, 2 * D, G, (int)blockIdx.x);
        pg8::EpiRes16<false> E{nullptr, nullptr, x16, modv + 5 * 6144 + M_GT1, 1.0f, 0}; pg8::gemm_phase<false>(lds, 2 * D, S, E); }
    SEAM(PH_WOUT_L1)
    if (IN(PH_NORM2_L1)) REP(PH_NORM2_L1) { norm_phase<true, 1>(lds, tid, wave, lane, G, xl, xctx, args.in[7] + D, modv + 5 * 6144, M_SH2, M_SC2, hbuf, ML, args.in[26], args.in[27], ctl, route, nullptr, false, x16);
        conv_pull(args.in, ws, ctl, lds, tid, wave, lane, nullptr, 0u); }
    SEAM(PH_NORM2_L1)
    if (IN(PH_MOE_UP)) REP(PH_MOE_UP) { pg8::MoeUpSched S; S.init(hbuf, ws + WS_WMOE, (const int*)(route + RT_IDX), ctl, G, (int)blockIdx.x);
        pg8::EpiSwiglu8 E{H8m, DFF, 1.0f / FP8_SW, FP8_SH}; pg8::gemm_phase<true>(lds + 2048, D, S, E); }
    SEAM(PH_MOE_UP)
    if (IN(PH_MOE_DOWN)) REP(PH_MOE_DOWN) { pg8::MoeDownSched S; S.init(H8m, ws + WS_WMOE, ctl, G, (int)blockIdx.x);
        pg8::EpiBf16Store E{Yb, D, 1.0f / (FP8_SW * FP8_SH)}; pg8::gemm_phase<true>(lds, DFF, S, E); }
    SEAM(PH_MOE_DOWN)
    if (IN(PH_FINAL)) REP(PH_FINAL) final_phase(wave, lane, G, xl, x16, Yb, modv + 5 * 6144 + M_GT2, args.in[31], ctl, route);
#undef IN
}

static_assert(CW_CQ2 >= CW_BAR + XCD_BAR_WORDS && CW_CQ2 + 8 * 64 <= CW_DONE && (CW_DONE + 8 * 16) * 4 <= 32 * 1024 && (CW_BAR + XCD_BAR_WORDS) * 4 <= 32 * 1024 && (CW_TEAM + 3 * 64) < CW_BAR && CW_CQ < CW_TEAM && (CW_WQ + 256) <= CW_CQ && (CW_CNT + 8 * 64) <= CW_WQ, "control words inside the per-call memset");
extern "C" void kernel_launch(void* const* d_in, const int* in_sizes, int n_in, void* d_out, int out_size, void* d_ws, size_t ws_size, hipStream_t stream) {
    static int grid = 0;
    if (grid == 0) {
        int dev = 0, cus = 0; (void)hipGetDevice(&dev); (void)hipDeviceGetAttribute(&cus, hipDeviceAttributeMultiprocessorCount, dev);
        (void)hipFuncSetAttribute((const void*)fwd, hipFuncAttributeMaxDynamicSharedMemorySize, LDS_BYTES);
        int per_cu = 0;
        (void)hipOccupancyMaxActiveBlocksPerMultiprocessor(&per_cu, (const void*)fwd, NTHREADS, LDS_BYTES);
        grid = cus > 0 ? cus : 256;
        if (per_cu < 1) fprintf(stderr, "kernel_launch: occupancy query reports %d blocks per CU\n", per_cu);
    }
    Args a{};
    for (int i = 0; i < 32; ++i) a.in[i] = (const float*)d_in[i];
    a.out = (float*)d_out; a.ws = (unsigned char*)d_ws;
    (void)hipMemsetAsync((char*)d_ws + WS_CTL, 0, 32 * 1024, stream);
#ifdef MULTI_LAUNCH
    for (int ph = 0; ph < PH_COUNT; ++ph) { a.ph_lo = ph; a.ph_hi = ph + 1; hipLaunchKernelGGL(fwd, dim3(grid), dim3(NTHREADS), LDS_BYTES, stream, a); }
#else
    a.ph_lo = 0; a.ph_hi = PH_COUNT; hipLaunchKernelGGL(fwd, dim3(grid), dim3(NTHREADS), LDS_BYTES, stream, a);
#endif
}
```
